# Optimizing an MI355X kernel written in HIP

```python
import math
import jax, jax.numpy as jnp
from jax import lax
import numpy as np

D_MODEL = 1024
BATCH = 16
SEQ = 256
DEPTH = 4
DEC_BATCH = 2
DEC_SEQ = 2048
PAST_LEN = 256

GRID_W = 64
N_MIXERS = 2
N_HYENA = (DEPTH + 1) // 2
N_ATTN = DEPTH // 2
N_HEADS = 8
HEAD_DIM = D_MODEL // (2 * N_HEADS)
V_DIM = 2 * HEAD_DIM
ROPE_THETA = 10000.0
ROT_FREQS = HEAD_DIM // 4
Q_BLOCK = 128
HYENA_ORDER = 2
SHORT_W = 3
EMB_BANDS = 16
EMB_DIM = 1 + 2 * EMB_BANDS
FILTER_HIDDEN = 64
DECAY_TARGET = 1e-2
DECAY_PCT_SHORT = 0.3
DECAY_PCT_LONG = 1.5
D_FF = 2816
EPS = 1e-6

kernel_name = "hyena_diffattn_prefix_dit_step"


def rmsnorm(x, w):
    x32 = x.astype(jnp.float32)
    y = x32 * lax.rsqrt(jnp.mean(x32 * x32, axis=-1, keepdims=True) + EPS)
    return (y * w.astype(jnp.float32)).astype(x.dtype)


def adaln_mod(cond, w_ada, b_ada):
    m = jax.nn.silu(cond) @ w_ada + b_ada
    return jnp.split(m[:, None, :], 6, axis=-1)


def modulate(h, shift, scale):
    return h * (1.0 + scale) + shift


def dwconv3(x, w, b):
    xp = jnp.pad(x, ((0, 0), (1, 1), (0, 0)))
    return xp[:, :-2] * w[0] + xp[:, 1:-1] * w[1] + xp[:, 2:] * w[2] + b


def hyena_filter(L, f_w1, f_b1, f_freq, f_w2, f_b2, f_w3):
    t = jnp.linspace(0.0, 1.0, L, dtype=jnp.float32)[:, None]
    w = 2.0 * math.pi * jnp.arange(L, dtype=jnp.float32)[:, None] / L
    bands = jnp.linspace(1e-4, EMB_BANDS - 1, EMB_BANDS, dtype=jnp.float32)
    z = jnp.concatenate([t, jnp.cos(bands * w), -jnp.sin(bands * w)], axis=-1)
    z = z.astype(f_w1.dtype)
    hid = jnp.sin(f_freq * (z @ f_w1 + f_b1))
    hid = jnp.sin(f_freq * (hid @ f_w2 + f_b2))
    h = (hid @ f_w3).astype(jnp.float32)
    min_decay = math.log(DECAY_TARGET) / DECAY_PCT_LONG
    max_decay = math.log(DECAY_TARGET) / DECAY_PCT_SHORT
    deltas = jnp.linspace(min_decay, max_decay, D_MODEL, dtype=jnp.float32)
    decay = jnp.exp(-t * jnp.abs(deltas))
    h_fwd = h[:, :D_MODEL] * decay
    h_bwd = h[:, D_MODEL:] * decay
    zero = jnp.zeros((1, D_MODEL), jnp.float32)
    return jnp.concatenate([h_fwd, zero, h_bwd[1:][::-1]], axis=0)


def long_conv(u, k_circ, d_bias):
    L = u.shape[1]
    uf = jnp.fft.rfft(u.astype(jnp.float32), n=2 * L, axis=1)
    kf = jnp.fft.rfft(k_circ, n=2 * L, axis=0)
    y = jnp.fft.irfft(uf * kf[None], n=2 * L, axis=1)[:, :L]
    y = y + u.astype(jnp.float32) * d_bias.astype(jnp.float32)
    return y.astype(u.dtype)


def hyena_mixer(h, w_in, b_in, w_short, b_short, f_w1, f_b1, f_freq, f_w2, f_b2, f_w3,
                d_bias, w_out, b_out):
    L = h.shape[1]
    u = dwconv3(h @ w_in + b_in, w_short, b_short)
    x0, x1, v = jnp.split(u, HYENA_ORDER + 1, axis=-1)
    k_circ = hyena_filter(L, f_w1, f_b1, f_freq, f_w2, f_b2, f_w3)
    y = x0 * long_conv(v * x1, k_circ, d_bias)
    return y @ w_out + b_out


def axial_rope_tables(rows, dtype):
    r = jnp.repeat(jnp.arange(rows, dtype=jnp.float32), GRID_W)
    cidx = jnp.tile(jnp.arange(GRID_W, dtype=jnp.float32), rows)
    inv = ROPE_THETA ** (-jnp.arange(ROT_FREQS, dtype=jnp.float32) / ROT_FREQS)
    ar = r[:, None] * inv
    ac = cidx[:, None] * inv
    cos = jnp.concatenate([jnp.cos(ar), jnp.cos(ar), jnp.cos(ac), jnp.cos(ac)], axis=-1)
    sin = jnp.concatenate([jnp.sin(ar), jnp.sin(ar), jnp.sin(ac), jnp.sin(ac)], axis=-1)
    return cos[:, None, :].astype(dtype), sin[:, None, :].astype(dtype)


def rope_2d(x, cos, sin):
    xa = x.reshape(x.shape[:-1] + (2, 2, ROT_FREQS))
    x1, x2 = xa[..., 0, :], xa[..., 1, :]
    rot = jnp.stack([-x2, x1], axis=-2).reshape(x.shape)
    return x * cos + rot * sin


def qkv_heads(h, w_qkv):
    B, L, _ = h.shape
    qkv = h @ w_qkv
    q, k, v = jnp.split(qkv, 3, axis=-1)
    q = q.reshape(B, L, N_HEADS, 2, HEAD_DIM).transpose(0, 2, 1, 3, 4)
    k = k.reshape(B, L, N_HEADS, 2, HEAD_DIM).transpose(0, 2, 1, 3, 4)
    v = v.reshape(B, L, N_HEADS, V_DIM).transpose(0, 2, 1, 3)
    return q, k, v


def diff_attention(q, k, v, lam, lam_init, subln_w):
    B, H, Lq = q.shape[:3]
    nb = Lq // Q_BLOCK
    scale = HEAD_DIM ** -0.5
    k1, k2 = k[:, :, :, 0], k[:, :, :, 1]
    qb = q.reshape(B, H, nb, Q_BLOCK, 2, HEAD_DIM).transpose(2, 0, 1, 3, 4, 5)

    def block(qblk):
        s1 = jnp.einsum('bhqd,bhkd->bhqk', qblk[:, :, :, 0], k1).astype(jnp.float32) * scale
        s2 = jnp.einsum('bhqd,bhkd->bhqk', qblk[:, :, :, 1], k2).astype(jnp.float32) * scale
        p = jax.nn.softmax(s1, axis=-1) - lam * jax.nn.softmax(s2, axis=-1)
        return jnp.einsum('bhqk,bhkd->bhqd', p.astype(v.dtype), v)

    o = lax.map(block, qb)
    o = o.transpose(1, 2, 0, 3, 4).reshape(B, H, Lq, V_DIM)
    o = rmsnorm(o, subln_w) * (1.0 - lam_init)
    return o.transpose(0, 2, 1, 3).reshape(B, Lq, N_HEADS * V_DIM)


def conv_ffn(h, w_up, w_dw, b_dw, w_down):
    u = dwconv3(h @ w_up, w_dw, b_dw)
    g, val = jnp.split(u, 2, axis=-1)
    return (jax.nn.silu(g) * val) @ w_down


def setup_inputs(seed: int = 0) -> dict:
    key = jax.random.key(seed)
    ks = iter(jax.random.split(key, 40))
    D = D_MODEL

    def nrm(shape, s):
        return jax.random.normal(next(ks), shape, jnp.float32) * s

    return {
        "x_prompt": nrm((BATCH, SEQ, D), 1.0),
        "x_sample": nrm((DEC_BATCH, DEC_SEQ, D), 1.0),
        "cache_k": nrm((DEC_BATCH, N_ATTN, N_HEADS, PAST_LEN, V_DIM), 1.0),
        "cache_v": nrm((DEC_BATCH, N_ATTN, N_HEADS, PAST_LEN, V_DIM), 1.0),
        "c": nrm((DEC_BATCH, D), 1.0),
        "c_ctx": nrm((D,), 1.0),
        "w_ada": nrm((DEPTH, D, 6 * D), 0.5 * D ** -0.5),
        "b_ada": nrm((DEPTH, 6 * D), 0.01),
        "norm_w": 1.0 + nrm((DEPTH, 4, D), 0.05),
        "hy_w_in": nrm((N_HYENA, D, 3 * D), D ** -0.5),
        "hy_b_in": nrm((N_HYENA, 3 * D), 0.01),
        "hy_w_short": nrm((N_HYENA, SHORT_W, 3 * D), SHORT_W ** -0.5),
        "hy_b_short": nrm((N_HYENA, 3 * D), 0.01),
        "hy_f_w1": nrm((N_HYENA, EMB_DIM, FILTER_HIDDEN), EMB_DIM ** -0.5),
        "hy_f_b1": nrm((N_HYENA, FILTER_HIDDEN), 0.1),
        "hy_f_freq": 1.0 + nrm((N_HYENA, FILTER_HIDDEN), 0.05),
        "hy_f_w2": nrm((N_HYENA, FILTER_HIDDEN, FILTER_HIDDEN), FILTER_HIDDEN ** -0.5),
        "hy_f_b2": nrm((N_HYENA, FILTER_HIDDEN), 0.1),
        "hy_f_w3": nrm((N_HYENA, FILTER_HIDDEN, 2 * D), FILTER_HIDDEN ** -0.5),
        "hy_d_bias": nrm((N_HYENA, D), 0.5),
        "hy_w_out": nrm((N_HYENA, D, D), D ** -0.5),
        "hy_b_out": nrm((N_HYENA, D), 0.01),
        "at_w_qkv": nrm((N_ATTN, D, 3 * D), D ** -0.5),
        "at_w_out": nrm((N_ATTN, D, D), D ** -0.5),
        "at_lambda_q1": nrm((N_ATTN, HEAD_DIM), 0.1),
        "at_lambda_k1": nrm((N_ATTN, HEAD_DIM), 0.1),
        "at_lambda_q2": nrm((N_ATTN, HEAD_DIM), 0.1),
        "at_lambda_k2": nrm((N_ATTN, HEAD_DIM), 0.1),
        "at_subln": 1.0 + nrm((N_ATTN, V_DIM), 0.05),
        "ffn_w_up": nrm((DEPTH, D, 2 * D_FF), D ** -0.5),
        "ffn_w_dw": nrm((DEPTH, 3, 2 * D_FF), 3 ** -0.5),
        "ffn_b_dw": nrm((DEPTH, 2 * D_FF), 0.01),
        "ffn_w_down": nrm((DEPTH, D_FF, D), D_FF ** -0.5),
    }


def reference(x_prompt, x_sample, cache_k, cache_v, c, c_ctx, w_ada, b_ada, norm_w,
              hy_w_in, hy_b_in, hy_w_short, hy_b_short, hy_f_w1, hy_f_b1, hy_f_freq,
              hy_f_w2, hy_f_b2, hy_f_w3, hy_d_bias, hy_w_out, hy_b_out,
              at_w_qkv, at_w_out, at_lambda_q1, at_lambda_k1, at_lambda_q2, at_lambda_k2,
              at_subln, ffn_w_up, ffn_w_dw, ffn_b_dw, ffn_w_down):
    ROWS = x_sample.shape[1] // GRID_W
    cos_s, sin_s = axial_rope_tables(ROWS, x_sample.dtype)
    xp, xs = x_prompt, x_sample
    Bp, Lp = xp.shape[:2]
    Bs, Ls = xs.shape[:2]
    Lc = cache_k.shape[3]
    new_k, new_v = [], []
    for i in range(DEPTH):
        mp = adaln_mod(c_ctx[None, :], w_ada[i], b_ada[i])
        ms = adaln_mod(c, w_ada[i], b_ada[i])
        j = i // N_MIXERS
        hp = modulate(rmsnorm(xp, norm_w[i, 0]), mp[0], mp[1])
        hs = modulate(rmsnorm(xs, norm_w[i, 0]), ms[0], ms[1])
        if i % N_MIXERS == 0:
            hy = (hy_w_in[j], hy_b_in[j], hy_w_short[j], hy_b_short[j], hy_f_w1[j],
                  hy_f_b1[j], hy_f_freq[j], hy_f_w2[j], hy_f_b2[j], hy_f_w3[j],
                  hy_d_bias[j], hy_w_out[j], hy_b_out[j])
            yp = hyena_mixer(hp, *hy)
            ys = hyena_mixer(hs, *hy)
        else:
            lam_init = 0.8 - 0.6 * math.exp(-0.3 * i)
            lam = (jnp.exp(jnp.sum(at_lambda_q1[j] * at_lambda_k1[j]).astype(jnp.float32))
                   - jnp.exp(jnp.sum(at_lambda_q2[j] * at_lambda_k2[j]).astype(jnp.float32))
                   + lam_init)
            qp, kp, vp = qkv_heads(hp, at_w_qkv[j])
            new_k.append(kp.reshape(Bp, N_HEADS, Lp, V_DIM))
            new_v.append(vp)
            yp = diff_attention(qp, kp, vp, lam, lam_init, at_subln[j]) @ at_w_out[j]
            qs, ks_, vs = qkv_heads(hs, at_w_qkv[j])
            qs = rope_2d(qs, cos_s, sin_s)
            ks_ = rope_2d(ks_, cos_s, sin_s)
            k_ctx = cache_k[:, j].reshape(Bs, N_HEADS, Lc, 2, HEAD_DIM).astype(ks_.dtype)
            k_all = jnp.concatenate([k_ctx, ks_], axis=2)
            v_all = jnp.concatenate([cache_v[:, j].astype(vs.dtype), vs], axis=2)
            ys = diff_attention(qs, k_all, v_all, lam, lam_init, at_subln[j]) @ at_w_out[j]
        xp = xp + mp[2] * rmsnorm(yp, norm_w[i, 1])
        xs = xs + ms[2] * rmsnorm(ys, norm_w[i, 1])
        ff = (ffn_w_up[i], ffn_w_dw[i], ffn_b_dw[i], ffn_w_down[i])
        hp = modulate(rmsnorm(xp, norm_w[i, 2]), mp[3], mp[4])
        hs = modulate(rmsnorm(xs, norm_w[i, 2]), ms[3], ms[4])
        xp = xp + mp[5] * rmsnorm(conv_ffn(hp, *ff), norm_w[i, 3])
        xs = xs + ms[5] * rmsnorm(conv_ffn(hs, *ff), norm_w[i, 3])
    new_cache_k = jnp.stack(new_k, axis=1)
    new_cache_v = jnp.stack(new_v, axis=1)
    return (xp, xs, new_cache_k, new_cache_v)
```

```cpp
#include <hip/hip_runtime.h>
#include <hip/hip_cooperative_groups.h>
#include <cstdio>
#include <cstdint>
namespace cg = cooperative_groups;

#ifndef KMASK
#define KMASK 0xFFFF
#endif
#define KON(n) ((KMASK >> (n)) & 1)
#ifndef REP_P0A
#define REP_P0A 1
#endif
#ifndef REP_P0C
#define REP_P0C 1
#endif
#ifndef REP_P0D
#define REP_P0D 1
#endif
#ifndef REP_CV1
#define REP_CV1 1
#endif
#ifndef REP_CV2
#define REP_CV2 1
#endif
#ifndef REP_CV4
#define REP_CV4 1
#endif
#ifndef REP_FC
#define REP_FC 1
#endif
#ifndef REP_FS
#define REP_FS 1
#endif
#ifndef REP_GEMM
#define REP_GEMM 1
#endif
#ifndef REP_CONV
#define REP_CONV 1
#endif
#ifndef REP_ATTN
#define REP_ATTN 1
#endif
#ifndef REP_ELEM
#define REP_ELEM 1
#endif
#ifndef REP_P0
#define REP_P0 1
#endif
#ifndef REP_SYNC
#define REP_SYNC 1
#endif
#ifndef MK_ONE_LAUNCH
#define MK_ONE_LAUNCH 1
#endif

#define LAS __attribute__((address_space(3)))
typedef unsigned short bf16_t;
typedef short bf16x8 __attribute__((ext_vector_type(8)));
typedef short s16x4 __attribute__((ext_vector_type(4)));
typedef float f32x4 __attribute__((ext_vector_type(4)));
typedef float f32x16 __attribute__((ext_vector_type(16)));
typedef unsigned u32x4 __attribute__((ext_vector_type(4)));
typedef unsigned u32x2 __attribute__((ext_vector_type(2)));
typedef float f32x2_t __attribute__((ext_vector_type(2)));
typedef __bf16 bf16x2_t __attribute__((ext_vector_type(2)));

#define DI __device__ __forceinline__
DI unsigned cvtpk(float lo, float hi) { f32x2_t v = {lo, hi}; bf16x2_t b = __builtin_convertvector(v, bf16x2_t); return __builtin_bit_cast(unsigned, b); }
DI float bflo(unsigned u) { return __builtin_bit_cast(float, u << 16); }
DI float bfhi(unsigned u) { return __builtin_bit_cast(float, u & 0xffff0000u); }
DI void unpack8(u32x4 v, float* f) { f[0] = bflo(v.x); f[1] = bfhi(v.x); f[2] = bflo(v.y); f[3] = bfhi(v.y); f[4] = bflo(v.z); f[5] = bfhi(v.z); f[6] = bflo(v.w); f[7] = bfhi(v.w); }
DI float wave_sum(float v) {
#pragma unroll
    for (int o = 1; o < 64; o <<= 1) v += __shfl_xor(v, o);
    return v;
}

constexpr int D = 1024, TT = 8192, TP = 4096, DFF = 2816, NUP = 5632, NMIX = 3072;
constexpr float EPS = 1e-6f;
constexpr int NWAVES = 8;
constexpr int LDS_BYTES = 139264, LDS_MISC = 135168;

constexpr size_t MiB = 1u << 20;
constexpr size_t WS_MOD = 0;
constexpr size_t WS_CTL = 512 * 1024, CTL_BYTES = 32768, WS_ZERO = WS_CTL + 16384;
constexpr size_t WS_ROPE = 1 * MiB;
constexpr size_t WS_W = 2 * MiB;
constexpr size_t W_MIX = 0, W_OUT = 6291456, W_UP = W_OUT + 2097152, W_DOWN = W_UP + 11534336, W_LAYER = W_DOWN + 5767168;
static_assert(W_LAYER == 25690112, "layer weight bytes");
constexpr size_t WS_FILT = 100 * MiB;
constexpr size_t FILT_LAYER = 9 * MiB;
constexpr size_t WS_Z = 118 * MiB;
constexpr size_t WS_A = 206 * MiB;
constexpr size_t WS_END = 254 * MiB;
static_assert(WS_W + 4 * W_LAYER <= WS_FILT, "ws map");

namespace pg8 {
constexpr int BM = 256, BK = 64, HALF = 128, HTB = HALF * BK * 2, STAGE_BYTES = 8 * HTB, NXCD = 8, WGM = 8;
DI int lds_byte(int r, int c) { const int st = (r >> 4) * 2 + (c >> 5), rr = r & 15, cc = c & 31, ob = rr * 64 + cc * 2; return st * 1024 + (ob ^ (((ob >> 9) & 1) << 5)); }
DI void stage_rc(int b, int& R, int& C) { const int st = b / 1024, sb = b % 1024, swz = sb ^ (((sb >> 9) & 1) << 5); R = (st >> 1) * 16 + swz / 64; C = (st & 1) * 32 + (swz % 64) / 2; }
DI int perm32(int rho) { const int n = rho >> 4, i = rho & 15; return 8 * (i >> 2) + 4 * n + (i & 3); }

struct Unit { int pm, pn, ks; };
struct Gemm { const bf16_t* A; const bf16_t* Bt; int M, N, K, KS, aslab; };

struct Order {
    int nM, nN, nwg, G, c, KS;
    DI void init(int M, int N, int KS_, int G_, int c_) { nM = M / BM; nN = N / BM; nwg = nM * nN; G = G_; c = c_; KS = KS_; }
    DI bool next(int i, Unit& u) const {
        const int L = i * G + c; if (L >= nwg * KS) return false;
        u.ks = L / nwg;
        int wgid = L % nwg; { const int q = nwg / NXCD, r = nwg % NXCD, xcd = wgid % NXCD, off = wgid / NXCD; wgid = (xcd < r ? xcd * (q + 1) : r * (q + 1) + (xcd - r) * q) + off; }
        const int nig = WGM * nN, gid = wgid / nig, fm = gid * WGM, gsz = (nM - fm) < WGM ? (nM - fm) : WGM;
        u.pm = fm + ((wgid % nig) % gsz); u.pn = (wgid % nig) / gsz; return true;
    }
};

struct EpiZ {
    bf16_t* O; int ldc; const float* bias; int slab;
    DI void operator()(const f32x4 (&acc)[2][2][4][2], const Unit& u, int wr, int wc, int fr, int fq) const {
        const int row0 = u.pm * BM + wr * 64 + fr, col0 = u.pn * BM + wc * 32 + 8 * fq;
        f32x4 bv[2][2];
#pragma unroll
        for (int bj = 0; bj < 2; ++bj)
#pragma unroll
            for (int n = 0; n < 2; ++n) bv[bj][n] = bias ? *(const f32x4*)(bias + col0 + bj * HALF + 4 * n) : (f32x4){0.f, 0.f, 0.f, 0.f};
#pragma unroll
        for (int ai = 0; ai < 2; ++ai)
#pragma unroll
            for (int m = 0; m < 4; ++m) { const int row = row0 + ai * HALF + m * 16;
                bf16_t* rowp = slab ? O + ((size_t)(col0 >> 3) * TT + row) * 8 : O + (size_t)row * ldc + col0;
                const size_t bjs = slab ? (size_t)16 * TT * 8 : (size_t)HALF;
#pragma unroll
                for (int bj = 0; bj < 2; ++bj) { const f32x4 v0 = acc[ai][bj][m][0] + bv[bj][0], v1 = acc[ai][bj][m][1] + bv[bj][1];
                    u32x4 w; w.x = cvtpk(v0[0], v0[1]); w.y = cvtpk(v0[2], v0[3]); w.z = cvtpk(v1[0], v1[1]); w.w = cvtpk(v1[2], v1[3]);
                    *(u32x4*)(rowp + bj * bjs) = w; } }
    }
};

struct EpiQKV {
    bf16_t* O; const float* ropec; const float* ropes; float* newk; float* newv;
    DI void operator()(const f32x4 (&acc)[2][2][4][2], const Unit& u, int wr, int wc, int fr, int fq) const {
        const int row0 = u.pm * BM + wr * 64 + fr, col0 = u.pn * BM + wc * 32 + 8 * fq;
        const bool sample = u.pm >= 16; const int sec = u.pn >> 2;
        const bool rope = sample && sec < 2;
        const float sgn = (fq & 2) ? 1.f : -1.f;
        const int axis = (col0 >> 5) & 1, f0 = col0 & 15;
#pragma unroll
        for (int ai = 0; ai < 2; ++ai) {
#pragma unroll
          for (int mh = 0; mh < 2; ++mh) {
            f32x4 c0[2], c1[2], s0[2], s1[2];
            if (rope) {
#pragma unroll
                for (int m2 = 0; m2 < 2; ++m2) { const int tpos = (row0 + ai * HALF + (2 * mh + m2) * 16 - TP) & 2047;
                    const float* cp = ropec + tpos * 32 + axis * 16 + f0; const float* sp = ropes + tpos * 32 + axis * 16 + f0;
                    c0[m2] = *(const f32x4*)cp; c1[m2] = *(const f32x4*)(cp + 4); s0[m2] = *(const f32x4*)sp; s1[m2] = *(const f32x4*)(sp + 4); }
            }
#pragma unroll
            for (int m2 = 0; m2 < 2; ++m2) { const int m = 2 * mh + m2; const int row = row0 + ai * HALF + m * 16;
#pragma unroll
                for (int bj = 0; bj < 2; ++bj) { const int col = col0 + bj * HALF;
                    f32x4 v0 = acc[ai][bj][m][0], v1 = acc[ai][bj][m][1];
                    if (rope) {
                        f32x4 p0, p1;
#pragma unroll
                        for (int e = 0; e < 4; ++e) { p0[e] = __shfl_xor(v0[e], 32); p1[e] = __shfl_xor(v1[e], 32); }
                        v0 = v0 * c0[m2] + (p0 * s0[m2]) * sgn; v1 = v1 * c1[m2] + (p1 * s1[m2]) * sgn;
                    }
                    u32x4 w; w.x = cvtpk(v0[0], v0[1]); w.y = cvtpk(v0[2], v0[3]); w.z = cvtpk(v1[0], v1[1]); w.w = cvtpk(v1[2], v1[3]);
                    *(u32x4*)(O + (size_t)row * NMIX + col) = w;
                    if (!sample && sec >= 1) {
                        const int cc = col - sec * 1024, h = cc >> 7, d = cc & 127, b = row >> 8, t = row & 255;
                        float* dst = (sec == 1 ? newk : newv) + ((size_t)((b * 2) * 8 + h) * 256 + t) * 128 + d;
                        *(f32x4*)dst = v0; *(f32x4*)(dst + 4) = v1;
                    }
                } }
          }
        }
    }
};

struct EpiF32 {
    bf16_t* Y; int ldc; size_t kstride;
    DI void operator()(const f32x4 (&acc)[2][2][4][2], const Unit& u, int wr, int wc, int fr, int fq) const {
        const int row0 = u.pm * BM + wr * 64 + fr, col0 = u.pn * BM + wc * 32 + 8 * fq;
        bf16_t* base = Y + (size_t)u.ks * kstride;
#pragma unroll
        for (int ai = 0; ai < 2; ++ai)
#pragma unroll
            for (int m = 0; m < 4; ++m) { bf16_t* rowp = base + (size_t)(row0 + ai * HALF + m * 16) * ldc + col0;
#pragma unroll
                for (int bj = 0; bj < 2; ++bj) { const f32x4 v0 = acc[ai][bj][m][0], v1 = acc[ai][bj][m][1];
                    u32x4 w; w.x = cvtpk(v0[0], v0[1]); w.y = cvtpk(v0[2], v0[3]); w.z = cvtpk(v1[0], v1[1]); w.w = cvtpk(v1[2], v1[3]);
                    *(u32x4*)(rowp + bj * HALF) = w; } }
    }
};

DI f32x4 bperm4(int addr, const f32x4 v) {
    const float v0 = v[0], v1 = v[1], v2 = v[2], v3 = v[3];
    const int a = __builtin_amdgcn_ds_bpermute(addr, __float_as_int(v0)), b = __builtin_amdgcn_ds_bpermute(addr, __float_as_int(v1));
    const int c = __builtin_amdgcn_ds_bpermute(addr, __float_as_int(v2)), d = __builtin_amdgcn_ds_bpermute(addr, __float_as_int(v3));
    return (f32x4){__int_as_float(a), __int_as_float(b), __int_as_float(c), __int_as_float(d)};
}
struct EpiFFN {
    bf16_t* Aout; const float* wdw; const float* bdw; float* side;
    DI void operator()(const f32x4 (&acc)[2][2][4][2], const Unit& u, int wr, int wc, int fr, int fq) const {
        const int colg = u.pn * 128 + wc * 32 + 8 * fq;
        const int tok0 = u.pm * BM + 8 * (16 * wr + fr);
        const bool efirst = (fr == 0), elast = (fr == 15);
        float* sb = side + (size_t)((u.pm * 4 + wr * 2 + (elast ? 1 : 0)) * 2) * NUP;
        bf16_t* ap_ = Aout + (size_t)tok0 * DFF + colg;
#pragma unroll
        for (int n = 0; n < 2; ++n) {
            const int cg = colg + 4 * n, cv = DFF + colg + 4 * n;
            const f32x4 wg0 = *(const f32x4*)(wdw + cg), wg1 = *(const f32x4*)(wdw + NUP + cg), wg2 = *(const f32x4*)(wdw + 2 * NUP + cg), bg = *(const f32x4*)(bdw + cg);
            const f32x4 wv0 = *(const f32x4*)(wdw + cv), wv1 = *(const f32x4*)(wdw + NUP + cv), wv2 = *(const f32x4*)(wdw + 2 * NUP + cv), bv = *(const f32x4*)(bdw + cv);
            const int lane_ = fq * 16 + fr, pl = ((lane_ - 1) & 63) * 4, nl = ((lane_ + 1) & 63) * 4;
            const float mf = efirst ? 0.f : 1.f, ml = elast ? 0.f : 1.f;
            const f32x4 pg = bperm4(pl, acc[1][0][3][n]) * mf, pv = bperm4(pl, acc[1][1][3][n]) * mf;
#pragma unroll
            for (int q = 0; q < 8; ++q) {
                const f32x4 zgp = q == 0 ? pg : acc[(q - 1) >> 2][0][(q - 1) & 3][n], zgc = acc[q >> 2][0][q & 3][n], zgn = q == 7 ? bperm4(nl, acc[0][0][0][n]) * ml : acc[((q + 1) & 7) >> 2][0][(q + 1) & 3][n];
                const f32x4 zvp = q == 0 ? pv : acc[(q - 1) >> 2][1][(q - 1) & 3][n], zvc = acc[q >> 2][1][q & 3][n], zvn = q == 7 ? bperm4(nl, acc[0][1][0][n]) * ml : acc[((q + 1) & 7) >> 2][1][(q + 1) & 3][n];
                const f32x4 g = wg0 * zgp + wg1 * zgc + wg2 * zgn + bg;
                const f32x4 v = wv0 * zvp + wv1 * zvc + wv2 * zvn + bv;
                const bool edge = (q == 0 && efirst) || (q == 7 && elast);
                if ((q == 0 || q == 7) && edge) {
                    *(f32x4*)(sb + cg) = zgc; *(f32x4*)(sb + cv) = zvc; *(f32x4*)(sb + NUP + cg) = g; *(f32x4*)(sb + NUP + cv) = v;
                } else {
                    float r[4];
#pragma unroll
                    for (int e = 0; e < 4; ++e) r[e] = g[e] * __builtin_amdgcn_rcpf(1.f + __expf(-g[e])) * v[e];
                    u32x2 w; w.x = cvtpk(r[0], r[1]); w.y = cvtpk(r[2], r[3]);
                    *(u32x2*)(ap_ + (size_t)q * DFF + 4 * n) = w;
                }
            }
        }
    }
};

struct EpiU {
    int mode; EpiZ z; EpiQKV q; EpiF32 f; EpiFFN n;
    DI void operator()(const f32x4 (&acc)[2][2][4][2], const Unit& u, int wr, int wc, int fr, int fq) const {
        if (mode == 0) z(acc, u, wr, wc, fr, fq); else if (mode == 1) q(acc, u, wr, wc, fr, fq); else if (mode == 2) f(acc, u, wr, wc, fr, fq); else n(acc, u, wr, wc, fr, fq);
    }
};

template <class Epi>
DI void gemm_phase(LAS unsigned char* lds, const int tid, const Gemm g, const Order& S, const Epi& E) {
    const int wid = __builtin_amdgcn_readfirstlane(tid >> 6), lane = tid & 63, wr = wid >> 2, wc = wid & 3, fr = lane & 15, fq = lane >> 4;
    const int K = g.K, Ksub = K / g.KS, nt = Ksub / BK;
    unsigned voffA[2], voffB[2];
#pragma unroll
    for (int i = 0; i < 2; ++i) { int R, C; stage_rc(tid * 16 + i * 8192, R, C); const int Rb = (R & ~31) + perm32(R & 31);
        const int tau = 8 * ((R >> 6) * 16 + (R & 15)) + ((R >> 4) & 3);
        voffA[i] = g.aslab == 1 ? (unsigned)((C >> 3) * g.M + R) * 16u : (g.aslab == 2 ? (unsigned)(tau * K + C) * 2u : (unsigned)(R * K + C) * 2u); voffB[i] = (unsigned)(Rb * K + C) * 2u; }
    const size_t kstep = (size_t)(BK * 2);
    const size_t hstep = (size_t)HALF * K * 2;
    const size_t tstep = 2 * hstep;
    const size_t ksb = (size_t)Ksub * 2;
    const size_t kstepA = g.aslab == 1 ? (size_t)8 * g.M * 16 : kstep, hstepA = g.aslab == 1 ? (size_t)HALF * 16 : (g.aslab == 2 ? (size_t)4 * K * 2 : hstep), tstepA = g.aslab == 1 ? (size_t)BM * 16 : tstep, ksbA = g.aslab == 1 ? (size_t)(Ksub / 8) * g.M * 16 : ksb;
    const unsigned ldsw = (unsigned)wid * 1024u;
    const int aoff = lds_byte(wr * 64 + fr, fq * 8), boff = lds_byte(wc * 32 + fr, fq * 8);
#define PG8_SA(b, h) (((b) * 2 + (h)) * HTB)
#define PG8_SB(b, h) ((4 + (b) * 2 + (h)) * HTB)
#define PG8_STAGE(bufoff, gbase, voff) do { _Pragma("unroll") for (int _i = 0; _i < 2; ++_i) \
        __builtin_amdgcn_global_load_lds((const unsigned*)((const char*)(gbase) + (voff)[_i]), (LAS unsigned*)(lds + (bufoff) + ldsw + _i * 8192), 16, 0, 0); } while (0)
#define PG8_LDA(dst, b, h) do { _Pragma("unroll") for (int m = 0; m < 4; ++m) _Pragma("unroll") for (int k = 0; k < 2; ++k) dst[m][k] = *(const LAS bf16x8*)(lds + PG8_SA(b, h) + aoff + m * 2048 + k * 1024); } while (0)
#define PG8_LDB(dst, b, h) do { _Pragma("unroll") for (int n = 0; n < 2; ++n) _Pragma("unroll") for (int k = 0; k < 2; ++k) dst[n][k] = *(const LAS bf16x8*)(lds + PG8_SB(b, h) + boff + n * 2048 + k * 1024); } while (0)
#define PG8_MMA(ai, bj, At, Bt) do { __builtin_amdgcn_s_setprio(1); _Pragma("unroll") for (int m = 0; m < 4; ++m) _Pragma("unroll") for (int n = 0; n < 2; ++n) _Pragma("unroll") for (int k = 0; k < 2; ++k) \
        acc[ai][bj][m][n] = __builtin_amdgcn_mfma_f32_16x16x32_bf16(Bt[n][k], At[m][k], acc[ai][bj][m][n], 0, 0, 0); __builtin_amdgcn_s_setprio(0); } while (0)
#define PG8_WAIT_V(n) asm volatile("s_waitcnt vmcnt(" #n ")" ::: "memory")
#define PG8_WAIT_L(n) asm volatile("s_waitcnt lgkmcnt(" #n ")" ::: "memory")
#define PG8_BAR __builtin_amdgcn_s_barrier()
#define PG8_SCHED __builtin_amdgcn_sched_barrier(0)
    Unit cur, nxt; int ui = 0;
    if (!S.next(0, cur)) return;
    f32x4 acc[2][2][4][2];
#pragma unroll
    for (int a = 0; a < 2; ++a)
#pragma unroll
        for (int b = 0; b < 2; ++b)
#pragma unroll
            for (int m = 0; m < 4; ++m)
#pragma unroll
                for (int n = 0; n < 2; ++n) acc[a][b][m][n] = (f32x4){0.f, 0.f, 0.f, 0.f};
    bf16x8 At[4][2], B0[2][2], B1[2][2];
    const char* cA = (const char*)g.A + (size_t)cur.pm * tstepA + (size_t)cur.ks * ksbA; const char* cB = (const char*)g.Bt + (size_t)cur.pn * tstep + (size_t)cur.ks * ksb;
    PG8_STAGE(PG8_SB(0, 0), cB, voffB); PG8_STAGE(PG8_SB(0, 1), cB + hstep, voffB); PG8_STAGE(PG8_SA(0, 0), cA, voffA); PG8_STAGE(PG8_SA(0, 1), cA + hstepA, voffA);
    if (wr == 1) PG8_BAR;
    PG8_WAIT_V(2); PG8_BAR;
    PG8_STAGE(PG8_SB(1, 0), cB + kstep, voffB); PG8_STAGE(PG8_SA(1, 0), cA + kstepA, voffA); PG8_STAGE(PG8_SB(1, 1), cB + hstep + kstep, voffB);
    PG8_WAIT_V(6); PG8_BAR;
    for (;;) {
        const bool has_next = S.next(ui + 1, nxt);
        const char* nA = has_next ? (const char*)g.A + (size_t)nxt.pm * tstepA + (size_t)nxt.ks * ksbA : cA; const char* nB = has_next ? (const char*)g.Bt + (size_t)nxt.pn * tstep + (size_t)nxt.ks * ksb : cB;
        for (int t = 0; t < nt; t += 2) {
            const bool last = (t == nt - 2);
            const char* a1 = cA + (size_t)(t + 1) * kstepA;
            const char* a2 = last ? nA : cA + (size_t)(t + 2) * kstepA; const char* b2 = last ? nB : cB + (size_t)(t + 2) * kstep;
            const char* a3 = a2 + kstepA; const char* b3 = b2 + kstep;
            PG8_LDB(B0, 0, 0); PG8_LDB(B1, 0, 1); PG8_SCHED; PG8_LDA(At, 0, 0); PG8_STAGE(PG8_SA(1, 1), a1 + hstepA, voffA);
            PG8_WAIT_V(8); PG8_WAIT_L(0); PG8_BAR; PG8_MMA(0, 0, At, B0); PG8_MMA(0, 1, At, B1); PG8_BAR; PG8_SCHED;
            PG8_LDA(At, 0, 1); PG8_STAGE(PG8_SB(0, 0), b2, voffB); PG8_STAGE(PG8_SB(0, 1), b2 + hstep, voffB); PG8_STAGE(PG8_SA(0, 0), a2, voffA);
            PG8_WAIT_V(8); PG8_WAIT_L(0); PG8_BAR; PG8_MMA(1, 0, At, B0); PG8_MMA(1, 1, At, B1); PG8_BAR; PG8_SCHED;
            PG8_LDB(B0, 1, 0); PG8_LDB(B1, 1, 1); PG8_SCHED; PG8_LDA(At, 1, 0); PG8_STAGE(PG8_SA(0, 1), a2 + hstepA, voffA);
            PG8_WAIT_V(8); PG8_WAIT_L(0); PG8_BAR; PG8_MMA(0, 0, At, B0); PG8_MMA(0, 1, At, B1); PG8_BAR; PG8_SCHED;
            PG8_LDA(At, 1, 1); PG8_STAGE(PG8_SB(1, 0), b3, voffB); PG8_STAGE(PG8_SB(1, 1), b3 + hstep, voffB); PG8_STAGE(PG8_SA(1, 0), a3, voffA);
            PG8_WAIT_V(8); PG8_WAIT_L(0); PG8_BAR; PG8_MMA(1, 0, At, B0); PG8_MMA(1, 1, At, B1); PG8_BAR; PG8_SCHED;
        }
        if (wr == 0) PG8_BAR;
        E(acc, cur, wr, wc, fr, fq);
        if (!has_next) break;
#pragma unroll
        for (int a = 0; a < 2; ++a)
#pragma unroll
            for (int b = 0; b < 2; ++b)
#pragma unroll
                for (int m = 0; m < 4; ++m)
#pragma unroll
                    for (int n = 0; n < 2; ++n) acc[a][b][m][n] = (f32x4){0.f, 0.f, 0.f, 0.f};
        cur = nxt; cA = nA; cB = nB; ++ui;
        if (wr == 1) PG8_BAR;
    }
    PG8_WAIT_V(0);
    PG8_BAR;
#undef PG8_SA
#undef PG8_SB
#undef PG8_STAGE
#undef PG8_LDA
#undef PG8_LDB
#undef PG8_MMA
#undef PG8_WAIT_V
#undef PG8_WAIT_L
#undef PG8_BAR
#undef PG8_SCHED
}
}

struct Args { const float* in[33]; float* out; unsigned char* ws; int ph_lo, ph_hi; };
enum { I_XP = 0, I_XS, I_CK, I_CV, I_C, I_CCTX, I_WADA, I_BADA, I_NORMW, I_HWIN, I_HBIN, I_HWSH, I_HBSH, I_FW1, I_FB1, I_FFREQ, I_FW2, I_FB2, I_FW3, I_DBIAS, I_HWOUT, I_HBOUT,
       I_AWQKV, I_AWOUT, I_LQ1, I_LK1, I_LQ2, I_LK2, I_SUBLN, I_FUP, I_FDW, I_FBDW, I_FDOWN };

DI int up_row(int n) { return n < DFF ? (n >> 7) * 256 + (n & 127) : ((n - DFF) >> 7) * 256 + 128 + ((n - DFF) & 127); }
DI void p0_transpose_item(const float* W, int K, int N, bf16_t* WT, LAS float* scr, int item, int lane, bool perm_up = false) {
    const int nblk = N / 32, kb = item / nblk, nb = item % nblk, k0 = 64 * kb, n0 = 32 * nb;
    float wv[32];
#pragma unroll
    for (int i = 0; i < 32; ++i) { const int kk = 2 * i + (lane >> 5); wv[i] = W[(size_t)(k0 + kk) * N + n0 + (lane & 31)]; }
#pragma unroll
    for (int i = 0; i < 32; ++i) { const int kk = 2 * i + (lane >> 5); scr[kk * 33 + (lane & 31)] = wv[i]; }
    asm volatile("s_waitcnt lgkmcnt(0)" ::: "memory");
    const int c = lane & 7;
#pragma unroll
    for (int j = 0; j < 4; ++j) { const int n = (lane >> 3) + 8 * j; const LAS float* s = scr + (8 * c) * 33 + n;
        u32x4 o; o.x = cvtpk(s[0 * 33], s[1 * 33]); o.y = cvtpk(s[2 * 33], s[3 * 33]); o.z = cvtpk(s[4 * 33], s[5 * 33]); o.w = cvtpk(s[6 * 33], s[7 * 33]);
        *(u32x4*)(WT + (size_t)(perm_up ? up_row(n0) + n : n0 + n) * K + k0 + 8 * c) = o; }
    asm volatile("s_waitcnt lgkmcnt(0)" ::: "memory");
}

typedef const __attribute__((address_space(4))) Args* ArgsP;
constexpr int I_MIX = 16 * 96, I_OUT = 16 * 32, I_UP = 16 * 176, I_DOWN = 44 * 32, I_LAYER = I_MIX + I_OUT + I_UP + I_DOWN;
DI void convert_layer_weights(ArgsP ap, int i, int gwl, int NGWL, LAS float* scr, int lane) {
    const int jj = i >> 1;
    unsigned char* wl = ap->ws + WS_W + (size_t)i * W_LAYER;
    for (int it = gwl; it < I_LAYER; it += NGWL) {
        int r = it;
        if (r < I_MIX) { const float* W = (i & 1) ? ap->in[I_AWQKV] + (size_t)jj * 1024 * 3072 : ap->in[I_HWIN] + (size_t)jj * 1024 * 3072; p0_transpose_item(W, 1024, 3072, (bf16_t*)(wl + W_MIX), scr, r, lane); continue; } r -= I_MIX;
        if (r < I_OUT) { const float* W = (i & 1) ? ap->in[I_AWOUT] + (size_t)jj * 1024 * 1024 : ap->in[I_HWOUT] + (size_t)jj * 1024 * 1024; p0_transpose_item(W, 1024, 1024, (bf16_t*)(wl + W_OUT), scr, r, lane); continue; } r -= I_OUT;
        if (r < I_UP) { p0_transpose_item(ap->in[I_FUP] + (size_t)i * 1024 * 5632, 1024, 5632, (bf16_t*)(wl + W_UP), scr, r, lane, true); continue; } r -= I_UP;
        p0_transpose_item(ap->in[I_FDOWN] + (size_t)i * 2816 * 1024, 2816, 1024, (bf16_t*)(wl + W_DOWN), scr, r, lane);
    }
}

DI void phase0(ArgsP ap, LAS unsigned char* lds, int tid, int lane, int wave, int G) {
    unsigned char* ws = ap->ws;
    LAS float* sl = (LAS float*)lds;
    LAS float* red = sl + 3072;
    for (int idx = tid; idx < 3072; idx += 512) { const int cnd = idx >> 10, k = idx & 1023; const float v = cnd == 0 ? ap->in[I_CCTX][k] : ap->in[I_C][(cnd - 1) * 1024 + k]; sl[idx] = v / (1.f + __expf(-v)); }
    __syncthreads();
    float* mod = (float*)(ws + WS_MOD);
    for (int rep = 0; rep < REP_P0A; ++rep)
    for (int item = blockIdx.x; item < 384; item += G) {
        const int i = item / 96, n0 = (item % 96) * 64;
        const float* W = ap->in[I_WADA] + (size_t)i * 1024 * 6144 + n0 + lane;
        float a0 = 0.f, a1 = 0.f, a2 = 0.f; const int k0 = wave * 128;
#pragma unroll 16
        for (int kk = 0; kk < 128; ++kk) { const float w = W[(size_t)(k0 + kk) * 6144]; a0 += sl[k0 + kk] * w; a1 += sl[1024 + k0 + kk] * w; a2 += sl[2048 + k0 + kk] * w; }
        red[(wave * 3 + 0) * 64 + lane] = a0; red[(wave * 3 + 1) * 64 + lane] = a1; red[(wave * 3 + 2) * 64 + lane] = a2;
        __syncthreads();
        if (tid < 192) { const int cnd = tid >> 6, l = tid & 63; float s = 0.f;
#pragma unroll
            for (int w = 0; w < 8; ++w) s += red[(w * 3 + cnd) * 64 + l];
            mod[(i * 3 + cnd) * 6144 + n0 + l] = s + ap->in[I_BADA][i * 6144 + n0 + l]; }
        __syncthreads();
    }
    __syncthreads();
    { float* rc = (float*)(ws + WS_ROPE); float* rs = rc + 2048 * 32;
      for (int idx = blockIdx.x * 512 + tid; idx < 2048 * 32; idx += G * 512) { const int t = idx >> 5, e = idx & 31, ax = e >> 4, f = e & 15;
          const float pos = (float)(ax == 0 ? (t >> 6) : (t & 63)); const float inv = __builtin_amdgcn_exp2f(-(float)f * (13.287712379549449f / 16.f)); const float ang = pos * inv;
          rc[idx] = __cosf(ang); rs[idx] = __sinf(ang); } }
    const int gw = blockIdx.x * NWAVES + wave, NGW = G * NWAVES;
    constexpr int FW_L = 33 * 64 + 64 * 64 + 192;
    LAS float* fw = (LAS float*)lds;
    for (int jj = 0; jj < 2; ++jj) {
        LAS float* f = fw + jj * FW_L;
        { float v[5];
#pragma unroll
          for (int k = 0; k < 5; ++k) { const int r = tid + 512 * k; v[k] = r < 2112 ? ap->in[I_FW1][jj * 2112 + r] : 0.f; }
#pragma unroll
          for (int k = 0; k < 5; ++k) { const int r = tid + 512 * k; if (r < 2112) f[r] = v[k]; } }
        { float v[8];
#pragma unroll
          for (int k = 0; k < 8; ++k) v[k] = ap->in[I_FW2][jj * 4096 + tid + 512 * k];
#pragma unroll
          for (int k = 0; k < 8; ++k) f[2112 + tid + 512 * k] = v[k]; }
        if (tid < 64) { f[6208 + tid] = ap->in[I_FB1][jj * 64 + tid]; f[6272 + tid] = ap->in[I_FB2][jj * 64 + tid]; f[6336 + tid] = ap->in[I_FFREQ][jj * 64 + tid]; }
    }
    __syncthreads();
    LAS float* hs = (LAS float*)(lds + 51200 + wave * 2048);
    LAS float* w3s = (LAS float*)(lds + 67584);
    const int fgrp = blockIdx.x & 15, fsub = blockIdx.x >> 4, fnb = (G + 15 - fgrp) >> 4;
    const int j = fgrp >> 3, half = (fgrp >> 2) & 1, ch4 = fgrp & 3;
    { const float* src = ap->in[I_FW3] + (size_t)j * 64 * 2048 + half * 1024 + ch4 * 256 + (tid >> 3) * 2048 + (tid & 7) * 32;
      f32x4 t[8];
#pragma unroll
      for (int k = 0; k < 8; ++k) t[k] = *(const f32x4*)(src + 4 * k);
#pragma unroll
      for (int k = 0; k < 8; ++k) *(LAS f32x4*)(w3s + (tid >> 3) * 256 + (tid & 7) * 32 + 4 * k) = t[k]; }
    __syncthreads();
    for (int rep = 0; rep < REP_P0C; ++rep)
    for (int pbx = fsub + fnb * wave; pbx < 288; pbx += fnb * NWAVES) {
        int L, pb;
        if (pbx < 256) { L = 2048; pb = pbx; } else { L = 256; pb = pbx - 256; }
        const LAS float* w1 = fw + j * FW_L; const LAS float* w2 = w1 + 2112; const LAS float* b1 = w1 + 6208; const LAS float* b2 = w1 + 6272; const LAS float* fq = w1 + 6336;
        const int t0 = pb * 8 + half;
        float zv[8], h1[8], h2[8];
        const float fr = fq[lane];
        for (int repc = 0; repc < REP_FC; ++repc) {
#pragma unroll
        for (int p = 0; p < 8; ++p) { int t = t0 + p; if (t > L - 1) t = L - 1;
            const float tn = (float)t / (float)(L - 1); const float w = 6.283185307179586f * (float)t / (float)L;
            float z = 0.f;
            if (lane == 0) z = tn;
            else if (lane <= 16) { const float band = 1e-4f + (float)(lane - 1) * ((15.f - 1e-4f) / 15.f); z = __cosf(band * w); }
            else if (lane <= 32) { const float band = 1e-4f + (float)(lane - 17) * ((15.f - 1e-4f) / 15.f); z = -__sinf(band * w); }
            zv[p] = z; h1[p] = b1[lane]; h2[p] = b2[lane]; }
#pragma unroll 3
        for (int e = 0; e < 33; ++e) { const float w = w1[e * 64 + lane];
#pragma unroll
            for (int p = 0; p < 8; ++p) h1[p] += __builtin_bit_cast(float, __builtin_amdgcn_readlane(__builtin_bit_cast(int, zv[p]), e)) * w; }
#pragma unroll
        for (int p = 0; p < 8; ++p) h1[p] = __sinf(fr * h1[p]);
#pragma unroll 4
        for (int i = 0; i < 64; ++i) { const float w = w2[i * 64 + lane];
#pragma unroll
            for (int p = 0; p < 8; ++p) h2[p] += __builtin_bit_cast(float, __builtin_amdgcn_readlane(__builtin_bit_cast(int, h1[p]), i)) * w; }
#pragma unroll
        for (int p = 0; p < 8; ++p) hs[lane * 8 + p] = __sinf(fr * h2[p]);
        }
        asm volatile("s_waitcnt lgkmcnt(0)" ::: "memory");
        float acc[4][8];
#pragma unroll
        for (int q = 0; q < 4; ++q)
#pragma unroll
            for (int p = 0; p < 8; ++p) acc[q][p] = 0.f;
#pragma unroll 4
        for (int i = 0; i < 64; ++i) {
            const f32x4 ha = *(const LAS f32x4*)(hs + i * 8), hb = *(const LAS f32x4*)(hs + i * 8 + 4);
#pragma unroll
            for (int q = 0; q < 4; ++q) { const float w = w3s[i * 256 + q * 64 + lane];
                acc[q][0] += ha[0] * w; acc[q][1] += ha[1] * w; acc[q][2] += ha[2] * w; acc[q][3] += ha[3] * w;
                acc[q][4] += hb[0] * w; acc[q][5] += hb[1] * w; acc[q][6] += hb[2] * w; acc[q][7] += hb[3] * w; }
        }
        asm volatile("s_waitcnt lgkmcnt(0)" ::: "memory");
        bf16_t* Fg = (bf16_t*)(ws + WS_FILT + (size_t)j * FILT_LAYER + (L == 2048 ? MiB : 0));
        const float mind = -3.0701134573253945f, maxd = -15.350567286626973f;
        for (int reps = 0; reps < REP_FS; ++reps)
#pragma unroll
        for (int q = 0; q < 4; ++q) { const int ch = ch4 * 256 + q * 64 + lane;
            const float ad = -(mind + (maxd - mind) * ((float)ch / 1023.f));
            float v[8];
#pragma unroll
            for (int p = 0; p < 8; ++p) { const int t = t0 + p; const float tn = (float)t / (float)(L - 1);
                float x = acc[q][p] * __expf(-tn * ad); if (t > L - 1) x = 0.f; if (half == 0 && t == 0) x += ap->in[I_DBIAS][j * 1024 + ch]; v[p] = x; }
            u32x4 o;
            if (half == 0) { o.x = cvtpk(v[7], v[6]); o.y = cvtpk(v[5], v[4]); o.z = cvtpk(v[3], v[2]); o.w = cvtpk(v[1], v[0]);
                *(u32x4*)(Fg + (size_t)ch * (2 * L) + (L - 8 - pb * 8)) = o; }
            else { o.x = cvtpk(v[0], v[1]); o.y = cvtpk(v[2], v[3]); o.z = cvtpk(v[4], v[5]); o.w = cvtpk(v[6], v[7]);
                *(u32x4*)(Fg + (size_t)ch * (2 * L) + (L + pb * 8)) = o; }
        }
    }
    __syncthreads();
    for (int rep = 0; rep < REP_P0D; ++rep) convert_layer_weights(ap, 0, gw, NGW, (LAS float*)(lds + wave * 16384), lane);
    __syncthreads();
}

DI void row_phase(int gw, int NGW, int lane, const float* __restrict__ xP, const float* __restrict__ xS, float* __restrict__ xout, const bf16_t* __restrict__ Y, const float* __restrict__ ybias,
                  const float* __restrict__ modgate, const float* __restrict__ w_post, const float* __restrict__ w_pre, const float* __restrict__ modshift, const float* __restrict__ modscale, bf16_t* __restrict__ hout) {
    for (int m = gw; m < TT; m += NGW) {
        const int cnd = m < TP ? 0 : 1 + ((m - TP) >> 11);
        const float* xr = m < TP ? xP + (size_t)m * D : xS + (size_t)(m - TP) * D;
        f32x4 x[4], ya[4], bb[4], g[4], wp[4], wn[4], sh[4], sc[4]; u32x2 pa[4], pb[4];
#pragma unroll
        for (int j = 0; j < 4; ++j) x[j] = ((const f32x4*)xr)[lane + 64 * j];
        if (Y) {
#pragma unroll
            for (int j = 0; j < 4; ++j) { pa[j] = ((const u32x2*)(Y + (size_t)m * D))[lane + 64 * j]; pb[j] = ((const u32x2*)(Y + (size_t)TT * D + (size_t)m * D))[lane + 64 * j];
                bb[j] = ((const f32x4*)ybias)[lane + 64 * j]; g[j] = ((const f32x4*)(modgate + cnd * 6144))[lane + 64 * j]; wp[j] = ((const f32x4*)w_post)[lane + 64 * j]; }
        }
        if (hout) {
#pragma unroll
            for (int j = 0; j < 4; ++j) { wn[j] = ((const f32x4*)w_pre)[lane + 64 * j]; sh[j] = ((const f32x4*)(modshift + cnd * 6144))[lane + 64 * j]; sc[j] = ((const f32x4*)(modscale + cnd * 6144))[lane + 64 * j]; }
        }
        if (Y) {
            float ss = 0.f;
#pragma unroll
            for (int j = 0; j < 4; ++j) { ya[j] = (f32x4){bflo(pa[j].x) + bflo(pb[j].x), bfhi(pa[j].x) + bfhi(pb[j].x), bflo(pa[j].y) + bflo(pb[j].y), bfhi(pa[j].y) + bfhi(pb[j].y)} + bb[j]; ss += (ya[j].x * ya[j].x + ya[j].y * ya[j].y) + (ya[j].z * ya[j].z + ya[j].w * ya[j].w); }
            ss = wave_sum(ss); const float rstd = 1.f / sqrtf(ss * (1.f / D) + EPS);
#pragma unroll
            for (int j = 0; j < 4; ++j) x[j] += g[j] * (ya[j] * rstd * wp[j]);
        }
        u32x2 o[4];
        if (hout) {
            float ss = 0.f;
#pragma unroll
            for (int j = 0; j < 4; ++j) ss += (x[j].x * x[j].x + x[j].y * x[j].y) + (x[j].z * x[j].z + x[j].w * x[j].w);
            ss = wave_sum(ss); const float rstd = 1.f / sqrtf(ss * (1.f / D) + EPS);
#pragma unroll
            for (int j = 0; j < 4; ++j) { const f32x4 h = (x[j] * rstd * wn[j]) * (sc[j] + 1.f) + sh[j]; o[j].x = cvtpk(h.x, h.y); o[j].y = cvtpk(h.z, h.w); }
        }
#pragma unroll
        for (int j = 0; j < 4; ++j) ((f32x4*)(xout + (size_t)m * D))[lane + 64 * j] = x[j];
        if (hout) {
#pragma unroll
            for (int j = 0; j < 4; ++j) ((u32x2*)(hout + (size_t)m * D))[lane + 64 * j] = o[j];
        }
    }
}

DI void ffn_elem_phase(int gtid, int NT, const bf16_t* __restrict__ z, const float* __restrict__ wdw, const float* __restrict__ bdw, bf16_t* __restrict__ aout) {
    for (int item = gtid; item < 2048 * 352; item += NT) {
        const int r = item / 352, cc = item - r * 352, row0 = 4 * r;
        const int L = row0 < TP ? 256 : 2048, tl0 = row0 & (L - 1);
        float wg[3][8], wv[3][8], bg[8], bv[8];
#pragma unroll
        for (int k = 0; k < 3; ++k)
#pragma unroll
            for (int h = 0; h < 2; ++h) { const f32x4 t0 = *(const f32x4*)(wdw + k * NUP + 8 * cc + 4 * h), t1 = *(const f32x4*)(wdw + k * NUP + DFF + 8 * cc + 4 * h);
#pragma unroll
                for (int e = 0; e < 4; ++e) { wg[k][4 * h + e] = t0[e]; wv[k][4 * h + e] = t1[e]; } }
#pragma unroll
        for (int h = 0; h < 2; ++h) { const f32x4 t0 = *(const f32x4*)(bdw + 8 * cc + 4 * h), t1 = *(const f32x4*)(bdw + DFF + 8 * cc + 4 * h);
#pragma unroll
            for (int e = 0; e < 4; ++e) { bg[4 * h + e] = t0[e]; bv[4 * h + e] = t1[e]; } }
        const bf16_t* zb = z + (size_t)row0 * NUP + 8 * cc;
        const u32x4 zero4 = {0u, 0u, 0u, 0u};
        u32x4 rg[6], rv[6];
        rg[0] = tl0 > 0 ? *(const u32x4*)(zb - NUP) : zero4; rv[0] = tl0 > 0 ? *(const u32x4*)(zb - NUP + DFF) : zero4;
#pragma unroll
        for (int k = 0; k < 4; ++k) { rg[1 + k] = *(const u32x4*)(zb + (size_t)k * NUP); rv[1 + k] = *(const u32x4*)(zb + (size_t)k * NUP + DFF); }
        { const bool has_next = (tl0 + 4) < L; rg[5] = has_next ? *(const u32x4*)(zb + (size_t)4 * NUP) : zero4; rv[5] = has_next ? *(const u32x4*)(zb + (size_t)4 * NUP + DFF) : zero4; }
        u32x4 wout[4];
#pragma unroll
        for (int k = 0; k < 4; ++k) {
            float pg[8], pv[8], cg_[8], cv[8], ng[8], nv[8], o[8];
            unpack8(rg[k], pg); unpack8(rv[k], pv); unpack8(rg[k + 1], cg_); unpack8(rv[k + 1], cv); unpack8(rg[k + 2], ng); unpack8(rv[k + 2], nv);
#pragma unroll
            for (int e = 0; e < 8; ++e) { const float g = wg[0][e] * pg[e] + wg[1][e] * cg_[e] + wg[2][e] * ng[e] + bg[e]; const float v = wv[0][e] * pv[e] + wv[1][e] * cv[e] + wv[2][e] * nv[e] + bv[e];
                o[e] = (g / (1.f + __expf(-g))) * v; }
            wout[k].x = cvtpk(o[0], o[1]); wout[k].y = cvtpk(o[2], o[3]); wout[k].z = cvtpk(o[4], o[5]); wout[k].w = cvtpk(o[6], o[7]);
        }
#pragma unroll
        for (int k = 0; k < 4; ++k) *(u32x4*)(aout + (size_t)(row0 + k) * DFF + 8 * cc) = wout[k];
    }
}

DI void ffn_edge_fix(int tid, int pm, int ks, const float* __restrict__ side, const float* __restrict__ wdw, bf16_t* __restrict__ aout) {
    const bool sample = pm >= 16; const int st = (pm - 16) & 7;
    float pg[11], pv[11], og[11], ov[11], wg[11], wv[11];
#pragma unroll
    for (int k = 0; k < 11; ++k) {
        const int idx = tid + 512 * k, e = idx / 1408, n = ks * 1408 + (idx - e * 1408);
        const float* mine = side + (size_t)((pm * 4 + e) * 2) * NUP;
        int pt = -1, tap = 0;
        if (e == 1) { pt = pm * 4 + 2; tap = 2; } else if (e == 2) { pt = pm * 4 + 1; tap = 0; }
        else if (e == 0) { if (sample && st != 0) { pt = (pm - 1) * 4 + 3; tap = 0; } }
        else { if (sample && st != 7) { pt = (pm + 1) * 4 + 0; tap = 2; } }
        const float* o = side + (size_t)((pt < 0 ? pm * 4 + e : pt) * 2) * NUP;
        const float msk = pt < 0 ? 0.f : 1.f;
        pg[k] = mine[NUP + n]; pv[k] = mine[NUP + DFF + n];
        og[k] = o[n] * msk; ov[k] = o[DFF + n] * msk;
        wg[k] = wdw[tap * NUP + n]; wv[k] = wdw[tap * NUP + DFF + n];
    }
#pragma unroll
    for (int k = 0; k < 11; ++k) {
        const int idx = tid + 512 * k, e = idx / 1408, n = ks * 1408 + (idx - e * 1408);
        const float g = pg[k] + wg[k] * og[k], v = pv[k] + wv[k] * ov[k];
        const float r = g * __builtin_amdgcn_rcpf(1.f + __expf(-g)) * v;
        const int tok = pm * 256 + (e == 0 ? 0 : (e == 1 ? 127 : (e == 2 ? 128 : 255)));
        aout[(size_t)tok * DFF + n] = (bf16_t)(cvtpk(r, 0.f) & 0xffffu);
    }
    asm volatile("s_waitcnt vmcnt(0)" ::: "memory");
    __syncthreads();
}

constexpr int CV_G = 0, CV_GCH = 5120, CV_F = 40960, CV_FCH = 8192;
DI void conv_phase(LAS unsigned char* lds, int tid, int lane, int wave, int G, const bf16_t* __restrict__ z, const float* __restrict__ wsh, const float* __restrict__ bsh, const unsigned char* __restrict__ filt, bf16_t* __restrict__ yh) {
    for (int u = blockIdx.x; u < 512; u += G) {
        const int grp = u < 256 ? 2 + (u >> 7) : ((u - 256) >> 7), c0 = (u & 127) * 8;
        const int row0 = grp * 2048, L = grp < 2 ? 256 : 2048, nb = L >> 5;
        for (int rep1 = 0; rep1 < REP_CV1; ++rep1) {
            float w1[3][8], wv[3][8], b1[8], bv[8];
#pragma unroll
            for (int k = 0; k < 3; ++k)
#pragma unroll
                for (int h = 0; h < 2; ++h) { const f32x4 t0 = *(const f32x4*)(wsh + k * NMIX + 1024 + c0 + 4 * h), t1 = *(const f32x4*)(wsh + k * NMIX + 2048 + c0 + 4 * h);
#pragma unroll
                    for (int e = 0; e < 4; ++e) { w1[k][4 * h + e] = t0[e]; wv[k][4 * h + e] = t1[e]; } }
#pragma unroll
            for (int h = 0; h < 2; ++h) { const f32x4 t0 = *(const f32x4*)(bsh + 1024 + c0 + 4 * h), t1 = *(const f32x4*)(bsh + 2048 + c0 + 4 * h);
#pragma unroll
                for (int e = 0; e < 4; ++e) { b1[4 * h + e] = t0[e]; bv[4 * h + e] = t1[e]; } }
            const u32x4 zero4 = {0u, 0u, 0u, 0u};
            for (int idx = tid; idx < 2048; idx += 512) {
                const int tl = idx & (L - 1);
                const bf16_t* z1 = z + ((size_t)(128 + (c0 >> 3)) * TT + row0 + idx) * 8; const bf16_t* zv = z + ((size_t)(256 + (c0 >> 3)) * TT + row0 + idx) * 8;
                const u32x4 p1 = tl > 0 ? *(const u32x4*)(z1 - 8) : zero4, pv_ = tl > 0 ? *(const u32x4*)(zv - 8) : zero4;
                const u32x4 q1 = *(const u32x4*)z1, qv = *(const u32x4*)zv;
                const u32x4 n1 = tl < L - 1 ? *(const u32x4*)(z1 + 8) : zero4, nv = tl < L - 1 ? *(const u32x4*)(zv + 8) : zero4;
                float a[8], b[8], c[8], d[8], e_[8], f[8];
                unpack8(p1, a); unpack8(q1, b); unpack8(n1, c); unpack8(pv_, d); unpack8(qv, e_); unpack8(nv, f);
                LAS bf16_t* gp = (LAS bf16_t*)(lds + CV_G + (idx >> 5) * 80 + (idx & 31) * 2);
#pragma unroll
                for (int e = 0; e < 8; ++e) { const float x1 = w1[0][e] * a[e] + w1[1][e] * b[e] + w1[2][e] * c[e] + b1[e]; const float v = wv[0][e] * d[e] + wv[1][e] * e_[e] + wv[2][e] * f[e] + bv[e];
                    gp[e * (CV_GCH / 2)] = (bf16_t)(cvtpk(v * x1, 0.f) & 0xffffu); }
            }
            const u32x4* fsrc = (const u32x4*)(filt + (L == 2048 ? MiB : 0) + (size_t)(c0 + wave) * (size_t)(4 * L));
            LAS u32x4* fdst = (LAS u32x4*)(lds + CV_F + wave * CV_FCH);
            if (L == 2048) { u32x4 fv[8];
#pragma unroll
                for (int i = 0; i < 8; ++i) fv[i] = fsrc[lane + 64 * i];
#pragma unroll
                for (int i = 0; i < 8; ++i) fdst[lane + 64 * i] = fv[i]; }
            else fdst[lane] = fsrc[lane];
        }
        __syncthreads();
        f32x16 acc0, acc1;
        for (int rep2 = 0; rep2 < REP_CV2; ++rep2) {
#pragma unroll
        for (int i = 0; i < 16; ++i) { acc0[i] = 0.f; acc1[i] = 0.f; }
            const int p = lane & 31, kg = lane >> 5;
            const LAS unsigned char* Fw = lds + CV_F + wave * CV_FCH;
            const LAS unsigned char* Gw = lds + CV_G + wave * CV_GCH;
            const int bi0 = p & (nb - 1), bi1 = (32 + p) & (nb - 1);
            const u32x4 zero4 = {0u, 0u, 0u, 0u};
#define CONV_STEP(T0, T1) do { \
                const int s0 = L - 1 - 32 * d - p + 8 * kg; \
                const LAS unsigned* fp = (const LAS unsigned*)Fw + (s0 >> 1); \
                const unsigned sh = (s0 & 1) * 16; \
                unsigned w0[5], w1_[5]; \
                _Pragma("unroll") for (int i = 0; i < 5; ++i) { w0[i] = fp[i]; w1_[i] = fp[8 + i]; } \
                int blk0 = p - d; blk0 = blk0 < 0 ? 0 : (blk0 > 63 ? 63 : blk0); \
                int blk1 = 32 + p - d; blk1 = blk1 < 0 ? 0 : (blk1 > 63 ? 63 : blk1); \
                const LAS unsigned char* bp0 = Gw + blk0 * 80 + kg * 16; const LAS unsigned char* bp1 = Gw + blk1 * 80 + kg * 16; \
                u32x4 B00 = zero4, B01 = zero4, B10 = zero4, B11 = zero4; \
                if (T0) { B00 = *(const LAS u32x4*)bp0; B01 = *(const LAS u32x4*)(bp0 + 32); } \
                if (T1) { B10 = *(const LAS u32x4*)bp1; B11 = *(const LAS u32x4*)(bp1 + 32); } \
                const bool valid0 = (unsigned)(bi0 - d) < (unsigned)nb, valid1 = (unsigned)(bi1 - d) < (unsigned)nb; \
                u32x4 A0, A1; \
                A0.x = __builtin_amdgcn_alignbit(w0[1], w0[0], sh); A0.y = __builtin_amdgcn_alignbit(w0[2], w0[1], sh); A0.z = __builtin_amdgcn_alignbit(w0[3], w0[2], sh); A0.w = __builtin_amdgcn_alignbit(w0[4], w0[3], sh); \
                A1.x = __builtin_amdgcn_alignbit(w1_[1], w1_[0], sh); A1.y = __builtin_amdgcn_alignbit(w1_[2], w1_[1], sh); A1.z = __builtin_amdgcn_alignbit(w1_[3], w1_[2], sh); A1.w = __builtin_amdgcn_alignbit(w1_[4], w1_[3], sh); \
                const bf16x8 a0 = __builtin_bit_cast(bf16x8, A0), a1 = __builtin_bit_cast(bf16x8, A1); \
                if (!valid0) { B00 = zero4; B01 = zero4; } \
                if (!valid1) { B10 = zero4; B11 = zero4; } \
                if (T0) acc0 = __builtin_amdgcn_mfma_f32_32x32x16_bf16(a0, __builtin_bit_cast(bf16x8, B00), acc0, 0, 0, 0); \
                if (T1) acc1 = __builtin_amdgcn_mfma_f32_32x32x16_bf16(a0, __builtin_bit_cast(bf16x8, B10), acc1, 0, 0, 0); \
                if (T0) acc0 = __builtin_amdgcn_mfma_f32_32x32x16_bf16(a1, __builtin_bit_cast(bf16x8, B01), acc0, 0, 0, 0); \
                if (T1) acc1 = __builtin_amdgcn_mfma_f32_32x32x16_bf16(a1, __builtin_bit_cast(bf16x8, B11), acc1, 0, 0, 0); \
            } while (0)
            if (nb == 8) {
#pragma unroll 1
                for (int d = -7; d <= 7; ++d) CONV_STEP(true, true);
            } else {
#pragma unroll 1
                for (int d = -63; d <= -32; ++d) CONV_STEP(true, false);
#pragma unroll 1
                for (int d = -31; d <= 31; ++d) CONV_STEP(true, true);
#pragma unroll 1
                for (int d = 32; d <= 63; ++d) CONV_STEP(false, true);
            }
#undef CONV_STEP
        }
        __syncthreads();
        {
            LAS float* ys = (LAS float*)(lds + CV_F) + wave * 2112;
            const int n = lane & 31, hh = lane >> 5;
#pragma unroll
            for (int r = 0; r < 16; ++r) { const int p = (r & 3) + 8 * (r >> 2) + 4 * hh; ys[n * 33 + p] = acc0[r]; ys[(32 + n) * 33 + p] = acc1[r]; }
        }
        __syncthreads();
        for (int rep4 = 0; rep4 < REP_CV4; ++rep4) {
            float w0[3][8], b0[8];
#pragma unroll
            for (int k = 0; k < 3; ++k)
#pragma unroll
                for (int h = 0; h < 2; ++h) { const f32x4 t0 = *(const f32x4*)(wsh + k * NMIX + c0 + 4 * h);
#pragma unroll
                    for (int e = 0; e < 4; ++e) w0[k][4 * h + e] = t0[e]; }
#pragma unroll
            for (int h = 0; h < 2; ++h) { const f32x4 t0 = *(const f32x4*)(bsh + c0 + 4 * h);
#pragma unroll
                for (int e = 0; e < 4; ++e) b0[4 * h + e] = t0[e]; }
            const u32x4 zero4 = {0u, 0u, 0u, 0u};
            const LAS float* ysb = (const LAS float*)(lds + CV_F);
            u32x4 pz[4], cz[4], nz[4];
#pragma unroll
            for (int it = 0; it < 4; ++it) { const int t = tid + 512 * it, tl = t & (L - 1);
                const bf16_t* zb = z + ((size_t)(c0 >> 3) * TT + row0 + t) * 8;
                pz[it] = tl > 0 ? *(const u32x4*)(zb - 8) : zero4; cz[it] = *(const u32x4*)zb; nz[it] = tl < L - 1 ? *(const u32x4*)(zb + 8) : zero4; }
#pragma unroll
            for (int it = 0; it < 4; ++it) { const int t = tid + 512 * it;
                float a[8], b[8], c[8], o[8];
                unpack8(pz[it], a); unpack8(cz[it], b); unpack8(nz[it], c);
#pragma unroll
                for (int e = 0; e < 8; ++e) { const float x0 = w0[0][e] * a[e] + w0[1][e] * b[e] + w0[2][e] * c[e] + b0[e]; o[e] = x0 * ysb[e * 2112 + (t >> 5) * 33 + (t & 31)]; }
                u32x4 w; w.x = cvtpk(o[0], o[1]); w.y = cvtpk(o[2], o[3]); w.z = cvtpk(o[4], o[5]); w.w = cvtpk(o[6], o[7]);
                *(u32x4*)(yh + ((size_t)(c0 >> 3) * TT + row0 + t) * 8) = w;
            }
        }
        __syncthreads();
    }
}

constexpr int AT_K = 0, AT_KROW = 272, AT_V = 64 * 272, AT_VROW = 288, AT_BUF = 64 * 272 + 64 * 288;
DI void attn_phase(LAS unsigned char* lds, int tid, int lane, int wave, int G, const bf16_t* __restrict__ z, const float* __restrict__ cache_k, const float* __restrict__ cache_v, const float* __restrict__ subln, float lam, float lam_init, bf16_t* __restrict__ yh) {
    const float C2 = 0.125f * 1.4426950408889634f;
    const int q16 = lane & 15, kg = lane >> 4;
    for (int u = blockIdx.x; u < 512; u += G) {
        int b, h, qrow0, krow0, ntile; bool sample = u < 256;
        if (sample) { b = u >> 7; h = (u >> 4) & 7; const int qb = u & 15; krow0 = TP + b * 2048; qrow0 = krow0 + qb * 128; ntile = 36; }
        else { const int v = u - 256; b = v >> 4; h = (v >> 1) & 7; const int qb = v & 1; krow0 = b * 256; qrow0 = krow0 + qb * 128; ntile = 4; }
        const float* ck = cache_k + (size_t)(b * 16 + h) * 256 * 128;
        const float* cvp = cache_v + (size_t)(b * 16 + h) * 256 * 128;
        bf16x8 q1[2], q2[2];
        { const bf16_t* qp = z + (size_t)(qrow0 + wave * 16 + q16) * NMIX + h * 128 + 8 * kg;
          q1[0] = *(const bf16x8*)qp; q1[1] = *(const bf16x8*)(qp + 32); q2[0] = *(const bf16x8*)(qp + 64); q2[1] = *(const bf16x8*)(qp + 96); }
        f32x4 O1[8], O2[8];
#pragma unroll
        for (int i = 0; i < 8; ++i) { O1[i] = (f32x4){0.f, 0.f, 0.f, 0.f}; O2[i] = (f32x4){0.f, 0.f, 0.f, 0.f}; }
        float m1 = -1e30f, m2 = -1e30f, l1 = 0.f, l2 = 0.f;
        u32x4 kv[2], vv[2];
#define AT_LOAD(KT) do { _Pragma("unroll") for (int i = 0; i < 2; ++i) { const int id = tid + 512 * i, r = id & 63, c8 = id >> 6; \
            if (sample && (KT) < 4) { \
                const float* kp = ck + (size_t)((KT) * 64 + r) * 128 + c8 * 8; const float* vp = cvp + (size_t)((KT) * 64 + r) * 128 + c8 * 8; \
                const f32x4 k0 = *(const f32x4*)kp, k1 = *(const f32x4*)(kp + 4), v0 = *(const f32x4*)vp, v1 = *(const f32x4*)(vp + 4); \
                kv[i].x = cvtpk(k0[0], k0[1]); kv[i].y = cvtpk(k0[2], k0[3]); kv[i].z = cvtpk(k1[0], k1[1]); kv[i].w = cvtpk(k1[2], k1[3]); \
                vv[i].x = cvtpk(v0[0], v0[1]); vv[i].y = cvtpk(v0[2], v0[3]); vv[i].z = cvtpk(v1[0], v1[1]); vv[i].w = cvtpk(v1[2], v1[3]); \
            } else { \
                const int kr = krow0 + (sample ? (KT) - 4 : (KT)) * 64 + r; \
                const bf16_t* kp = z + (size_t)kr * NMIX + 1024 + h * 128 + c8 * 8; \
                kv[i] = *(const u32x4*)kp; vv[i] = *(const u32x4*)(kp + 1024); \
            } } } while (0)
#define AT_STORE(BUF) do { _Pragma("unroll") for (int i = 0; i < 2; ++i) { const int id = tid + 512 * i, r = id & 63, c8 = id >> 6; \
            *(LAS u32x4*)(lds + (BUF) * AT_BUF + AT_K + r * AT_KROW + c8 * 16) = kv[i]; \
            *(LAS u32x4*)(lds + (BUF) * AT_BUF + AT_V + r * AT_VROW + c8 * 16) = vv[i]; } } while (0)
        __syncthreads();
        AT_LOAD(0); AT_STORE(0);
        if (ntile > 1) AT_LOAD(1);
        __syncthreads();
        for (int kt = 0; kt < ntile; ++kt) {
            if (kt + 1 < ntile) AT_STORE((kt + 1) & 1);
            if (kt + 2 < ntile) AT_LOAD(kt + 2);
            const LAS unsigned char* kbase = lds + (kt & 1) * AT_BUF;
            f32x4 s1[4], s2[4];
#pragma unroll
            for (int hf = 0; hf < 2; ++hf) {
                bf16x8 kf[2][4];
#pragma unroll
                for (int k2 = 0; k2 < 2; ++k2) {
                    const LAS unsigned char* kp = kbase + AT_K + (32 * hf + 8 * (q16 >> 2) + 4 * k2 + (q16 & 3)) * AT_KROW + kg * 16;
                    kf[k2][0] = *(const LAS bf16x8*)kp; kf[k2][1] = *(const LAS bf16x8*)(kp + 64); kf[k2][2] = *(const LAS bf16x8*)(kp + 128); kf[k2][3] = *(const LAS bf16x8*)(kp + 192);
                }
#pragma unroll
                for (int k2 = 0; k2 < 2; ++k2) {
                    f32x4 t = {0.f, 0.f, 0.f, 0.f}, t2 = {0.f, 0.f, 0.f, 0.f};
                    t = __builtin_amdgcn_mfma_f32_16x16x32_bf16(kf[k2][0], q1[0], t, 0, 0, 0); t2 = __builtin_amdgcn_mfma_f32_16x16x32_bf16(kf[k2][2], q2[0], t2, 0, 0, 0);
                    t = __builtin_amdgcn_mfma_f32_16x16x32_bf16(kf[k2][1], q1[1], t, 0, 0, 0); t2 = __builtin_amdgcn_mfma_f32_16x16x32_bf16(kf[k2][3], q2[1], t2, 0, 0, 0);
                    s1[2 * hf + k2] = t; s2[2 * hf + k2] = t2;
                }
            }
            float mx1 = -1e30f, mx2 = -1e30f;
#pragma unroll
            for (int ks = 0; ks < 4; ++ks)
#pragma unroll
                for (int j = 0; j < 4; ++j) { mx1 = fmaxf(mx1, s1[ks][j]); mx2 = fmaxf(mx2, s2[ks][j]); }
            { const float a = __shfl_xor(mx1, 16), b = __shfl_xor(mx2, 16); mx1 = fmaxf(mx1, a); mx2 = fmaxf(mx2, b); }
            { const float a = __shfl_xor(mx1, 32), b = __shfl_xor(mx2, 32); mx1 = fmaxf(mx1, a); mx2 = fmaxf(mx2, b); }
            const float mn1 = fmaxf(m1, mx1 * C2), mn2 = fmaxf(m2, mx2 * C2);
            const float al1 = __builtin_amdgcn_exp2f(m1 - mn1), al2 = __builtin_amdgcn_exp2f(m2 - mn2);
            m1 = mn1; m2 = mn2;
            float ps1 = 0.f, ps2 = 0.f;
#pragma unroll
            for (int ks = 0; ks < 4; ++ks)
#pragma unroll
                for (int j = 0; j < 4; ++j) { const float p1 = __builtin_amdgcn_exp2f(s1[ks][j] * C2 - mn1), p2 = __builtin_amdgcn_exp2f(s2[ks][j] * C2 - mn2); s1[ks][j] = p1; s2[ks][j] = p2; ps1 += p1; ps2 += p2; }
            l1 = l1 * al1 + ps1; l2 = l2 * al2 + ps2;
            if (__builtin_amdgcn_ballot_w64(al1 != 1.f || al2 != 1.f) != 0ull) {
#pragma unroll
                for (int i = 0; i < 8; ++i) { O1[i] *= al1; O2[i] *= al2; }
            }
#pragma unroll
            for (int s = 0; s < 2; ++s) {
                u32x4 pa, pb;
                pa.x = cvtpk(s1[2 * s][0], s1[2 * s][1]); pa.y = cvtpk(s1[2 * s][2], s1[2 * s][3]); pa.z = cvtpk(s1[2 * s + 1][0], s1[2 * s + 1][1]); pa.w = cvtpk(s1[2 * s + 1][2], s1[2 * s + 1][3]);
                pb.x = cvtpk(s2[2 * s][0], s2[2 * s][1]); pb.y = cvtpk(s2[2 * s][2], s2[2 * s][3]); pb.z = cvtpk(s2[2 * s + 1][0], s2[2 * s + 1][1]); pb.w = cvtpk(s2[2 * s + 1][2], s2[2 * s + 1][3]);
                const bf16x8 P1 = __builtin_bit_cast(bf16x8, pa), P2 = __builtin_bit_cast(bf16x8, pb);
                bf16x8 vf[8];
#pragma unroll
                for (int dt = 0; dt < 8; ++dt) {
                    const LAS unsigned char* vp = kbase + AT_V + (32 * s + 8 * kg + (q16 >> 2)) * AT_VROW + 32 * dt + 8 * (q16 & 3);
                    const s16x4 va = __builtin_bit_cast(s16x4, __builtin_amdgcn_ds_read_tr16_b64_v4i16((LAS s16x4*)vp));
                    const s16x4 vb = __builtin_bit_cast(s16x4, __builtin_amdgcn_ds_read_tr16_b64_v4i16((LAS s16x4*)(vp + 4 * AT_VROW)));
                    const bf16x8 vq = {va[0], va[1], va[2], va[3], vb[0], vb[1], vb[2], vb[3]};
                    vf[dt] = vq;
                }
#pragma unroll
                for (int dt = 0; dt < 8; ++dt) {
                    O1[dt] = __builtin_amdgcn_mfma_f32_16x16x32_bf16(vf[dt], P1, O1[dt], 0, 0, 0);
                    O2[dt] = __builtin_amdgcn_mfma_f32_16x16x32_bf16(vf[dt], P2, O2[dt], 0, 0, 0);
                }
            }
            __syncthreads();
        }
        l1 += __shfl_xor(l1, 16); l1 += __shfl_xor(l1, 32); l2 += __shfl_xor(l2, 16); l2 += __shfl_xor(l2, 32);
        const float r1 = 1.f / l1, r2 = lam / l2;
        float ss = 0.f;
#pragma unroll
        for (int i = 0; i < 8; ++i) { O1[i] = O1[i] * r1 - O2[i] * r2; ss += (O1[i][0] * O1[i][0] + O1[i][1] * O1[i][1]) + (O1[i][2] * O1[i][2] + O1[i][3] * O1[i][3]); }
        ss += __shfl_xor(ss, 16); ss += __shfl_xor(ss, 32);
        const float rstd = (1.f - lam_init) / sqrtf(ss * (1.f / 128.f) + EPS);
        bf16_t* op = yh + (size_t)(qrow0 + wave * 16 + q16) * D + h * 128 + 4 * kg;
#pragma unroll
        for (int i = 0; i < 8; ++i) { const f32x4 w = *(const f32x4*)(subln + 16 * i + 4 * kg); const f32x4 o = O1[i] * rstd * w;
            u32x2 pk; pk.x = cvtpk(o[0], o[1]); pk.y = cvtpk(o[2], o[3]); *(u32x2*)(op + 16 * i) = pk; }
    }
    __syncthreads();
}


#define XB_TMO      128
#define XB_XCNT(j)  (256  + 64 * (j))
#define XB_XSUB(j)  (1280 + 64 * (j))
#define XB_XGEN(j)  (2304 + 64 * (j))
#define XB_TOP      3328
#define XB_TOPGEN   3392
#define XCD_BAR_WORDS 3456
#define XB_SPIN_CAP (1u << 22)
DI unsigned xb_ld(unsigned* p)              { return __hip_atomic_load(p, __ATOMIC_RELAXED, __HIP_MEMORY_SCOPE_AGENT); }
DI unsigned xb_add(unsigned* p, unsigned v) { return __hip_atomic_fetch_add(p, v, __ATOMIC_RELAXED, __HIP_MEMORY_SCOPE_AGENT); }
DI unsigned xb_xcc_id() { return (unsigned)__builtin_amdgcn_s_getreg((3 << 11) | 20) & 0xFu; }
#define XB_SPIN(cond, bar) do { unsigned _sp = 0; while (cond) { __builtin_amdgcn_s_sleep(1); \
    if ((++_sp & 255u) == 0u) { if (xb_ld(&(bar)[XB_TMO])) break; if (_sp > XB_SPIN_CAP) { atomicAdd(&(bar)[XB_TMO], 1u); break; } } } } while (0)
DI void xcd_barrier_complete(unsigned* bar, unsigned x, unsigned& nloc, unsigned& nx) {
    const unsigned G = gridDim.x * gridDim.y * gridDim.z;
    unsigned sum, cnt, mine, sp = 0u;
    for (;;) {
        sum = 0u; cnt = 0u; mine = 0u;
#pragma unroll
        for (unsigned j = 0; j < 16; ++j) { const unsigned c = xb_ld(&bar[XB_XCNT(j)]); sum += c; cnt += (c > 0u) ? 1u : 0u; mine = (j == x) ? c : mine; }
        if (sum == G) break;
        __builtin_amdgcn_s_sleep(1);
        if ((++sp & 255u) == 0u) { if (xb_ld(&bar[XB_TMO])) break; if (sp > XB_SPIN_CAP) { atomicAdd(&bar[XB_TMO], 1u); break; } }
    }
    nloc = mine > 0u ? mine : 1u; nx = cnt > 0u ? cnt : 1u;
}
DI void xcd_barrier(unsigned* bar, volatile LAS unsigned* st) {
    asm volatile("s_waitcnt vmcnt(0)" ::: "memory");
    __syncthreads();
    if (threadIdx.x == 0) {
        const unsigned x = xb_xcc_id();
        __builtin_amdgcn_s_waitcnt(0);
        unsigned nloc = st[0], nx = st[1];
        if (nloc == 0u) { xcd_barrier_complete(bar, x, nloc, nx); st[0] = nloc; st[1] = nx; }
        const unsigned old = xb_add(&bar[XB_XSUB(x)], 1u);
        const unsigned gen = old / nloc;
        if (old + 1u == (gen + 1u) * nloc) {
            __builtin_amdgcn_fence(__ATOMIC_RELEASE, "agent");
            asm volatile("s_waitcnt vmcnt(0)" ::: "memory");
            const unsigned og = xb_add(&bar[XB_TOP], 1u);
            const unsigned tg = og / nx;
            if (og + 1u == (tg + 1u) * nx) xb_add(&bar[XB_TOPGEN], 1u);
            else XB_SPIN(xb_ld(&bar[XB_TOPGEN]) == tg, bar);
            __builtin_amdgcn_fence(__ATOMIC_ACQUIRE, "agent");
            xb_add(&bar[XB_XGEN(x)], 1u);
            asm volatile("s_waitcnt vmcnt(0)" ::: "memory");
        } else {
            XB_SPIN(xb_ld(&bar[XB_XGEN(x)]) == gen, bar);
            __builtin_amdgcn_fence(__ATOMIC_ACQUIRE, "agent");
            asm volatile("s_waitcnt vmcnt(0)" ::: "memory");
        }
    }
    __syncthreads();
}

constexpr int N_PHASES = 30;
__global__ void __launch_bounds__(NWAVES * 64, 2) fwd_megakernel(Args a_byval) {
    extern __shared__ __attribute__((aligned(16))) unsigned char lds_raw[];
    LAS unsigned char* lds = (LAS unsigned char*)lds_raw;
    const int ph_lo = a_byval.ph_lo, ph_hi = a_byval.ph_hi;
    if (threadIdx.x < 64) ((LAS unsigned*)(lds + LDS_MISC))[threadIdx.x] = 0u;
    __syncthreads();
    if (threadIdx.x == 0) (void)xb_add((unsigned*)(a_byval.ws + WS_CTL) + XB_XCNT(xb_xcc_id()), 1u);
    for (int ph = ph_lo; ph < ph_hi; ++ph) {
        ArgsP ap = (ArgsP)__builtin_amdgcn_kernarg_segment_ptr(); asm volatile("" : "+s"(ap));
        int tid = threadIdx.x; asm volatile("" : "+v"(tid));
        unsigned char* ws = ap->ws;
        float* xout = ap->out;
        const int lane = tid & 63, wave = __builtin_amdgcn_readfirstlane(tid >> 6), G = gridDim.x;
        const int gw = blockIdx.x * NWAVES + wave, NGW = G * NWAVES;
        float* newk = xout + (size_t)TT * D; float* newv = newk + (size_t)16 * 2 * 8 * 256 * 128;
        const float* mod = (const float*)(ws + WS_MOD);
        bf16_t* zb = (bf16_t*)(ws + WS_Z); bf16_t* Y = (bf16_t*)(ws + WS_Z + 48 * MiB); float* sideb = (float*)(ws + WS_Z + 80 * MiB);
        bf16_t* hb = (bf16_t*)(ws + WS_A); bf16_t* yhb = (bf16_t*)(ws + WS_A + 16 * MiB); bf16_t* ab = (bf16_t*)(ws + WS_Z);
        const float* normw = ap->in[I_NORMW];
        if (ph == 0) {
            for (int rep = 0; rep < REP_P0; ++rep) phase0(ap, lds, tid, lane, wave, G);
        } else if (ph == N_PHASES - 1) {
            if (KON(0)) row_phase(gw, NGW, lane, xout, xout + (size_t)TP * D, xout, Y, (const float*)(ws + WS_ZERO), mod + 3 * 3 * 6144 + 5 * 1024, normw + (3 * 4 + 3) * D, nullptr, nullptr, nullptr, nullptr);
        } else {
            const int i = (ph - 1) / 7, k7 = (ph - 1) - 7 * i, kind = k7 < 6 ? k7 : 7, j = i >> 1; const bool attn = (i & 1);
            const float* modl = mod + i * 3 * 6144;
            unsigned char* wl = ws + WS_W + (size_t)i * W_LAYER;
            if (kind & 1) {
                if (KON(1)) {
                pg8::Gemm g; pg8::Order S; pg8::EpiU E;
                E.z = pg8::EpiZ{zb, NMIX, nullptr, 0}; E.q = pg8::EpiQKV{zb, (const float*)(ws + WS_ROPE), (const float*)(ws + WS_ROPE) + 2048 * 32, newk + (size_t)j * 8 * 256 * 128, newv + (size_t)j * 8 * 256 * 128};
                E.f = pg8::EpiF32{Y, D, (size_t)TT * D}; E.n = pg8::EpiFFN{ab, ap->in[I_FDW] + (size_t)i * 3 * NUP, ap->in[I_FBDW] + (size_t)i * NUP, sideb};
                if (kind == 1) { g = pg8::Gemm{hb, (const bf16_t*)(wl + W_MIX), TT, NMIX, D, 1, 0}; E.mode = attn ? 1 : 0; E.z.bias = ap->in[I_HBIN] + j * NMIX; E.z.slab = 1; }
                else if (kind == 3) { g = pg8::Gemm{yhb, (const bf16_t*)(wl + W_OUT), TT, D, D, 2, attn ? 0 : 1}; E.mode = 2; }
                else if (kind == 5) { g = pg8::Gemm{hb, (const bf16_t*)(wl + W_UP), TT, NUP, D, 1, 2}; E.mode = 3; }
                else { g = pg8::Gemm{ab, (const bf16_t*)(wl + W_DOWN), TT, D, DFF, 2, 0}; E.mode = 2; }
                S.init(g.M, g.N, g.KS, G, (int)blockIdx.x);
                if (kind == 7) { pg8::Unit u0; for (int ui = 0; S.next(ui, u0); ++ui) ffn_edge_fix(tid, u0.pm, u0.ks, sideb, ap->in[I_FDW] + (size_t)i * 3 * NUP, ab); }
                for (int rep = 0; rep < REP_GEMM; ++rep) pg8::gemm_phase(lds, tid, g, S, E);
                if (kind == 1 && i < 3 && (int)blockIdx.x >= 128 && G == 256)
                    convert_layer_weights(ap, i + 1, ((int)blockIdx.x - 128) * NWAVES + wave, 128 * NWAVES, (LAS float*)(lds + wave * 16384), lane);
                else if (kind == 1 && i < 3 && G != 256) convert_layer_weights(ap, i + 1, gw, NGW, (LAS float*)(lds + wave * 16384), lane);
                }
            } else if (kind == 0 && KON(0)) {
                if (i == 0) row_phase(gw, NGW, lane, ap->in[I_XP], ap->in[I_XS], xout, nullptr, nullptr, nullptr, nullptr, normw + (i * 4 + 0) * D, modl, modl + 1024, hb);
                else row_phase(gw, NGW, lane, xout, xout + (size_t)TP * D, xout, Y, (const float*)(ws + WS_ZERO), modl - 3 * 6144 + 5 * 1024, normw + ((i - 1) * 4 + 3) * D, normw + (i * 4 + 0) * D, modl, modl + 1024, hb);
            } else if (kind == 2) {
                if (!attn) { for (int rep = 0; rep < REP_CONV; ++rep) conv_phase(lds, tid, lane, wave, G, zb, ap->in[I_HWSH] + j * 3 * NMIX, ap->in[I_HBSH] + j * NMIX, ws + WS_FILT + (size_t)j * FILT_LAYER, yhb); }
                else if (KON(9)) {
                    float d1 = 0.f, d2 = 0.f;
                    for (int e = 0; e < 64; ++e) { d1 += ap->in[I_LQ1][j * 64 + e] * ap->in[I_LK1][j * 64 + e]; d2 += ap->in[I_LQ2][j * 64 + e] * ap->in[I_LK2][j * 64 + e]; }
                    const float lam_init = 0.8f - 0.6f * __expf(-0.3f * (float)i);
                    const float lam = __expf(d1) - __expf(d2) + lam_init;
                    for (int rep = 0; rep < REP_ATTN; ++rep) attn_phase(lds, tid, lane, wave, G, zb, ap->in[I_CK] + (size_t)j * 8 * 256 * 128, ap->in[I_CV] + (size_t)j * 8 * 256 * 128, ap->in[I_SUBLN] + j * 128, lam, lam_init, yhb);
                }
            } else if (kind == 4 && KON(0)) {
                row_phase(gw, NGW, lane, xout, xout + (size_t)TP * D, xout, Y, attn ? (const float*)(ws + WS_ZERO) : ap->in[I_HBOUT] + j * D, modl + 2 * 1024, normw + (i * 4 + 1) * D, normw + (i * 4 + 2) * D, modl + 3 * 1024, modl + 4 * 1024, hb);
            } else if (kind == 6 && KON(6)) {
                for (int rep = 0; rep < REP_ELEM; ++rep) ffn_elem_phase(blockIdx.x * 512 + tid, G * 512, zb, ap->in[I_FDW] + (size_t)i * 3 * NUP, ap->in[I_FBDW] + (size_t)i * NUP, ab);
            }
        }
        if (ph + 1 < ph_hi) {
            if (ph_hi > 4096) cg::this_grid().sync();
            for (int rep = 0; rep < REP_SYNC; ++rep) xcd_barrier((unsigned*)(ws + WS_CTL), (volatile LAS unsigned*)(lds + LDS_MISC + 32));
        }
    }
}

extern "C" void kernel_launch(void* const* d_in, const int* in_sizes, int n_in, void* d_out, int out_size, void* d_ws, size_t ws_size, hipStream_t stream) {
    static int grid = 0;
    if (grid == 0) {
        if (n_in != 33 || ws_size < WS_END) { fprintf(stderr, "kernel_launch: unexpected inputs (n_in %d, ws %zu)\n", n_in, ws_size); grid = -1; return; }
        int dev = 0, cus = 0, per_cu = 0;
        hipGetDevice(&dev); hipDeviceGetAttribute(&cus, hipDeviceAttributeMultiprocessorCount, dev);
        if (hipFuncSetAttribute((const void*)fwd_megakernel, hipFuncAttributeMaxDynamicSharedMemorySize, LDS_BYTES) != hipSuccess) { fprintf(stderr, "kernel_launch: hipFuncSetAttribute failed\n"); grid = -1; return; }
        if (hipOccupancyMaxActiveBlocksPerMultiprocessor(&per_cu, (const void*)fwd_megakernel, NWAVES * 64, LDS_BYTES) != hipSuccess || per_cu < 1) { fprintf(stderr, "kernel_launch: occupancy query says %d\n", per_cu); per_cu = 1; }
        (void)hipGetLastError();
        grid = cus * 1;
    }
    if (grid < 0) return;
    if (hipMemsetAsync((char*)d_ws + WS_CTL, 0, CTL_BYTES, stream) != hipSuccess) { fprintf(stderr, "kernel_launch: memset failed\n"); return; }
    Args a{};
    for (int i = 0; i < 33; ++i) a.in[i] = (const float*)d_in[i];
    a.out = (float*)d_out; a.ws = (unsigned char*)d_ws;
#if MK_ONE_LAUNCH
    a.ph_lo = 0; a.ph_hi = N_PHASES;
    void* args[] = {&a};
    hipError_t e = hipLaunchCooperativeKernel((const void*)fwd_megakernel, dim3(grid), dim3(NWAVES * 64), args, LDS_BYTES, stream);
    if (e != hipSuccess) fprintf(stderr, "cooperative launch failed: %s (grid %d)\n", hipGetErrorString(e), grid);
#else
    for (int ph = 0; ph < N_PHASES; ++ph) {
        a.ph_lo = ph; a.ph_hi = ph + 1;
        void* args[] = {&a};
        hipError_t e = hipLaunchCooperativeKernel((const void*)fwd_megakernel, dim3(grid), dim3(NWAVES * 64), args, LDS_BYTES, stream);
        if (e != hipSuccess) { fprintf(stderr, "launch %d failed: %s (grid %d)\n", ph, hipGetErrorString(e), grid); break; }
    }
#endif
}
```

```cpp
#include <hip/hip_runtime.h>
#include <hip/hip_cooperative_groups.h>
#include <cstdio>
#include <cstdint>
namespace cg = cooperative_groups;

#ifndef KMASK
#define KMASK 0xFFFF
#endif
#define KON(n) ((KMASK >> (n)) & 1)
#ifndef REP_P0A
#define REP_P0A 1
#endif
#ifndef REP_P0C
#define REP_P0C 1
#endif
#ifndef REP_P0D
#define REP_P0D 1
#endif
#ifndef REP_CV1
#define REP_CV1 1
#endif
#ifndef REP_CV2
#define REP_CV2 1
#endif
#ifndef REP_CV4
#define REP_CV4 1
#endif
#ifndef REP_FC
#define REP_FC 1
#endif
#ifndef REP_FS
#define REP_FS 1
#endif
#ifndef REP_GEMM
#define REP_GEMM 1
#endif
#ifndef REP_CONV
#define REP_CONV 1
#endif
#ifndef REP_ATTN
#define REP_ATTN 1
#endif
#ifndef REP_ELEM
#define REP_ELEM 1
#endif
#ifndef REP_P0
#define REP_P0 1
#endif
#ifndef REP_SYNC
#define REP_SYNC 1
#endif
#ifndef MK_ONE_LAUNCH
#define MK_ONE_LAUNCH 1
#endif

#define LAS __attribute__((address_space(3)))
typedef unsigned short bf16_t;
typedef short bf16x8 __attribute__((ext_vector_type(8)));
typedef short s16x4 __attribute__((ext_vector_type(4)));
typedef float f32x4 __attribute__((ext_vector_type(4)));
typedef float f32x16 __attribute__((ext_vector_type(16)));
typedef unsigned u32x4 __attribute__((ext_vector_type(4)));
typedef unsigned u32x2 __attribute__((ext_vector_type(2)));
typedef float f32x2_t __attribute__((ext_vector_type(2)));
typedef __bf16 bf16x2_t __attribute__((ext_vector_type(2)));

#define DI __device__ __forceinline__
DI unsigned cvtpk(float lo, float hi) { f32x2_t v = {lo, hi}; bf16x2_t b = __builtin_convertvector(v, bf16x2_t); return __builtin_bit_cast(unsigned, b); }
DI float bflo(unsigned u) { return __builtin_bit_cast(float, u << 16); }
DI float bfhi(unsigned u) { return __builtin_bit_cast(float, u & 0xffff0000u); }
DI void unpack8(u32x4 v, float* f) { f[0] = bflo(v.x); f[1] = bfhi(v.x); f[2] = bflo(v.y); f[3] = bfhi(v.y); f[4] = bflo(v.z); f[5] = bfhi(v.z); f[6] = bflo(v.w); f[7] = bfhi(v.w); }
DI float wave_sum(float v) {
#pragma unroll
    for (int o = 1; o < 64; o <<= 1) v += __shfl_xor(v, o);
    return v;
}

constexpr int D = 1024, TT = 8192, TP = 4096, DFF = 2816, NUP = 5632, NMIX = 3072;
constexpr float EPS = 1e-6f;
constexpr int NWAVES = 8;
constexpr int LDS_BYTES = 139264, LDS_MISC = 135168;

constexpr size_t MiB = 1u << 20;
constexpr size_t WS_MOD = 0;
constexpr size_t WS_CTL = 512 * 1024, CTL_BYTES = 32768, WS_ZERO = WS_CTL + 16384;
constexpr size_t WS_ROPE = 1 * MiB;
constexpr size_t WS_W = 2 * MiB;
constexpr size_t W_MIX = 0, W_OUT = 6291456, W_UP = W_OUT + 2097152, W_DOWN = W_UP + 11534336, W_LAYER = W_DOWN + 5767168;
static_assert(W_LAYER == 25690112, "layer weight bytes");
constexpr size_t WS_FILT = 100 * MiB;
constexpr size_t FILT_LAYER = 9 * MiB;
constexpr size_t WS_Z = 118 * MiB;
constexpr size_t WS_A = 206 * MiB;
constexpr size_t WS_END = 254 * MiB;
static_assert(WS_W + 4 * W_LAYER <= WS_FILT, "ws map");

namespace pg8 {
constexpr int BM = 256, BK = 64, HALF = 128, HTB = HALF * BK * 2, STAGE_BYTES = 8 * HTB, NXCD = 8, WGM = 8;
DI int lds_byte(int r, int c) { const int st = (r >> 4) * 2 + (c >> 5), rr = r & 15, cc = c & 31, ob = rr * 64 + cc * 2; return st * 1024 + (ob ^ (((ob >> 9) & 1) << 5)); }
DI void stage_rc(int b, int& R, int& C) { const int st = b / 1024, sb = b % 1024, swz = sb ^ (((sb >> 9) & 1) << 5); R = (st >> 1) * 16 + swz / 64; C = (st & 1) * 32 + (swz % 64) / 2; }
DI int perm32(int rho) { const int n = rho >> 4, i = rho & 15; return 8 * (i >> 2) + 4 * n + (i & 3); }

struct Unit { int pm, pn, ks; };
struct Gemm { const bf16_t* A; const bf16_t* Bt; int M, N, K, KS, aslab; };

struct Order {
    int nM, nN, nwg, G, c, KS;
    DI void init(int M, int N, int KS_, int G_, int c_) { nM = M / BM; nN = N / BM; nwg = nM * nN; G = G_; c = c_; KS = KS_; }
    DI bool next(int i, Unit& u) const {
        const int L = i * G + c; if (L >= nwg * KS) return false;
        u.ks = L / nwg;
        int wgid = L % nwg; { const int q = nwg / NXCD, r = nwg % NXCD, xcd = wgid % NXCD, off = wgid / NXCD; wgid = (xcd < r ? xcd * (q + 1) : r * (q + 1) + (xcd - r) * q) + off; }
        const int nig = WGM * nN, gid = wgid / nig, fm = gid * WGM, gsz = (nM - fm) < WGM ? (nM - fm) : WGM;
        u.pm = fm + ((wgid % nig) % gsz); u.pn = (wgid % nig) / gsz; return true;
    }
};

struct EpiZ {
    bf16_t* O; int ldc; const float* bias; int slab;
    DI void operator()(const f32x4 (&acc)[2][2][4][2], const Unit& u, int wr, int wc, int fr, int fq) const {
        const int row0 = u.pm * BM + wr * 64 + fr, col0 = u.pn * BM + wc * 32 + 8 * fq;
        f32x4 bv[2][2];
#pragma unroll
        for (int bj = 0; bj < 2; ++bj)
#pragma unroll
            for (int n = 0; n < 2; ++n) bv[bj][n] = bias ? *(const f32x4*)(bias + col0 + bj * HALF + 4 * n) : (f32x4){0.f, 0.f, 0.f, 0.f};
#pragma unroll
        for (int ai = 0; ai < 2; ++ai)
#pragma unroll
            for (int m = 0; m < 4; ++m) { const int row = row0 + ai * HALF + m * 16;
                bf16_t* rowp = slab ? O + ((size_t)(col0 >> 3) * TT + row) * 8 : O + (size_t)row * ldc + col0;
                const size_t bjs = slab ? (size_t)16 * TT * 8 : (size_t)HALF;
#pragma unroll
                for (int bj = 0; bj < 2; ++bj) { const f32x4 v0 = acc[ai][bj][m][0] + bv[bj][0], v1 = acc[ai][bj][m][1] + bv[bj][1];
                    u32x4 w; w.x = cvtpk(v0[0], v0[1]); w.y = cvtpk(v0[2], v0[3]); w.z = cvtpk(v1[0], v1[1]); w.w = cvtpk(v1[2], v1[3]);
                    *(u32x4*)(rowp + bj * bjs) = w; } }
    }
};

struct EpiQKV {
    bf16_t* O; const float* ropec; const float* ropes; float* newk; float* newv;
    DI void operator()(const f32x4 (&acc)[2][2][4][2], const Unit& u, int wr, int wc, int fr, int fq) const {
        const int row0 = u.pm * BM + wr * 64 + fr, col0 = u.pn * BM + wc * 32 + 8 * fq;
        const bool sample = u.pm >= 16; const int sec = u.pn >> 2;
        const bool rope = sample && sec < 2;
        const float sgn = (fq & 2) ? 1.f : -1.f;
        const int axis = (col0 >> 5) & 1, f0 = col0 & 15;
#pragma unroll
        for (int ai = 0; ai < 2; ++ai) {
#pragma unroll
          for (int mh = 0; mh < 2; ++mh) {
            f32x4 c0[2], c1[2], s0[2], s1[2];
            if (rope) {
#pragma unroll
                for (int m2 = 0; m2 < 2; ++m2) { const int tpos = (row0 + ai * HALF + (2 * mh + m2) * 16 - TP) & 2047;
                    const float* cp = ropec + tpos * 32 + axis * 16 + f0; const float* sp = ropes + tpos * 32 + axis * 16 + f0;
                    c0[m2] = *(const f32x4*)cp; c1[m2] = *(const f32x4*)(cp + 4); s0[m2] = *(const f32x4*)sp; s1[m2] = *(const f32x4*)(sp + 4); }
            }
#pragma unroll
            for (int m2 = 0; m2 < 2; ++m2) { const int m = 2 * mh + m2; const int row = row0 + ai * HALF + m * 16;
#pragma unroll
                for (int bj = 0; bj < 2; ++bj) { const int col = col0 + bj * HALF;
                    f32x4 v0 = acc[ai][bj][m][0], v1 = acc[ai][bj][m][1];
                    if (rope) {
                        f32x4 p0, p1;
#pragma unroll
                        for (int e = 0; e < 4; ++e) { p0[e] = __shfl_xor(v0[e], 32); p1[e] = __shfl_xor(v1[e], 32); }
                        v0 = v0 * c0[m2] + (p0 * s0[m2]) * sgn; v1 = v1 * c1[m2] + (p1 * s1[m2]) * sgn;
                    }
                    u32x4 w; w.x = cvtpk(v0[0], v0[1]); w.y = cvtpk(v0[2], v0[3]); w.z = cvtpk(v1[0], v1[1]); w.w = cvtpk(v1[2], v1[3]);
                    *(u32x4*)(O + (size_t)row * NMIX + col) = w;
                    if (!sample && sec >= 1) {
                        const int cc = col - sec * 1024, h = cc >> 7, d = cc & 127, b = row >> 8, t = row & 255;
                        float* dst = (sec == 1 ? newk : newv) + ((size_t)((b * 2) * 8 + h) * 256 + t) * 128 + d;
                        *(f32x4*)dst = v0; *(f32x4*)(dst + 4) = v1;
                    }
                } }
          }
        }
    }
};

struct EpiF32 {
    bf16_t* Y; int ldc; size_t kstride;
    DI void operator()(const f32x4 (&acc)[2][2][4][2], const Unit& u, int wr, int wc, int fr, int fq) const {
        const int row0 = u.pm * BM + wr * 64 + fr, col0 = u.pn * BM + wc * 32 + 8 * fq;
        bf16_t* base = Y + (size_t)u.ks * kstride;
#pragma unroll
        for (int ai = 0; ai < 2; ++ai)
#pragma unroll
            for (int m = 0; m < 4; ++m) { bf16_t* rowp = base + (size_t)(row0 + ai * HALF + m * 16) * ldc + col0;
#pragma unroll
                for (int bj = 0; bj < 2; ++bj) { const f32x4 v0 = acc[ai][bj][m][0], v1 = acc[ai][bj][m][1];
                    u32x4 w; w.x = cvtpk(v0[0], v0[1]); w.y = cvtpk(v0[2], v0[3]); w.z = cvtpk(v1[0], v1[1]); w.w = cvtpk(v1[2], v1[3]);
                    *(u32x4*)(rowp + bj * HALF) = w; } }
    }
};

DI f32x4 bperm4(int addr, const f32x4 v) {
    const float v0 = v[0], v1 = v[1], v2 = v[2], v3 = v[3];
    const int a = __builtin_amdgcn_ds_bpermute(addr, __float_as_int(v0)), b = __builtin_amdgcn_ds_bpermute(addr, __float_as_int(v1));
    const int c = __builtin_amdgcn_ds_bpermute(addr, __float_as_int(v2)), d = __builtin_amdgcn_ds_bpermute(addr, __float_as_int(v3));
    return (f32x4){__int_as_float(a), __int_as_float(b), __int_as_float(c), __int_as_float(d)};
}
struct EpiFFN {
    bf16_t* Aout; const float* wdw; const float* bdw; float* side;
    DI void operator()(const f32x4 (&acc)[2][2][4][2], const Unit& u, int wr, int wc, int fr, int fq) const {
        const int colg = u.pn * 128 + wc * 32 + 8 * fq;
        const int tok0 = u.pm * BM + 8 * (16 * wr + fr);
        const bool efirst = (fr == 0), elast = (fr == 15);
        float* sb = side + (size_t)((u.pm * 4 + wr * 2 + (elast ? 1 : 0)) * 2) * NUP;
        bf16_t* ap_ = Aout + (size_t)tok0 * DFF + colg;
#pragma unroll
        for (int n = 0; n < 2; ++n) {
            const int cg = colg + 4 * n, cv = DFF + colg + 4 * n;
            const f32x4 wg0 = *(const f32x4*)(wdw + cg), wg1 = *(const f32x4*)(wdw + NUP + cg), wg2 = *(const f32x4*)(wdw + 2 * NUP + cg), bg = *(const f32x4*)(bdw + cg);
            const f32x4 wv0 = *(const f32x4*)(wdw + cv), wv1 = *(const f32x4*)(wdw + NUP + cv), wv2 = *(const f32x4*)(wdw + 2 * NUP + cv), bv = *(const f32x4*)(bdw + cv);
            const int lane_ = fq * 16 + fr, pl = ((lane_ - 1) & 63) * 4, nl = ((lane_ + 1) & 63) * 4;
            const float mf = efirst ? 0.f : 1.f, ml = elast ? 0.f : 1.f;
            const f32x4 pg = bperm4(pl, acc[1][0][3][n]) * mf, pv = bperm4(pl, acc[1][1][3][n]) * mf;
#pragma unroll
            for (int q = 0; q < 8; ++q) {
                const f32x4 zgp = q == 0 ? pg : acc[(q - 1) >> 2][0][(q - 1) & 3][n], zgc = acc[q >> 2][0][q & 3][n], zgn = q == 7 ? bperm4(nl, acc[0][0][0][n]) * ml : acc[((q + 1) & 7) >> 2][0][(q + 1) & 3][n];
                const f32x4 zvp = q == 0 ? pv : acc[(q - 1) >> 2][1][(q - 1) & 3][n], zvc = acc[q >> 2][1][q & 3][n], zvn = q == 7 ? bperm4(nl, acc[0][1][0][n]) * ml : acc[((q + 1) & 7) >> 2][1][(q + 1) & 3][n];
                const f32x4 g = wg0 * zgp + wg1 * zgc + wg2 * zgn + bg;
                const f32x4 v = wv0 * zvp + wv1 * zvc + wv2 * zvn + bv;
                const bool edge = (q == 0 && efirst) || (q == 7 && elast);
                if ((q == 0 || q == 7) && edge) {
                    *(f32x4*)(sb + cg) = zgc; *(f32x4*)(sb + cv) = zvc; *(f32x4*)(sb + NUP + cg) = g; *(f32x4*)(sb + NUP + cv) = v;
                } else {
                    float r[4];
#pragma unroll
                    for (int e = 0; e < 4; ++e) r[e] = g[e] * __builtin_amdgcn_rcpf(1.f + __expf(-g[e])) * v[e];
                    u32x2 w; w.x = cvtpk(r[0], r[1]); w.y = cvtpk(r[2], r[3]);
                    *(u32x2*)(ap_ + (size_t)q * DFF + 4 * n) = w;
                }
            }
        }
    }
};

struct EpiU {
    int mode; EpiZ z; EpiQKV q; EpiF32 f; EpiFFN n;
    DI void operator()(const f32x4 (&acc)[2][2][4][2], const Unit& u, int wr, int wc, int fr, int fq) const {
        if (mode == 0) z(acc, u, wr, wc, fr, fq); else if (mode == 1) q(acc, u, wr, wc, fr, fq); else if (mode == 2) f(acc, u, wr, wc, fr, fq); else n(acc, u, wr, wc, fr, fq);
    }
};

template <class Epi>
DI void gemm_phase(LAS unsigned char* lds, const int tid, const Gemm g, const Order& S, const Epi& E) {
    const int wid = __builtin_amdgcn_readfirstlane(tid >> 6), lane = tid & 63, wr = wid >> 2, wc = wid & 3, fr = lane & 15, fq = lane >> 4;
    const int K = g.K, Ksub = K / g.KS, nt = Ksub / BK;
    unsigned voffA[2], voffB[2];
#pragma unroll
    for (int i = 0; i < 2; ++i) { int R, C; stage_rc(tid * 16 + i * 8192, R, C); const int Rb = (R & ~31) + perm32(R & 31);
        const int tau = 8 * ((R >> 6) * 16 + (R & 15)) + ((R >> 4) & 3);
        voffA[i] = g.aslab == 1 ? (unsigned)((C >> 3) * g.M + R) * 16u : (g.aslab == 2 ? (unsigned)(tau * K + C) * 2u : (unsigned)(R * K + C) * 2u); voffB[i] = (unsigned)(Rb * K + C) * 2u; }
    const size_t kstep = (size_t)(BK * 2);
    const size_t hstep = (size_t)HALF * K * 2;
    const size_t tstep = 2 * hstep;
    const size_t ksb = (size_t)Ksub * 2;
    const size_t kstepA = g.aslab == 1 ? (size_t)8 * g.M * 16 : kstep, hstepA = g.aslab == 1 ? (size_t)HALF * 16 : (g.aslab == 2 ? (size_t)4 * K * 2 : hstep), tstepA = g.aslab == 1 ? (size_t)BM * 16 : tstep, ksbA = g.aslab == 1 ? (size_t)(Ksub / 8) * g.M * 16 : ksb;
    const unsigned ldsw = (unsigned)wid * 1024u;
    const int aoff = lds_byte(wr * 64 + fr, fq * 8), boff = lds_byte(wc * 32 + fr, fq * 8);
#define PG8_SA(b, h) (((b) * 2 + (h)) * HTB)
#define PG8_SB(b, h) ((4 + (b) * 2 + (h)) * HTB)
#define PG8_STAGE(bufoff, gbase, voff) do { _Pragma("unroll") for (int _i = 0; _i < 2; ++_i) \
        __builtin_amdgcn_global_load_lds((const unsigned*)((const char*)(gbase) + (voff)[_i]), (LAS unsigned*)(lds + (bufoff) + ldsw + _i * 8192), 16, 0, 0); } while (0)
#define PG8_LDA(dst, b, h) do { _Pragma("unroll") for (int m = 0; m < 4; ++m) _Pragma("unroll") for (int k = 0; k < 2; ++k) dst[m][k] = *(const LAS bf16x8*)(lds + PG8_SA(b, h) + aoff + m * 2048 + k * 1024); } while (0)
#define PG8_LDB(dst, b, h) do { _Pragma("unroll") for (int n = 0; n < 2; ++n) _Pragma("unroll") for (int k = 0; k < 2; ++k) dst[n][k] = *(const LAS bf16x8*)(lds + PG8_SB(b, h) + boff + n * 2048 + k * 1024); } while (0)
#define PG8_MMA(ai, bj, At, Bt) do { __builtin_amdgcn_s_setprio(1); _Pragma("unroll") for (int m = 0; m < 4; ++m) _Pragma("unroll") for (int n = 0; n < 2; ++n) _Pragma("unroll") for (int k = 0; k < 2; ++k) \
        acc[ai][bj][m][n] = __builtin_amdgcn_mfma_f32_16x16x32_bf16(Bt[n][k], At[m][k], acc[ai][bj][m][n], 0, 0, 0); __builtin_amdgcn_s_setprio(0); } while (0)
#define PG8_WAIT_V(n) asm volatile("s_waitcnt vmcnt(" #n ")" ::: "memory")
#define PG8_WAIT_L(n) asm volatile("s_waitcnt lgkmcnt(" #n ")" ::: "memory")
#define PG8_BAR __builtin_amdgcn_s_barrier()
#define PG8_SCHED __builtin_amdgcn_sched_barrier(0)
    Unit cur, nxt; int ui = 0;
    if (!S.next(0, cur)) return;
    f32x4 acc[2][2][4][2];
#pragma unroll
    for (int a = 0; a < 2; ++a)
#pragma unroll
        for (int b = 0; b < 2; ++b)
#pragma unroll
            for (int m = 0; m < 4; ++m)
#pragma unroll
                for (int n = 0; n < 2; ++n) acc[a][b][m][n] = (f32x4){0.f, 0.f, 0.f, 0.f};
    bf16x8 At[4][2], B0[2][2], B1[2][2];
    const char* cA = (const char*)g.A + (size_t)cur.pm * tstepA + (size_t)cur.ks * ksbA; const char* cB = (const char*)g.Bt + (size_t)cur.pn * tstep + (size_t)cur.ks * ksb;
    PG8_STAGE(PG8_SB(0, 0), cB, voffB); PG8_STAGE(PG8_SB(0, 1), cB + hstep, voffB); PG8_STAGE(PG8_SA(0, 0), cA, voffA); PG8_STAGE(PG8_SA(0, 1), cA + hstepA, voffA);
    if (wr == 1) PG8_BAR;
    PG8_WAIT_V(2); PG8_BAR;
    PG8_STAGE(PG8_SB(1, 0), cB + kstep, voffB); PG8_STAGE(PG8_SA(1, 0), cA + kstepA, voffA); PG8_STAGE(PG8_SB(1, 1), cB + hstep + kstep, voffB);
    PG8_WAIT_V(6); PG8_BAR;
    for (;;) {
        const bool has_next = S.next(ui + 1, nxt);
        const char* nA = has_next ? (const char*)g.A + (size_t)nxt.pm * tstepA + (size_t)nxt.ks * ksbA : cA; const char* nB = has_next ? (const char*)g.Bt + (size_t)nxt.pn * tstep + (size_t)nxt.ks * ksb : cB;
        for (int t = 0; t < nt; t += 2) {
            const bool last = (t == nt - 2);
            const char* a1 = cA + (size_t)(t + 1) * kstepA;
            const char* a2 = last ? nA : cA + (size_t)(t + 2) * kstepA; const char* b2 = last ? nB : cB + (size_t)(t + 2) * kstep;
            const char* a3 = a2 + kstepA; const char* b3 = b2 + kstep;
            PG8_LDB(B0, 0, 0); PG8_LDB(B1, 0, 1); PG8_SCHED; PG8_LDA(At, 0, 0); PG8_STAGE(PG8_SA(1, 1), a1 + hstepA, voffA);
            PG8_WAIT_V(8); PG8_WAIT_L(0); PG8_BAR; PG8_MMA(0, 0, At, B0); PG8_MMA(0, 1, At, B1); PG8_BAR; PG8_SCHED;
            PG8_LDA(At, 0, 1); PG8_STAGE(PG8_SB(0, 0), b2, voffB); PG8_STAGE(PG8_SB(0, 1), b2 + hstep, voffB); PG8_STAGE(PG8_SA(0, 0), a2, voffA);
            PG8_WAIT_V(8); PG8_WAIT_L(0); PG8_BAR; PG8_MMA(1, 0, At, B0); PG8_MMA(1, 1, At, B1); PG8_BAR; PG8_SCHED;
            PG8_LDB(B0, 1, 0); PG8_LDB(B1, 1, 1); PG8_SCHED; PG8_LDA(At, 1, 0); PG8_STAGE(PG8_SA(0, 1), a2 + hstepA, voffA);
            PG8_WAIT_V(8); PG8_WAIT_L(0); PG8_BAR; PG8_MMA(0, 0, At, B0); PG8_MMA(0, 1, At, B1); PG8_BAR; PG8_SCHED;
            PG8_LDA(At, 1, 1); PG8_STAGE(PG8_SB(1, 0), b3, voffB); PG8_STAGE(PG8_SB(1, 1), b3 + hstep, voffB); PG8_STAGE(PG8_SA(1, 0), a3, voffA);
            PG8_WAIT_V(8); PG8_WAIT_L(0); PG8_BAR; PG8_MMA(1, 0, At, B0); PG8_MMA(1, 1, At, B1); PG8_BAR; PG8_SCHED;
        }
        if (wr == 0) PG8_BAR;
        E(acc, cur, wr, wc, fr, fq);
        if (!has_next) break;
#pragma unroll
        for (int a = 0; a < 2; ++a)
#pragma unroll
            for (int b = 0; b < 2; ++b)
#pragma unroll
                for (int m = 0; m < 4; ++m)
#pragma unroll
                    for (int n = 0; n < 2; ++n) acc[a][b][m][n] = (f32x4){0.f, 0.f, 0.f, 0.f};
        cur = nxt; cA = nA; cB = nB; ++ui;
        if (wr == 1) PG8_BAR;
    }
    PG8_WAIT_V(0);
    PG8_BAR;
#undef PG8_SA
#undef PG8_SB
#undef PG8_STAGE
#undef PG8_LDA
#undef PG8_LDB
#undef PG8_MMA
#undef PG8_WAIT_V
#undef PG8_WAIT_L
#undef PG8_BAR
#undef PG8_SCHED
}
}

struct Args { const float* in[33]; float* out; unsigned char* ws; int ph_lo, ph_hi; };
enum { I_XP = 0, I_XS, I_CK, I_CV, I_C, I_CCTX, I_WADA, I_BADA, I_NORMW, I_HWIN, I_HBIN, I_HWSH, I_HBSH, I_FW1, I_FB1, I_FFREQ, I_FW2, I_FB2, I_FW3, I_DBIAS, I_HWOUT, I_HBOUT,
       I_AWQKV, I_AWOUT, I_LQ1, I_LK1, I_LQ2, I_LK2, I_SUBLN, I_FUP, I_FDW, I_FBDW, I_FDOWN };

DI int up_row(int n) { return n < DFF ? (n >> 7) * 256 + (n & 127) : ((n - DFF) >> 7) * 256 + 128 + ((n - DFF) & 127); }
DI void p0_transpose_item(const float* W, int K, int N, bf16_t* WT, LAS float* scr, int item, int lane, bool perm_up = false) {
    const int nblk = N / 32, kb = item / nblk, nb = item % nblk, k0 = 64 * kb, n0 = 32 * nb;
    float wv[32];
#pragma unroll
    for (int i = 0; i < 32; ++i) { const int kk = 2 * i + (lane >> 5); wv[i] = W[(size_t)(k0 + kk) * N + n0 + (lane & 31)]; }
#pragma unroll
    for (int i = 0; i < 32; ++i) { const int kk = 2 * i + (lane >> 5); scr[kk * 33 + (lane & 31)] = wv[i]; }
    asm volatile("s_waitcnt lgkmcnt(0)" ::: "memory");
    const int c = lane & 7;
#pragma unroll
    for (int j = 0; j < 4; ++j) { const int n = (lane >> 3) + 8 * j; const LAS float* s = scr + (8 * c) * 33 + n;
        u32x4 o; o.x = cvtpk(s[0 * 33], s[1 * 33]); o.y = cvtpk(s[2 * 33], s[3 * 33]); o.z = cvtpk(s[4 * 33], s[5 * 33]); o.w = cvtpk(s[6 * 33], s[7 * 33]);
        *(u32x4*)(WT + (size_t)(perm_up ? up_row(n0) + n : n0 + n) * K + k0 + 8 * c) = o; }
    asm volatile("s_waitcnt lgkmcnt(0)" ::: "memory");
}

typedef const __attribute__((address_space(4))) Args* ArgsP;
constexpr int I_MIX = 16 * 96, I_OUT = 16 * 32, I_UP = 16 * 176, I_DOWN = 44 * 32, I_LAYER = I_MIX + I_OUT + I_UP + I_DOWN;
DI void convert_layer_weights(ArgsP ap, int i, int gwl, int NGWL, LAS float* scr, int lane) {
    const int jj = i >> 1;
    unsigned char* wl = ap->ws + WS_W + (size_t)i * W_LAYER;
    for (int it = gwl; it < I_LAYER; it += NGWL) {
        int r = it;
        if (r < I_MIX) { const float* W = (i & 1) ? ap->in[I_AWQKV] + (size_t)jj * 1024 * 3072 : ap->in[I_HWIN] + (size_t)jj * 1024 * 3072; p0_transpose_item(W, 1024, 3072, (bf16_t*)(wl + W_MIX), scr, r, lane); continue; } r -= I_MIX;
        if (r < I_OUT) { const float* W = (i & 1) ? ap->in[I_AWOUT] + (size_t)jj * 1024 * 1024 : ap->in[I_HWOUT] + (size_t)jj * 1024 * 1024; p0_transpose_item(W, 1024, 1024, (bf16_t*)(wl + W_OUT), scr, r, lane); continue; } r -= I_OUT;
        if (r < I_UP) { p0_transpose_item(ap->in[I_FUP] + (size_t)i * 1024 * 5632, 1024, 5632, (bf16_t*)(wl + W_UP), scr, r, lane, true); continue; } r -= I_UP;
        p0_transpose_item(ap->in[I_FDOWN] + (size_t)i * 2816 * 1024, 2816, 1024, (bf16_t*)(wl + W_DOWN), scr, r, lane);
    }
}

DI void phase0(ArgsP ap, LAS unsigned char* lds, int tid, int lane, int wave, int G) {
    unsigned char* ws = ap->ws;
    LAS float* sl = (LAS float*)lds;
    LAS float* red = sl + 3072;
    for (int idx = tid; idx < 3072; idx += 512) { const int cnd = idx >> 10, k = idx & 1023; const float v = cnd == 0 ? ap->in[I_CCTX][k] : ap->in[I_C][(cnd - 1) * 1024 + k]; sl[idx] = v / (1.f + __expf(-v)); }
    __syncthreads();
    float* mod = (float*)(ws + WS_MOD);
    for (int rep = 0; rep < REP_P0A; ++rep)
    for (int item = blockIdx.x; item < 384; item += G) {
        const int i = item / 96, n0 = (item % 96) * 64;
        const float* W = ap->in[I_WADA] + (size_t)i * 1024 * 6144 + n0 + lane;
        float a0 = 0.f, a1 = 0.f, a2 = 0.f; const int k0 = wave * 128;
#pragma unroll 16
        for (int kk = 0; kk < 128; ++kk) { const float w = W[(size_t)(k0 + kk) * 6144]; a0 += sl[k0 + kk] * w; a1 += sl[1024 + k0 + kk] * w; a2 += sl[2048 + k0 + kk] * w; }
        red[(wave * 3 + 0) * 64 + lane] = a0; red[(wave * 3 + 1) * 64 + lane] = a1; red[(wave * 3 + 2) * 64 + lane] = a2;
        __syncthreads();
        if (tid < 192) { const int cnd = tid >> 6, l = tid & 63; float s = 0.f;
#pragma unroll
            for (int w = 0; w < 8; ++w) s += red[(w * 3 + cnd) * 64 + l];
            mod[(i * 3 + cnd) * 6144 + n0 + l] = s + ap->in[I_BADA][i * 6144 + n0 + l]; }
        __syncthreads();
    }
    __syncthreads();
    { float* rc = (float*)(ws + WS_ROPE); float* rs = rc + 2048 * 32;
      for (int idx = blockIdx.x * 512 + tid; idx < 2048 * 32; idx += G * 512) { const int t = idx >> 5, e = idx & 31, ax = e >> 4, f = e & 15;
          const float pos = (float)(ax == 0 ? (t >> 6) : (t & 63)); const float inv = __builtin_amdgcn_exp2f(-(float)f * (13.287712379549449f / 16.f)); const float ang = pos * inv;
          rc[idx] = __cosf(ang); rs[idx] = __sinf(ang); } }
    const int gw = blockIdx.x * NWAVES + wave, NGW = G * NWAVES;
    constexpr int FW_L = 33 * 64 + 64 * 64 + 192;
    LAS float* fw = (LAS float*)lds;
    for (int jj = 0; jj < 2; ++jj) {
        LAS float* f = fw + jj * FW_L;
        { float v[5];
#pragma unroll
          for (int k = 0; k < 5; ++k) { const int r = tid + 512 * k; v[k] = r < 2112 ? ap->in[I_FW1][jj * 2112 + r] : 0.f; }
#pragma unroll
          for (int k = 0; k < 5; ++k) { const int r = tid + 512 * k; if (r < 2112) f[r] = v[k]; } }
        { float v[8];
#pragma unroll
          for (int k = 0; k < 8; ++k) v[k] = ap->in[I_FW2][jj * 4096 + tid + 512 * k];
#pragma unroll
          for (int k = 0; k < 8; ++k) f[2112 + tid + 512 * k] = v[k]; }
        if (tid < 64) { f[6208 + tid] = ap->in[I_FB1][jj * 64 + tid]; f[6272 + tid] = ap->in[I_FB2][jj * 64 + tid]; f[6336 + tid] = ap->in[I_FFREQ][jj * 64 + tid]; }
    }
    __syncthreads();
    LAS float* hs = (LAS float*)(lds + 51200 + wave * 2048);
    LAS float* w3s = (LAS float*)(lds + 67584);
    const int fgrp = blockIdx.x & 15, fsub = blockIdx.x >> 4, fnb = (G + 15 - fgrp) >> 4;
    const int j = fgrp >> 3, half = (fgrp >> 2) & 1, ch4 = fgrp & 3;
    { const float* src = ap->in[I_FW3] + (size_t)j * 64 * 2048 + half * 1024 + ch4 * 256 + (tid >> 3) * 2048 + (tid & 7) * 32;
      f32x4 t[8];
#pragma unroll
      for (int k = 0; k < 8; ++k) t[k] = *(const f32x4*)(src + 4 * k);
#pragma unroll
      for (int k = 0; k < 8; ++k) *(LAS f32x4*)(w3s + (tid >> 3) * 256 + (tid & 7) * 32 + 4 * k) = t[k]; }
    __syncthreads();
    for (int rep = 0; rep < REP_P0C; ++rep)
    for (int pbx = fsub + fnb * wave; pbx < 288; pbx += fnb * NWAVES) {
        int L, pb;
        if (pbx < 256) { L = 2048; pb = pbx; } else { L = 256; pb = pbx - 256; }
        const LAS float* w1 = fw + j * FW_L; const LAS float* w2 = w1 + 2112; const LAS float* b1 = w1 + 6208; const LAS float* b2 = w1 + 6272; const LAS float* fq = w1 + 6336;
        const int t0 = pb * 8 + half;
        float zv[8], h1[8], h2[8];
        const float fr = fq[lane];
        for (int repc = 0; repc < REP_FC; ++repc) {
#pragma unroll
        for (int p = 0; p < 8; ++p) { int t = t0 + p; if (t > L - 1) t = L - 1;
            const float tn = (float)t / (float)(L - 1); const float w = 6.283185307179586f * (float)t / (float)L;
            float z = 0.f;
            if (lane == 0) z = tn;
            else if (lane <= 16) { const float band = 1e-4f + (float)(lane - 1) * ((15.f - 1e-4f) / 15.f); z = __cosf(band * w); }
            else if (lane <= 32) { const float band = 1e-4f + (float)(lane - 17) * ((15.f - 1e-4f) / 15.f); z = -__sinf(band * w); }
            zv[p] = z; h1[p] = b1[lane]; h2[p] = b2[lane]; }
#pragma unroll 3
        for (int e = 0; e < 33; ++e) { const float w = w1[e * 64 + lane];
#pragma unroll
            for (int p = 0; p < 8; ++p) h1[p] += __builtin_bit_cast(float, __builtin_amdgcn_readlane(__builtin_bit_cast(int, zv[p]), e)) * w; }
#pragma unroll
        for (int p = 0; p < 8; ++p) h1[p] = __sinf(fr * h1[p]);
#pragma unroll 4
        for (int i = 0; i < 64; ++i) { const float w = w2[i * 64 + lane];
#pragma unroll
            for (int p = 0; p < 8; ++p) h2[p] += __builtin_bit_cast(float, __builtin_amdgcn_readlane(__builtin_bit_cast(int, h1[p]), i)) * w; }
#pragma unroll
        for (int p = 0; p < 8; ++p) hs[lane * 8 + p] = __sinf(fr * h2[p]);
        }
        asm volatile("s_waitcnt lgkmcnt(0)" ::: "memory");
        float acc[4][8];
#pragma unroll
        for (int q = 0; q < 4; ++q)
#pragma unroll
            for (int p = 0; p < 8; ++p) acc[q][p] = 0.f;
#pragma unroll 4
        for (int i = 0; i < 64; ++i) {
            const f32x4 ha = *(const LAS f32x4*)(hs + i * 8), hb = *(const LAS f32x4*)(hs + i * 8 + 4);
#pragma unroll
            for (int q = 0; q < 4; ++q) { const float w = w3s[i * 256 + q * 64 + lane];
                acc[q][0] += ha[0] * w; acc[q][1] += ha[1] * w; acc[q][2] += ha[2] * w; acc[q][3] += ha[3] * w;
                acc[q][4] += hb[0] * w; acc[q][5] += hb[1] * w; acc[q][6] += hb[2] * w; acc[q][7] += hb[3] * w; }
        }
        asm volatile("s_waitcnt lgkmcnt(0)" ::: "memory");
        bf16_t* Fg = (bf16_t*)(ws + WS_FILT + (size_t)j * FILT_LAYER + (L == 2048 ? MiB : 0));
        const float mind = -3.0701134573253945f, maxd = -15.350567286626973f;
        for (int reps = 0; reps < REP_FS; ++reps)
#pragma unroll
        for (int q = 0; q < 4; ++q) { const int ch = ch4 * 256 + q * 64 + lane;
            const float ad = -(mind + (maxd - mind) * ((float)ch / 1023.f));
            float v[8];
#pragma unroll
            for (int p = 0; p < 8; ++p) { const int t = t0 + p; const float tn = (float)t / (float)(L - 1);
                float x = acc[q][p] * __expf(-tn * ad); if (t > L - 1) x = 0.f; if (half == 0 && t == 0) x += ap->in[I_DBIAS][j * 1024 + ch]; v[p] = x; }
            u32x4 o;
            if (half == 0) { o.x = cvtpk(v[7], v[6]); o.y = cvtpk(v[5], v[4]); o.z = cvtpk(v[3], v[2]); o.w = cvtpk(v[1], v[0]);
                *(u32x4*)(Fg + (size_t)ch * (2 * L) + (L - 8 - pb * 8)) = o; }
            else { o.x = cvtpk(v[0], v[1]); o.y = cvtpk(v[2], v[3]); o.z = cvtpk(v[4], v[5]); o.w = cvtpk(v[6], v[7]);
                *(u32x4*)(Fg + (size_t)ch * (2 * L) + (L + pb * 8)) = o; }
        }
    }
    __syncthreads();
    for (int rep = 0; rep < REP_P0D; ++rep) convert_layer_weights(ap, 0, gw, NGW, (LAS float*)(lds + wave * 16384), lane);
    __syncthreads();
}

DI void row_phase(int gw, int NGW, int lane, const float* __restrict__ xP, const float* __restrict__ xS, float* __restrict__ xout, const bf16_t* __restrict__ Y, const float* __restrict__ ybias,
                  const float* __restrict__ modgate, const float* __restrict__ w_post, const float* __restrict__ w_pre, const float* __restrict__ modshift, const float* __restrict__ modscale, bf16_t* __restrict__ hout) {
    for (int m = gw; m < TT; m += NGW) {
        const int cnd = m < TP ? 0 : 1 + ((m - TP) >> 11);
        const float* xr = m < TP ? xP + (size_t)m * D : xS + (size_t)(m - TP) * D;
        f32x4 x[4], ya[4], bb[4], g[4], wp[4], wn[4], sh[4], sc[4]; u32x2 pa[4], pb[4];
#pragma unroll
        for (int j = 0; j < 4; ++j) x[j] = ((const f32x4*)xr)[lane + 64 * j];
        if (Y) {
#pragma unroll
            for (int j = 0; j < 4; ++j) { pa[j] = ((const u32x2*)(Y + (size_t)m * D))[lane + 64 * j]; pb[j] = ((const u32x2*)(Y + (size_t)TT * D + (size_t)m * D))[lane + 64 * j];
                bb[j] = ((const f32x4*)ybias)[lane + 64 * j]; g[j] = ((const f32x4*)(modgate + cnd * 6144))[lane + 64 * j]; wp[j] = ((const f32x4*)w_post)[lane + 64 * j]; }
        }
        if (hout) {
#pragma unroll
            for (int j = 0; j < 4; ++j) { wn[j] = ((const f32x4*)w_pre)[lane + 64 * j]; sh[j] = ((const f32x4*)(modshift + cnd * 6144))[lane + 64 * j]; sc[j] = ((const f32x4*)(modscale + cnd * 6144))[lane + 64 * j]; }
        }
        if (Y) {
            float ss = 0.f;
#pragma unroll
            for (int j = 0; j < 4; ++j) { ya[j] = (f32x4){bflo(pa[j].x) + bflo(pb[j].x), bfhi(pa[j].x) + bfhi(pb[j].x), bflo(pa[j].y) + bflo(pb[j].y), bfhi(pa[j].y) + bfhi(pb[j].y)} + bb[j]; ss += (ya[j].x * ya[j].x + ya[j].y * ya[j].y) + (ya[j].z * ya[j].z + ya[j].w * ya[j].w); }
            ss = wave_sum(ss); const float rstd = 1.f / sqrtf(ss * (1.f / D) + EPS);
#pragma unroll
            for (int j = 0; j < 4; ++j) x[j] += g[j] * (ya[j] * rstd * wp[j]);
        }
        u32x2 o[4];
        if (hout) {
            float ss = 0.f;
#pragma unroll
            for (int j = 0; j < 4; ++j) ss += (x[j].x * x[j].x + x[j].y * x[j].y) + (x[j].z * x[j].z + x[j].w * x[j].w);
            ss = wave_sum(ss); const float rstd = 1.f / sqrtf(ss * (1.f / D) + EPS);
#pragma unroll
            for (int j = 0; j < 4; ++j) { const f32x4 h = (x[j] * rstd * wn[j]) * (sc[j] + 1.f) + sh[j]; o[j].x = cvtpk(h.x, h.y); o[j].y = cvtpk(h.z, h.w); }
        }
#pragma unroll
        for (int j = 0; j < 4; ++j) ((f32x4*)(xout + (size_t)m * D))[lane + 64 * j] = x[j];
        if (hout) {
#pragma unroll
            for (int j = 0; j < 4; ++j) ((u32x2*)(hout + (size_t)m * D))[lane + 64 * j] = o[j];
        }
    }
}

DI void ffn_elem_phase(int gtid, int NT, const bf16_t* __restrict__ z, const float* __restrict__ wdw, const float* __restrict__ bdw, bf16_t* __restrict__ aout) {
    for (int item = gtid; item < 2048 * 352; item += NT) {
        const int r = item / 352, cc = item - r * 352, row0 = 4 * r;
        const int L = row0 < TP ? 256 : 2048, tl0 = row0 & (L - 1);
        float wg[3][8], wv[3][8], bg[8], bv[8];
#pragma unroll
        for (int k = 0; k < 3; ++k)
#pragma unroll
            for (int h = 0; h < 2; ++h) { const f32x4 t0 = *(const f32x4*)(wdw + k * NUP + 8 * cc + 4 * h), t1 = *(const f32x4*)(wdw + k * NUP + DFF + 8 * cc + 4 * h);
#pragma unroll
                for (int e = 0; e < 4; ++e) { wg[k][4 * h + e] = t0[e]; wv[k][4 * h + e] = t1[e]; } }
#pragma unroll
        for (int h = 0; h < 2; ++h) { const f32x4 t0 = *(const f32x4*)(bdw + 8 * cc + 4 * h), t1 = *(const f32x4*)(bdw + DFF + 8 * cc + 4 * h);
#pragma unroll
            for (int e = 0; e < 4; ++e) { bg[4 * h + e] = t0[e]; bv[4 * h + e] = t1[e]; } }
        const bf16_t* zb = z + (size_t)row0 * NUP + 8 * cc;
        const u32x4 zero4 = {0u, 0u, 0u, 0u};
        u32x4 rg[6], rv[6];
        rg[0] = tl0 > 0 ? *(const u32x4*)(zb - NUP) : zero4; rv[0] = tl0 > 0 ? *(const u32x4*)(zb - NUP + DFF) : zero4;
#pragma unroll
        for (int k = 0; k < 4; ++k) { rg[1 + k] = *(const u32x4*)(zb + (size_t)k * NUP); rv[1 + k] = *(const u32x4*)(zb + (size_t)k * NUP + DFF); }
        { const bool has_next = (tl0 + 4) < L; rg[5] = has_next ? *(const u32x4*)(zb + (size_t)4 * NUP) : zero4; rv[5] = has_next ? *(const u32x4*)(zb + (size_t)4 * NUP + DFF) : zero4; }
        u32x4 wout[4];
#pragma unroll
        for (int k = 0; k < 4; ++k) {
            float pg[8], pv[8], cg_[8], cv[8], ng[8], nv[8], o[8];
            unpack8(rg[k], pg); unpack8(rv[k], pv); unpack8(rg[k + 1], cg_); unpack8(rv[k + 1], cv); unpack8(rg[k + 2], ng); unpack8(rv[k + 2], nv);
#pragma unroll
            for (int e = 0; e < 8; ++e) { const float g = wg[0][e] * pg[e] + wg[1][e] * cg_[e] + wg[2][e] * ng[e] + bg[e]; const float v = wv[0][e] * pv[e] + wv[1][e] * cv[e] + wv[2][e] * nv[e] + bv[e];
                o[e] = (g / (1.f + __expf(-g))) * v; }
            wout[k].x = cvtpk(o[0], o[1]); wout[k].y = cvtpk(o[2], o[3]); wout[k].z = cvtpk(o[4], o[5]); wout[k].w = cvtpk(o[6], o[7]);
        }
#pragma unroll
        for (int k = 0; k < 4; ++k) *(u32x4*)(aout + (size_t)(row0 + k) * DFF + 8 * cc) = wout[k];
    }
}

DI void ffn_edge_fix(int tid, int pm, int ks, const float* __restrict__ side, const float* __restrict__ wdw, bf16_t* __restrict__ aout) {
    const bool sample = pm >= 16; const int st = (pm - 16) & 7;
    float pg[11], pv[11], og[11], ov[11], wg[11], wv[11];
#pragma unroll
    for (int k = 0; k < 11; ++k) {
        const int idx = tid + 512 * k, e = idx / 1408, n = ks * 1408 + (idx - e * 1408);
        const float* mine = side + (size_t)((pm * 4 + e) * 2) * NUP;
        int pt = -1, tap = 0;
        if (e == 1) { pt = pm * 4 + 2; tap = 2; } else if (e == 2) { pt = pm * 4 + 1; tap = 0; }
        else if (e == 0) { if (sample && st != 0) { pt = (pm - 1) * 4 + 3; tap = 0; } }
        else { if (sample && st != 7) { pt = (pm + 1) * 4 + 0; tap = 2; } }
        const float* o = side + (size_t)((pt < 0 ? pm * 4 + e : pt) * 2) * NUP;
        const float msk = pt < 0 ? 0.f : 1.f;
        pg[k] = mine[NUP + n]; pv[k] = mine[NUP + DFF + n];
        og[k] = o[n] * msk; ov[k] = o[DFF + n] * msk;
        wg[k] = wdw[tap * NUP + n]; wv[k] = wdw[tap * NUP + DFF + n];
    }
#pragma unroll
    for (int k = 0; k < 11; ++k) {
        const int idx = tid + 512 * k, e = idx / 1408, n = ks * 1408 + (idx - e * 1408);
        const float g = pg[k] + wg[k] * og[k], v = pv[k] + wv[k] * ov[k];
        const float r = g * __builtin_amdgcn_rcpf(1.f + __expf(-g)) * v;
        const int tok = pm * 256 + (e == 0 ? 0 : (e == 1 ? 127 : (e == 2 ? 128 : 255)));
        aout[(size_t)tok * DFF + n] = (bf16_t)(cvtpk(r, 0.f) & 0xffffu);
    }
    asm volatile("s_waitcnt vmcnt(0)" ::: "memory");
    __syncthreads();
}

constexpr int CV_G = 0, CV_GCH = 5120, CV_F = 40960, CV_FCH = 8192;
DI void conv_phase(LAS unsigned char* lds, int tid, int lane, int wave, int G, const bf16_t* __restrict__ z, const float* __restrict__ wsh, const float* __restrict__ bsh, const unsigned char* __restrict__ filt, bf16_t* __restrict__ yh) {
    for (int u = blockIdx.x; u < 512; u += G) {
        const int grp = u < 256 ? 2 + (u >> 7) : ((u - 256) >> 7), c0 = (u & 127) * 8;
        const int row0 = grp * 2048, L = grp < 2 ? 256 : 2048, nb = L >> 5;
        for (int rep1 = 0; rep1 < REP_CV1; ++rep1) {
            float w1[3][8], wv[3][8], b1[8], bv[8];
#pragma unroll
            for (int k = 0; k < 3; ++k)
#pragma unroll
                for (int h = 0; h < 2; ++h) { const f32x4 t0 = *(const f32x4*)(wsh + k * NMIX + 1024 + c0 + 4 * h), t1 = *(const f32x4*)(wsh + k * NMIX + 2048 + c0 + 4 * h);
#pragma unroll
                    for (int e = 0; e < 4; ++e) { w1[k][4 * h + e] = t0[e]; wv[k][4 * h + e] = t1[e]; } }
#pragma unroll
            for (int h = 0; h < 2; ++h) { const f32x4 t0 = *(const f32x4*)(bsh + 1024 + c0 + 4 * h), t1 = *(const f32x4*)(bsh + 2048 + c0 + 4 * h);
#pragma unroll
                for (int e = 0; e < 4; ++e) { b1[4 * h + e] = t0[e]; bv[4 * h + e] = t1[e]; } }
            const u32x4 zero4 = {0u, 0u, 0u, 0u};
            for (int idx = tid; idx < 2048; idx += 512) {
                const int tl = idx & (L - 1);
                const bf16_t* z1 = z + ((size_t)(128 + (c0 >> 3)) * TT + row0 + idx) * 8; const bf16_t* zv = z + ((size_t)(256 + (c0 >> 3)) * TT + row0 + idx) * 8;
                const u32x4 p1 = tl > 0 ? *(const u32x4*)(z1 - 8) : zero4, pv_ = tl > 0 ? *(const u32x4*)(zv - 8) : zero4;
                const u32x4 q1 = *(const u32x4*)z1, qv = *(const u32x4*)zv;
                const u32x4 n1 = tl < L - 1 ? *(const u32x4*)(z1 + 8) : zero4, nv = tl < L - 1 ? *(const u32x4*)(zv + 8) : zero4;
                float a[8], b[8], c[8], d[8], e_[8], f[8];
                unpack8(p1, a); unpack8(q1, b); unpack8(n1, c); unpack8(pv_, d); unpack8(qv, e_); unpack8(nv, f);
                LAS bf16_t* gp = (LAS bf16_t*)(lds + CV_G + (idx >> 5) * 80 + (idx & 31) * 2);
#pragma unroll
                for (int e = 0; e < 8; ++e) { const float x1 = w1[0][e] * a[e] + w1[1][e] * b[e] + w1[2][e] * c[e] + b1[e]; const float v = wv[0][e] * d[e] + wv[1][e] * e_[e] + wv[2][e] * f[e] + bv[e];
                    gp[e * (CV_GCH / 2)] = (bf16_t)(cvtpk(v * x1, 0.f) & 0xffffu); }
            }
            const u32x4* fsrc = (const u32x4*)(filt + (L == 2048 ? MiB : 0) + (size_t)(c0 + wave) * (size_t)(4 * L));
            LAS u32x4* fdst = (LAS u32x4*)(lds + CV_F + wave * CV_FCH);
            if (L == 2048) { u32x4 fv[8];
#pragma unroll
                for (int i = 0; i < 8; ++i) fv[i] = fsrc[lane + 64 * i];
#pragma unroll
                for (int i = 0; i < 8; ++i) fdst[lane + 64 * i] = fv[i]; }
            else fdst[lane] = fsrc[lane];
        }
        __syncthreads();
        f32x16 acc0, acc1;
        for (int rep2 = 0; rep2 < REP_CV2; ++rep2) {
#pragma unroll
        for (int i = 0; i < 16; ++i) { acc0[i] = 0.f; acc1[i] = 0.f; }
            const int p = lane & 31, kg = lane >> 5;
            const LAS unsigned char* Fw = lds + CV_F + wave * CV_FCH;
            const LAS unsigned char* Gw = lds + CV_G + wave * CV_GCH;
            const int bi0 = p & (nb - 1), bi1 = (32 + p) & (nb - 1);
            const u32x4 zero4 = {0u, 0u, 0u, 0u};
#define CONV_STEP(T0, T1) do { \
                const int s0 = L - 1 - 32 * d - p + 8 * kg; \
                const LAS unsigned* fp = (const LAS unsigned*)Fw + (s0 >> 1); \
                const unsigned sh = (s0 & 1) * 16; \
                unsigned w0[5], w1_[5]; \
                _Pragma("unroll") for (int i = 0; i < 5; ++i) { w0[i] = fp[i]; w1_[i] = fp[8 + i]; } \
                int blk0 = p - d; blk0 = blk0 < 0 ? 0 : (blk0 > 63 ? 63 : blk0); \
                int blk1 = 32 + p - d; blk1 = blk1 < 0 ? 0 : (blk1 > 63 ? 63 : blk1); \
                const LAS unsigned char* bp0 = Gw + blk0 * 80 + kg * 16; const LAS unsigned char* bp1 = Gw + blk1 * 80 + kg * 16; \
                u32x4 B00 = zero4, B01 = zero4, B10 = zero4, B11 = zero4; \
                if (T0) { B00 = *(const LAS u32x4*)bp0; B01 = *(const LAS u32x4*)(bp0 + 32); } \
                if (T1) { B10 = *(const LAS u32x4*)bp1; B11 = *(const LAS u32x4*)(bp1 + 32); } \
                const bool valid0 = (unsigned)(bi0 - d) < (unsigned)nb, valid1 = (unsigned)(bi1 - d) < (unsigned)nb; \
                u32x4 A0, A1; \
                A0.x = __builtin_amdgcn_alignbit(w0[1], w0[0], sh); A0.y = __builtin_amdgcn_alignbit(w0[2], w0[1], sh); A0.z = __builtin_amdgcn_alignbit(w0[3], w0[2], sh); A0.w = __builtin_amdgcn_alignbit(w0[4], w0[3], sh); \
                A1.x = __builtin_amdgcn_alignbit(w1_[1], w1_[0], sh); A1.y = __builtin_amdgcn_alignbit(w1_[2], w1_[1], sh); A1.z = __builtin_amdgcn_alignbit(w1_[3], w1_[2], sh); A1.w = __builtin_amdgcn_alignbit(w1_[4], w1_[3], sh); \
                const bf16x8 a0 = __builtin_bit_cast(bf16x8, A0), a1 = __builtin_bit_cast(bf16x8, A1); \
                if (!valid0) { B00 = zero4; B01 = zero4; } \
                if (!valid1) { B10 = zero4; B11 = zero4; } \
                if (T0) acc0 = __builtin_amdgcn_mfma_f32_32x32x16_bf16(a0, __builtin_bit_cast(bf16x8, B00), acc0, 0, 0, 0); \
                if (T1) acc1 = __builtin_amdgcn_mfma_f32_32x32x16_bf16(a0, __builtin_bit_cast(bf16x8, B10), acc1, 0, 0, 0); \
                if (T0) acc0 = __builtin_amdgcn_mfma_f32_32x32x16_bf16(a1, __builtin_bit_cast(bf16x8, B01), acc0, 0, 0, 0); \
                if (T1) acc1 = __builtin_amdgcn_mfma_f32_32x32x16_bf16(a1, __builtin_bit_cast(bf16x8, B11), acc1, 0, 0, 0); \
            } while (0)
            if (nb == 8) {
#pragma unroll 1
                for (int d = -7; d <= 7; ++d) CONV_STEP(true, true);
            } else {
#pragma unroll 1
                for (int d = -63; d <= -32; ++d) CONV_STEP(true, false);
#pragma unroll 1
                for (int d = -31; d <= 31; ++d) CONV_STEP(true, true);
#pragma unroll 1
                for (int d = 32; d <= 63; ++d) CONV_STEP(false, true);
            }
#undef CONV_STEP
        }
        __syncthreads();
        {
            LAS float* ys = (LAS float*)(lds + CV_F) + wave * 2112;
            const int n = lane & 31, hh = lane >> 5;
#pragma unroll
            for (int r = 0; r < 16; ++r) { const int p = (r & 3) + 8 * (r >> 2) + 4 * hh; ys[n * 33 + p] = acc0[r]; ys[(32 + n) * 33 + p] = acc1[r]; }
        }
        __syncthreads();
        for (int rep4 = 0; rep4 < REP_CV4; ++rep4) {
            float w0[3][8], b0[8];
#pragma unroll
            for (int k = 0; k < 3; ++k)
#pragma unroll
                for (int h = 0; h < 2; ++h) { const f32x4 t0 = *(const f32x4*)(wsh + k * NMIX + c0 + 4 * h);
#pragma unroll
                    for (int e = 0; e < 4; ++e) w0[k][4 * h + e] = t0[e]; }
#pragma unroll
            for (int h = 0; h < 2; ++h) { const f32x4 t0 = *(const f32x4*)(bsh + c0 + 4 * h);
#pragma unroll
                for (int e = 0; e < 4; ++e) b0[4 * h + e] = t0[e]; }
            const u32x4 zero4 = {0u, 0u, 0u, 0u};
            const LAS float* ysb = (const LAS float*)(lds + CV_F);
            u32x4 pz[4], cz[4], nz[4];
#pragma unroll
            for (int it = 0; it < 4; ++it) { const int t = tid + 512 * it, tl = t & (L - 1);
                const bf16_t* zb = z + ((size_t)(c0 >> 3) * TT + row0 + t) * 8;
                pz[it] = tl > 0 ? *(const u32x4*)(zb - 8) : zero4; cz[it] = *(const u32x4*)zb; nz[it] = tl < L - 1 ? *(const u32x4*)(zb + 8) : zero4; }
#pragma unroll
            for (int it = 0; it < 4; ++it) { const int t = tid + 512 * it;
                float a[8], b[8], c[8], o[8];
                unpack8(pz[it], a); unpack8(cz[it], b); unpack8(nz[it], c);
#pragma unroll
                for (int e = 0; e < 8; ++e) { const float x0 = w0[0][e] * a[e] + w0[1][e] * b[e] + w0[2][e] * c[e] + b0[e]; o[e] = x0 * ysb[e * 2112 + (t >> 5) * 33 + (t & 31)]; }
                u32x4 w; w.x = cvtpk(o[0], o[1]); w.y = cvtpk(o[2], o[3]); w.z = cvtpk(o[4], o[5]); w.w = cvtpk(o[6], o[7]);
                *(u32x4*)(yh + ((size_t)(c0 >> 3) * TT + row0 + t) * 8) = w;
            }
        }
        __syncthreads();
    }
}

constexpr int AT_K = 0, AT_KROW = 272, AT_V = 64 * 272, AT_VROW = 288, AT_BUF = 64 * 272 + 64 * 288;
DI void attn_phase(LAS unsigned char* lds, int tid, int lane, int wave, int G, const bf16_t* __restrict__ z, const float* __restrict__ cache_k, const float* __restrict__ cache_v, const float* __restrict__ subln, float lam, float lam_init, bf16_t* __restrict__ yh) {
    const float C2 = 0.125f * 1.4426950408889634f;
    const int q16 = lane & 15, kg = lane >> 4;
    for (int u = blockIdx.x; u < 512; u += G) {
        int b, h, qrow0, krow0, ntile; bool sample = u < 256;
        if (sample) { b = u >> 7; h = (u >> 4) & 7; const int qb = u & 15; krow0 = TP + b * 2048; qrow0 = krow0 + qb * 128; ntile = 36; }
        else { const int v = u - 256; b = v >> 4; h = (v >> 1) & 7; const int qb = v & 1; krow0 = b * 256; qrow0 = krow0 + qb * 128; ntile = 4; }
        const float* ck = cache_k + (size_t)(b * 16 + h) * 256 * 128;
        const float* cvp = cache_v + (size_t)(b * 16 + h) * 256 * 128;
        bf16x8 q1[2], q2[2];
        { const bf16_t* qp = z + (size_t)(qrow0 + wave * 16 + q16) * NMIX + h * 128 + 8 * kg;
          q1[0] = *(const bf16x8*)qp; q1[1] = *(const bf16x8*)(qp + 32); q2[0] = *(const bf16x8*)(qp + 64); q2[1] = *(const bf16x8*)(qp + 96); }
        f32x4 O1[8], O2[8];
#pragma unroll
        for (int i = 0; i < 8; ++i) { O1[i] = (f32x4){0.f, 0.f, 0.f, 0.f}; O2[i] = (f32x4){0.f, 0.f, 0.f, 0.f}; }
        float m1 = -1e30f, m2 = -1e30f, l1 = 0.f, l2 = 0.f;
        u32x4 kv[2], vv[2];
#define AT_LOAD(KT) do { _Pragma("unroll") for (int i = 0; i < 2; ++i) { const int id = tid + 512 * i, r = id & 63, c8 = id >> 6; \
            if (sample && (KT) < 4) { \
                const float* kp = ck + (size_t)((KT) * 64 + r) * 128 + c8 * 8; const float* vp = cvp + (size_t)((KT) * 64 + r) * 128 + c8 * 8; \
                const f32x4 k0 = *(const f32x4*)kp, k1 = *(const f32x4*)(kp + 4), v0 = *(const f32x4*)vp, v1 = *(const f32x4*)(vp + 4); \
                kv[i].x = cvtpk(k0[0], k0[1]); kv[i].y = cvtpk(k0[2], k0[3]); kv[i].z = cvtpk(k1[0], k1[1]); kv[i].w = cvtpk(k1[2], k1[3]); \
                vv[i].x = cvtpk(v0[0], v0[1]); vv[i].y = cvtpk(v0[2], v0[3]); vv[i].z = cvtpk(v1[0], v1[1]); vv[i].w = cvtpk(v1[2], v1[3]); \
            } else { \
                const int kr = krow0 + (sample ? (KT) - 4 : (KT)) * 64 + r; \
                const bf16_t* kp = z + (size_t)kr * NMIX + 1024 + h * 128 + c8 * 8; \
                kv[i] = *(const u32x4*)kp; vv[i] = *(const u32x4*)(kp + 1024); \
            } } } while (0)
#define AT_STORE(BUF) do { _Pragma("unroll") for (int i = 0; i < 2; ++i) { const int id = tid + 512 * i, r = id & 63, c8 = id >> 6; \
            *(LAS u32x4*)(lds + (BUF) * AT_BUF + AT_K + r * AT_KROW + c8 * 16) = kv[i]; \
            *(LAS u32x4*)(lds + (BUF) * AT_BUF + AT_V + r * AT_VROW + c8 * 16) = vv[i]; } } while (0)
        __syncthreads();
        AT_LOAD(0); AT_STORE(0);
        if (ntile > 1) AT_LOAD(1);
        __syncthreads();
        for (int kt = 0; kt < ntile; ++kt) {
            if (kt + 1 < ntile) AT_STORE((kt + 1) & 1);
            if (kt + 2 < ntile) AT_LOAD(kt + 2);
            const LAS unsigned char* kbase = lds + (kt & 1) * AT_BUF;
            f32x4 s1[4], s2[4];
#pragma unroll
            for (int hf = 0; hf < 2; ++hf) {
                bf16x8 kf[2][4];
#pragma unroll
                for (int k2 = 0; k2 < 2; ++k2) {
                    const LAS unsigned char* kp = kbase + AT_K + (32 * hf + 8 * (q16 >> 2) + 4 * k2 + (q16 & 3)) * AT_KROW + kg * 16;
                    kf[k2][0] = *(const LAS bf16x8*)kp; kf[k2][1] = *(const LAS bf16x8*)(kp + 64); kf[k2][2] = *(const LAS bf16x8*)(kp + 128); kf[k2][3] = *(const LAS bf16x8*)(kp + 192);
                }
#pragma unroll
                for (int k2 = 0; k2 < 2; ++k2) {
                    f32x4 t = {0.f, 0.f, 0.f, 0.f}, t2 = {0.f, 0.f, 0.f, 0.f};
                    t = __builtin_amdgcn_mfma_f32_16x16x32_bf16(kf[k2][0], q1[0], t, 0, 0, 0); t2 = __builtin_amdgcn_mfma_f32_16x16x32_bf16(kf[k2][2], q2[0], t2, 0, 0, 0);
                    t = __builtin_amdgcn_mfma_f32_16x16x32_bf16(kf[k2][1], q1[1], t, 0, 0, 0); t2 = __builtin_amdgcn_mfma_f32_16x16x32_bf16(kf[k2][3], q2[1], t2, 0, 0, 0);
                    s1[2 * hf + k2] = t; s2[2 * hf + k2] = t2;
                }
            }
            float mx1 = -1e30f, mx2 = -1e30f;
#pragma unroll
            for (int ks = 0; ks < 4; ++ks)
#pragma unroll
                for (int j = 0; j < 4; ++j) { mx1 = fmaxf(mx1, s1[ks][j]); mx2 = fmaxf(mx2, s2[ks][j]); }
            { const float a = __shfl_xor(mx1, 16), b = __shfl_xor(mx2, 16); mx1 = fmaxf(mx1, a); mx2 = fmaxf(mx2, b); }
            { const float a = __shfl_xor(mx1, 32), b = __shfl_xor(mx2, 32); mx1 = fmaxf(mx1, a); mx2 = fmaxf(mx2, b); }
            const float mn1 = fmaxf(m1, mx1 * C2), mn2 = fmaxf(m2, mx2 * C2);
            const float al1 = __builtin_amdgcn_exp2f(m1 - mn1), al2 = __builtin_amdgcn_exp2f(m2 - mn2);
            m1 = mn1; m2 = mn2;
            float ps1 = 0.f, ps2 = 0.f;
#pragma unroll
            for (int ks = 0; ks < 4; ++ks)
#pragma unroll
                for (int j = 0; j < 4; ++j) { const float p1 = __builtin_amdgcn_exp2f(s1[ks][j] * C2 - mn1), p2 = __builtin_amdgcn_exp2f(s2[ks][j] * C2 - mn2); s1[ks][j] = p1; s2[ks][j] = p2; ps1 += p1; ps2 += p2; }
            l1 = l1 * al1 + ps1; l2 = l2 * al2 + ps2;
#pragma unroll
            for (int i = 0; i < 8; ++i) { O1[i] *= al1; O2[i] *= al2; }
#pragma unroll
            for (int s = 0; s < 2; ++s) {
                u32x4 pa, pb;
                pa.x = cvtpk(s1[2 * s][0], s1[2 * s][1]); pa.y = cvtpk(s1[2 * s][2], s1[2 * s][3]); pa.z = cvtpk(s1[2 * s + 1][0], s1[2 * s + 1][1]); pa.w = cvtpk(s1[2 * s + 1][2], s1[2 * s + 1][3]);
                pb.x = cvtpk(s2[2 * s][0], s2[2 * s][1]); pb.y = cvtpk(s2[2 * s][2], s2[2 * s][3]); pb.z = cvtpk(s2[2 * s + 1][0], s2[2 * s + 1][1]); pb.w = cvtpk(s2[2 * s + 1][2], s2[2 * s + 1][3]);
                const bf16x8 P1 = __builtin_bit_cast(bf16x8, pa), P2 = __builtin_bit_cast(bf16x8, pb);
                bf16x8 vf[8];
#pragma unroll
                for (int dt = 0; dt < 8; ++dt) {
                    const LAS unsigned char* vp = kbase + AT_V + (32 * s + 8 * kg + (q16 >> 2)) * AT_VROW + 32 * dt + 8 * (q16 & 3);
                    const s16x4 va = __builtin_bit_cast(s16x4, __builtin_amdgcn_ds_read_tr16_b64_v4i16((LAS s16x4*)vp));
                    const s16x4 vb = __builtin_bit_cast(s16x4, __builtin_amdgcn_ds_read_tr16_b64_v4i16((LAS s16x4*)(vp + 4 * AT_VROW)));
                    const bf16x8 vq = {va[0], va[1], va[2], va[3], vb[0], vb[1], vb[2], vb[3]};
                    vf[dt] = vq;
                }
#pragma unroll
                for (int dt = 0; dt < 8; ++dt) {
                    O1[dt] = __builtin_amdgcn_mfma_f32_16x16x32_bf16(vf[dt], P1, O1[dt], 0, 0, 0);
                    O2[dt] = __builtin_amdgcn_mfma_f32_16x16x32_bf16(vf[dt], P2, O2[dt], 0, 0, 0);
                }
            }
            __syncthreads();
        }
        l1 += __shfl_xor(l1, 16); l1 += __shfl_xor(l1, 32); l2 += __shfl_xor(l2, 16); l2 += __shfl_xor(l2, 32);
        const float r1 = 1.f / l1, r2 = lam / l2;
        float ss = 0.f;
#pragma unroll
        for (int i = 0; i < 8; ++i) { O1[i] = O1[i] * r1 - O2[i] * r2; ss += (O1[i][0] * O1[i][0] + O1[i][1] * O1[i][1]) + (O1[i][2] * O1[i][2] + O1[i][3] * O1[i][3]); }
        ss += __shfl_xor(ss, 16); ss += __shfl_xor(ss, 32);
        const float rstd = (1.f - lam_init) / sqrtf(ss * (1.f / 128.f) + EPS);
        bf16_t* op = yh + (size_t)(qrow0 + wave * 16 + q16) * D + h * 128 + 4 * kg;
#pragma unroll
        for (int i = 0; i < 8; ++i) { const f32x4 w = *(const f32x4*)(subln + 16 * i + 4 * kg); const f32x4 o = O1[i] * rstd * w;
            u32x2 pk; pk.x = cvtpk(o[0], o[1]); pk.y = cvtpk(o[2], o[3]); *(u32x2*)(op + 16 * i) = pk; }
    }
    __syncthreads();
}


#define XB_TMO      128
#define XB_XCNT(j)  (256  + 64 * (j))
#define XB_XSUB(j)  (1280 + 64 * (j))
#define XB_XGEN(j)  (2304 + 64 * (j))
#define XB_TOP      3328
#define XB_TOPGEN   3392
#define XCD_BAR_WORDS 3456
#define XB_SPIN_CAP (1u << 22)
DI unsigned xb_ld(unsigned* p)              { return __hip_atomic_load(p, __ATOMIC_RELAXED, __HIP_MEMORY_SCOPE_AGENT); }
DI unsigned xb_add(unsigned* p, unsigned v) { return __hip_atomic_fetch_add(p, v, __ATOMIC_RELAXED, __HIP_MEMORY_SCOPE_AGENT); }
DI unsigned xb_xcc_id() { return (unsigned)__builtin_amdgcn_s_getreg((3 << 11) | 20) & 0xFu; }
#define XB_SPIN(cond, bar) do { unsigned _sp = 0; while (cond) { __builtin_amdgcn_s_sleep(1); \
    if ((++_sp & 255u) == 0u) { if (xb_ld(&(bar)[XB_TMO])) break; if (_sp > XB_SPIN_CAP) { atomicAdd(&(bar)[XB_TMO], 1u); break; } } } } while (0)
DI void xcd_barrier_complete(unsigned* bar, unsigned x, unsigned& nloc, unsigned& nx) {
    const unsigned G = gridDim.x * gridDim.y * gridDim.z;
    unsigned sum, cnt, mine, sp = 0u;
    for (;;) {
        sum = 0u; cnt = 0u; mine = 0u;
#pragma unroll
        for (unsigned j = 0; j < 16; ++j) { const unsigned c = xb_ld(&bar[XB_XCNT(j)]); sum += c; cnt += (c > 0u) ? 1u : 0u; mine = (j == x) ? c : mine; }
        if (sum == G) break;
        __builtin_amdgcn_s_sleep(1);
        if ((++sp & 255u) == 0u) { if (xb_ld(&bar[XB_TMO])) break; if (sp > XB_SPIN_CAP) { atomicAdd(&bar[XB_TMO], 1u); break; } }
    }
    nloc = mine > 0u ? mine : 1u; nx = cnt > 0u ? cnt : 1u;
}
DI void xcd_barrier(unsigned* bar, volatile LAS unsigned* st) {
    asm volatile("s_waitcnt vmcnt(0)" ::: "memory");
    __syncthreads();
    if (threadIdx.x == 0) {
        const unsigned x = xb_xcc_id();
        __builtin_amdgcn_s_waitcnt(0);
        unsigned nloc = st[0], nx = st[1];
        if (nloc == 0u) { xcd_barrier_complete(bar, x, nloc, nx); st[0] = nloc; st[1] = nx; }
        const unsigned old = xb_add(&bar[XB_XSUB(x)], 1u);
        const unsigned gen = old / nloc;
        if (old + 1u == (gen + 1u) * nloc) {
            __builtin_amdgcn_fence(__ATOMIC_RELEASE, "agent");
            asm volatile("s_waitcnt vmcnt(0)" ::: "memory");
            const unsigned og = xb_add(&bar[XB_TOP], 1u);
            const unsigned tg = og / nx;
            if (og + 1u == (tg + 1u) * nx) xb_add(&bar[XB_TOPGEN], 1u);
            else XB_SPIN(xb_ld(&bar[XB_TOPGEN]) == tg, bar);
            __builtin_amdgcn_fence(__ATOMIC_ACQUIRE, "agent");
            asm volatile("s_waitcnt vmcnt(0)" ::: "memory");
        } else {
            XB_SPIN(xb_ld(&bar[XB_TOPGEN]) == gen, bar);
            __builtin_amdgcn_fence(__ATOMIC_ACQUIRE, "agent");
            asm volatile("s_waitcnt vmcnt(0)" ::: "memory");
        }
    }
    __syncthreads();
}

constexpr int N_PHASES = 30;
__global__ void __launch_bounds__(NWAVES * 64, 2) fwd_megakernel(Args a_byval) {
    extern __shared__ __attribute__((aligned(16))) unsigned char lds_raw[];
    LAS unsigned char* lds = (LAS unsigned char*)lds_raw;
    const int ph_lo = a_byval.ph_lo, ph_hi = a_byval.ph_hi;
    if (threadIdx.x < 64) ((LAS unsigned*)(lds + LDS_MISC))[threadIdx.x] = 0u;
    __syncthreads();
    if (threadIdx.x == 0) (void)xb_add((unsigned*)(a_byval.ws + WS_CTL) + XB_XCNT(xb_xcc_id()), 1u);
    for (int ph = ph_lo; ph < ph_hi; ++ph) {
        ArgsP ap = (ArgsP)__builtin_amdgcn_kernarg_segment_ptr(); asm volatile("" : "+s"(ap));
        int tid = threadIdx.x; asm volatile("" : "+v"(tid));
        unsigned char* ws = ap->ws;
        float* xout = ap->out;
        const int lane = tid & 63, wave = __builtin_amdgcn_readfirstlane(tid >> 6), G = gridDim.x;
        const int gw = blockIdx.x * NWAVES + wave, NGW = G * NWAVES;
        float* newk = xout + (size_t)TT * D; float* newv = newk + (size_t)16 * 2 * 8 * 256 * 128;
        const float* mod = (const float*)(ws + WS_MOD);
        bf16_t* zb = (bf16_t*)(ws + WS_Z); bf16_t* Y = (bf16_t*)(ws + WS_Z + 48 * MiB); float* sideb = (float*)(ws + WS_Z + 80 * MiB);
        bf16_t* hb = (bf16_t*)(ws + WS_A); bf16_t* yhb = (bf16_t*)(ws + WS_A + 16 * MiB); bf16_t* ab = (bf16_t*)(ws + WS_Z);
        const float* normw = ap->in[I_NORMW];
        if (ph == 0) {
            for (int rep = 0; rep < REP_P0; ++rep) phase0(ap, lds, tid, lane, wave, G);
        } else if (ph == N_PHASES - 1) {
            if (KON(0)) row_phase(gw, NGW, lane, xout, xout + (size_t)TP * D, xout, Y, (const float*)(ws + WS_ZERO), mod + 3 * 3 * 6144 + 5 * 1024, normw + (3 * 4 + 3) * D, nullptr, nullptr, nullptr, nullptr);
        } else {
            const int i = (ph - 1) / 7, k7 = (ph - 1) - 7 * i, kind = k7 < 6 ? k7 : 7, j = i >> 1; const bool attn = (i & 1);
            const float* modl = mod + i * 3 * 6144;
            unsigned char* wl = ws + WS_W + (size_t)i * W_LAYER;
            if (kind & 1) {
                if (KON(1)) {
                pg8::Gemm g; pg8::Order S; pg8::EpiU E;
                E.z = pg8::EpiZ{zb, NMIX, nullptr, 0}; E.q = pg8::EpiQKV{zb, (const float*)(ws + WS_ROPE), (const float*)(ws + WS_ROPE) + 2048 * 32, newk + (size_t)j * 8 * 256 * 128, newv + (size_t)j * 8 * 256 * 128};
                E.f = pg8::EpiF32{Y, D, (size_t)TT * D}; E.n = pg8::EpiFFN{ab, ap->in[I_FDW] + (size_t)i * 3 * NUP, ap->in[I_FBDW] + (size_t)i * NUP, sideb};
                if (kind == 1) { g = pg8::Gemm{hb, (const bf16_t*)(wl + W_MIX), TT, NMIX, D, 1, 0}; E.mode = attn ? 1 : 0; E.z.bias = ap->in[I_HBIN] + j * NMIX; E.z.slab = 1; }
                else if (kind == 3) { g = pg8::Gemm{yhb, (const bf16_t*)(wl + W_OUT), TT, D, D, 2, attn ? 0 : 1}; E.mode = 2; }
                else if (kind == 5) { g = pg8::Gemm{hb, (const bf16_t*)(wl + W_UP), TT, NUP, D, 1, 2}; E.mode = 3; }
                else { g = pg8::Gemm{ab, (const bf16_t*)(wl + W_DOWN), TT, D, DFF, 2, 0}; E.mode = 2; }
                S.init(g.M, g.N, g.KS, G, (int)blockIdx.x);
                if (kind == 7) { pg8::Unit u0; for (int ui = 0; S.next(ui, u0); ++ui) ffn_edge_fix(tid, u0.pm, u0.ks, sideb, ap->in[I_FDW] + (size_t)i * 3 * NUP, ab); }
                for (int rep = 0; rep < REP_GEMM; ++rep) pg8::gemm_phase(lds, tid, g, S, E);
                if (kind == 1 && i < 3 && (int)blockIdx.x >= 128 && G == 256)
                    convert_layer_weights(ap, i + 1, ((int)blockIdx.x - 128) * NWAVES + wave, 128 * NWAVES, (LAS float*)(lds + wave * 16384), lane);
                else if (kind == 1 && i < 3 && G != 256) convert_layer_weights(ap, i + 1, gw, NGW, (LAS float*)(lds + wave * 16384), lane);
                }
            } else if (kind == 0 && KON(0)) {
                if (i == 0) row_phase(gw, NGW, lane, ap->in[I_XP], ap->in[I_XS], xout, nullptr, nullptr, nullptr, nullptr, normw + (i * 4 + 0) * D, modl, modl + 1024, hb);
                else row_phase(gw, NGW, lane, xout, xout + (size_t)TP * D, xout, Y, (const float*)(ws + WS_ZERO), modl - 3 * 6144 + 5 * 1024, normw + ((i - 1) * 4 + 3) * D, normw + (i * 4 + 0) * D, modl, modl + 1024, hb);
            } else if (kind == 2) {
                if (!attn) { for (int rep = 0; rep < REP_CONV; ++rep) conv_phase(lds, tid, lane, wave, G, zb, ap->in[I_HWSH] + j * 3 * NMIX, ap->in[I_HBSH] + j * NMIX, ws + WS_FILT + (size_t)j * FILT_LAYER, yhb); }
                else if (KON(9)) {
                    float d1 = 0.f, d2 = 0.f;
                    for (int e = 0; e < 64; ++e) { d1 += ap->in[I_LQ1][j * 64 + e] * ap->in[I_LK1][j * 64 + e]; d2 += ap->in[I_LQ2][j * 64 + e] * ap->in[I_LK2][j * 64 + e]; }
                    const float lam_init = 0.8f - 0.6f * __expf(-0.3f * (float)i);
                    const float lam = __expf(d1) - __expf(d2) + lam_init;
                    for (int rep = 0; rep < REP_ATTN; ++rep) attn_phase(lds, tid, lane, wave, G, zb, ap->in[I_CK] + (size_t)j * 8 * 256 * 128, ap->in[I_CV] + (size_t)j * 8 * 256 * 128, ap->in[I_SUBLN] + j * 128, lam, lam_init, yhb);
                }
            } else if (kind == 4 && KON(0)) {
                row_phase(gw, NGW, lane, xout, xout + (size_t)TP * D, xout, Y, attn ? (const float*)(ws + WS_ZERO) : ap->in[I_HBOUT] + j * D, modl + 2 * 1024, normw + (i * 4 + 1) * D, normw + (i * 4 + 2) * D, modl + 3 * 1024, modl + 4 * 1024, hb);
            } else if (kind == 6 && KON(6)) {
                for (int rep = 0; rep < REP_ELEM; ++rep) ffn_elem_phase(blockIdx.x * 512 + tid, G * 512, zb, ap->in[I_FDW] + (size_t)i * 3 * NUP, ap->in[I_FBDW] + (size_t)i * NUP, ab);
            }
        }
        if (ph + 1 < ph_hi) {
            if (ph_hi > 4096) cg::this_grid().sync();
            for (int rep = 0; rep < REP_SYNC; ++rep) xcd_barrier((unsigned*)(ws + WS_CTL), (volatile LAS unsigned*)(lds + LDS_MISC + 32));
        }
    }
}

extern "C" void kernel_launch(void* const* d_in, const int* in_sizes, int n_in, void* d_out, int out_size, void* d_ws, size_t ws_size, hipStream_t stream) {
    static int grid = 0;
    if (grid == 0) {
        if (n_in != 33 || ws_size < WS_END) { fprintf(stderr, "kernel_launch: unexpected inputs (n_in %d, ws %zu)\n", n_in, ws_size); grid = -1; return; }
        int dev = 0, cus = 0, per_cu = 0;
        hipGetDevice(&dev); hipDeviceGetAttribute(&cus, hipDeviceAttributeMultiprocessorCount, dev);
        if (hipFuncSetAttribute((const void*)fwd_megakernel, hipFuncAttributeMaxDynamicSharedMemorySize, LDS_BYTES) != hipSuccess) { fprintf(stderr, "kernel_launch: hipFuncSetAttribute failed\n"); grid = -1; return; }
        if (hipOccupancyMaxActiveBlocksPerMultiprocessor(&per_cu, (const void*)fwd_megakernel, NWAVES * 64, LDS_BYTES) != hipSuccess || per_cu < 1) { fprintf(stderr, "kernel_launch: occupancy query says %d\n", per_cu); per_cu = 1; }
        (void)hipGetLastError();
        grid = cus * 1;
    }
    if (grid < 0) return;
    if (hipMemsetAsync((char*)d_ws + WS_CTL, 0, CTL_BYTES, stream) != hipSuccess) { fprintf(stderr, "kernel_launch: memset failed\n"); return; }
    Args a{};
    for (int i = 0; i < 33; ++i) a.in[i] = (const float*)d_in[i];
    a.out = (float*)d_out; a.ws = (unsigned char*)d_ws;
#if MK_ONE_LAUNCH
    a.ph_lo = 0; a.ph_hi = N_PHASES;
    void* args[] = {&a};
    hipError_t e = hipLaunchCooperativeKernel((const void*)fwd_megakernel, dim3(grid), dim3(NWAVES * 64), args, LDS_BYTES, stream);
    if (e != hipSuccess) fprintf(stderr, "cooperative launch failed: %s (grid %d)\n", hipGetErrorString(e), grid);
#else
    for (int ph = 0; ph < N_PHASES; ++ph) {
        a.ph_lo = ph; a.ph_hi = ph + 1;
        void* args[] = {&a};
        hipError_t e = hipLaunchCooperativeKernel((const void*)fwd_megakernel, dim3(grid), dim3(NWAVES * 64), args, LDS_BYTES, stream);
        if (e != hipSuccess) { fprintf(stderr, "launch %d failed: %s (grid %d)\n", ph, hipGetErrorString(e), grid); break; }
    }
#endif
}
```

```cpp
#include <hip/hip_runtime.h>
#include <hip/hip_cooperative_groups.h>
#include <cstdio>
#include <cstdint>
namespace cg = cooperative_groups;

#ifndef KMASK
#define KMASK 0xFFFF
#endif
#define KON(n) ((KMASK >> (n)) & 1)
#ifndef REP_P0A
#define REP_P0A 1
#endif
#ifndef REP_P0C
#define REP_P0C 1
#endif
#ifndef REP_P0D
#define REP_P0D 1
#endif
#ifndef REP_CV1
#define REP_CV1 1
#endif
#ifndef REP_CV2
#define REP_CV2 1
#endif
#ifndef REP_CV4
#define REP_CV4 1
#endif
#ifndef REP_FC
#define REP_FC 1
#endif
#ifndef REP_FS
#define REP_FS 1
#endif
#ifndef REP_GEMM
#define REP_GEMM 1
#endif
#ifndef REP_CONV
#define REP_CONV 1
#endif
#ifndef REP_ATTN
#define REP_ATTN 1
#endif
#ifndef REP_ELEM
#define REP_ELEM 1
#endif
#ifndef REP_P0
#define REP_P0 1
#endif
#ifndef REP_SYNC
#define REP_SYNC 1
#endif
#ifndef MK_ONE_LAUNCH
#define MK_ONE_LAUNCH 1
#endif

#define LAS __attribute__((address_space(3)))
typedef unsigned short bf16_t;
typedef short bf16x8 __attribute__((ext_vector_type(8)));
typedef short s16x4 __attribute__((ext_vector_type(4)));
typedef float f32x4 __attribute__((ext_vector_type(4)));
typedef float f32x16 __attribute__((ext_vector_type(16)));
typedef unsigned u32x4 __attribute__((ext_vector_type(4)));
typedef unsigned u32x2 __attribute__((ext_vector_type(2)));
typedef float f32x2_t __attribute__((ext_vector_type(2)));
typedef __bf16 bf16x2_t __attribute__((ext_vector_type(2)));

#define DI __device__ __forceinline__
DI unsigned cvtpk(float lo, float hi) { f32x2_t v = {lo, hi}; bf16x2_t b = __builtin_convertvector(v, bf16x2_t); return __builtin_bit_cast(unsigned, b); }
DI float bflo(unsigned u) { return __builtin_bit_cast(float, u << 16); }
DI float bfhi(unsigned u) { return __builtin_bit_cast(float, u & 0xffff0000u); }
DI void unpack8(u32x4 v, float* f) { f[0] = bflo(v.x); f[1] = bfhi(v.x); f[2] = bflo(v.y); f[3] = bfhi(v.y); f[4] = bflo(v.z); f[5] = bfhi(v.z); f[6] = bflo(v.w); f[7] = bfhi(v.w); }
DI float wave_sum(float v) {
#pragma unroll
    for (int o = 1; o < 64; o <<= 1) v += __shfl_xor(v, o);
    return v;
}

constexpr int D = 1024, TT = 8192, TP = 4096, DFF = 2816, NUP = 5632, NMIX = 3072;
constexpr float EPS = 1e-6f;
constexpr int NWAVES = 8;
constexpr int LDS_BYTES = 139264, LDS_MISC = 135168;

constexpr size_t MiB = 1u << 20;
constexpr size_t WS_MOD = 0;
constexpr size_t WS_CTL = 512 * 1024, CTL_BYTES = 32768, WS_ZERO = WS_CTL + 16384;
constexpr size_t WS_ROPE = 1 * MiB;
constexpr size_t WS_W = 2 * MiB;
constexpr size_t W_MIX = 0, W_OUT = 6291456, W_UP = W_OUT + 2097152, W_DOWN = W_UP + 11534336, W_LAYER = W_DOWN + 5767168;
static_assert(W_LAYER == 25690112, "layer weight bytes");
constexpr size_t WS_FILT = 100 * MiB;
constexpr size_t FILT_LAYER = 9 * MiB;
constexpr size_t WS_Z = 118 * MiB;
constexpr size_t WS_A = 206 * MiB;
constexpr size_t WS_END = 254 * MiB;
static_assert(WS_W + 4 * W_LAYER <= WS_FILT, "ws map");

namespace pg8 {
constexpr int BM = 256, BK = 64, HALF = 128, HTB = HALF * BK * 2, STAGE_BYTES = 8 * HTB, NXCD = 8, WGM = 8;
DI int lds_byte(int r, int c) { const int st = (r >> 4) * 2 + (c >> 5), rr = r & 15, cc = c & 31, ob = rr * 64 + cc * 2; return st * 1024 + (ob ^ (((ob >> 9) & 1) << 5)); }
DI void stage_rc(int b, int& R, int& C) { const int st = b / 1024, sb = b % 1024, swz = sb ^ (((sb >> 9) & 1) << 5); R = (st >> 1) * 16 + swz / 64; C = (st & 1) * 32 + (swz % 64) / 2; }
DI int perm32(int rho) { const int n = rho >> 4, i = rho & 15; return 8 * (i >> 2) + 4 * n + (i & 3); }

struct Unit { int pm, pn, ks; };
struct Gemm { const bf16_t* A; const bf16_t* Bt; int M, N, K, KS, aslab; };

struct Order {
    int nM, nN, nwg, G, c, KS;
    DI void init(int M, int N, int KS_, int G_, int c_) { nM = M / BM; nN = N / BM; nwg = nM * nN; G = G_; c = c_; KS = KS_; }
    DI bool next(int i, Unit& u) const {
        const int L = i * G + c; if (L >= nwg * KS) return false;
        u.ks = L / nwg;
        int wgid = L % nwg; { const int q = nwg / NXCD, r = nwg % NXCD, xcd = wgid % NXCD, off = wgid / NXCD; wgid = (xcd < r ? xcd * (q + 1) : r * (q + 1) + (xcd - r) * q) + off; }
        const int nig = WGM * nN, gid = wgid / nig, fm = gid * WGM, gsz = (nM - fm) < WGM ? (nM - fm) : WGM;
        u.pm = fm + ((wgid % nig) % gsz); u.pn = (wgid % nig) / gsz; return true;
    }
};

struct EpiZ {
    bf16_t* O; int ldc; const float* bias; int slab;
    DI void operator()(const f32x4 (&acc)[2][2][4][2], const Unit& u, int wr, int wc, int fr, int fq) const {
        const int row0 = u.pm * BM + wr * 64 + fr, col0 = u.pn * BM + wc * 32 + 8 * fq;
        f32x4 bv[2][2];
#pragma unroll
        for (int bj = 0; bj < 2; ++bj)
#pragma unroll
            for (int n = 0; n < 2; ++n) bv[bj][n] = bias ? *(const f32x4*)(bias + col0 + bj * HALF + 4 * n) : (f32x4){0.f, 0.f, 0.f, 0.f};
#pragma unroll
        for (int ai = 0; ai < 2; ++ai)
#pragma unroll
            for (int m = 0; m < 4; ++m) { const int row = row0 + ai * HALF + m * 16;
                bf16_t* rowp = slab ? O + ((size_t)(col0 >> 3) * TT + row) * 8 : O + (size_t)row * ldc + col0;
                const size_t bjs = slab ? (size_t)16 * TT * 8 : (size_t)HALF;
#pragma unroll
                for (int bj = 0; bj < 2; ++bj) { const f32x4 v0 = acc[ai][bj][m][0] + bv[bj][0], v1 = acc[ai][bj][m][1] + bv[bj][1];
                    u32x4 w; w.x = cvtpk(v0[0], v0[1]); w.y = cvtpk(v0[2], v0[3]); w.z = cvtpk(v1[0], v1[1]); w.w = cvtpk(v1[2], v1[3]);
                    *(u32x4*)(rowp + bj * bjs) = w; } }
    }
};

struct EpiQKV {
    bf16_t* O; const float* ropec; const float* ropes; float* newk; float* newv;
    DI void operator()(const f32x4 (&acc)[2][2][4][2], const Unit& u, int wr, int wc, int fr, int fq) const {
        const int row0 = u.pm * BM + wr * 64 + fr, col0 = u.pn * BM + wc * 32 + 8 * fq;
        const bool sample = u.pm >= 16; const int sec = u.pn >> 2;
        const bool rope = sample && sec < 2;
        const float sgn = (fq & 2) ? 1.f : -1.f;
        const int axis = (col0 >> 5) & 1, f0 = col0 & 15;
#pragma unroll
        for (int ai = 0; ai < 2; ++ai) {
#pragma unroll
          for (int mh = 0; mh < 2; ++mh) {
            f32x4 c0[2], c1[2], s0[2], s1[2];
            if (rope) {
#pragma unroll
                for (int m2 = 0; m2 < 2; ++m2) { const int tpos = (row0 + ai * HALF + (2 * mh + m2) * 16 - TP) & 2047;
                    const float* cp = ropec + tpos * 32 + axis * 16 + f0; const float* sp = ropes + tpos * 32 + axis * 16 + f0;
                    c0[m2] = *(const f32x4*)cp; c1[m2] = *(const f32x4*)(cp + 4); s0[m2] = *(const f32x4*)sp; s1[m2] = *(const f32x4*)(sp + 4); }
            }
#pragma unroll
            for (int m2 = 0; m2 < 2; ++m2) { const int m = 2 * mh + m2; const int row = row0 + ai * HALF + m * 16;
#pragma unroll
                for (int bj = 0; bj < 2; ++bj) { const int col = col0 + bj * HALF;
                    f32x4 v0 = acc[ai][bj][m][0], v1 = acc[ai][bj][m][1];
                    if (rope) {
                        f32x4 p0, p1;
#pragma unroll
                        for (int e = 0; e < 4; ++e) { p0[e] = __shfl_xor(v0[e], 32); p1[e] = __shfl_xor(v1[e], 32); }
                        v0 = v0 * c0[m2] + (p0 * s0[m2]) * sgn; v1 = v1 * c1[m2] + (p1 * s1[m2]) * sgn;
                    }
                    u32x4 w; w.x = cvtpk(v0[0], v0[1]); w.y = cvtpk(v0[2], v0[3]); w.z = cvtpk(v1[0], v1[1]); w.w = cvtpk(v1[2], v1[3]);
                    *(u32x4*)(O + (size_t)row * NMIX + col) = w;
                    if (!sample && sec >= 1) {
                        const int cc = col - sec * 1024, h = cc >> 7, d = cc & 127, b = row >> 8, t = row & 255;
                        float* dst = (sec == 1 ? newk : newv) + ((size_t)((b * 2) * 8 + h) * 256 + t) * 128 + d;
                        *(f32x4*)dst = v0; *(f32x4*)(dst + 4) = v1;
                    }
                } }
          }
        }
    }
};

struct EpiF32 {
    bf16_t* Y; int ldc; size_t kstride;
    DI void operator()(const f32x4 (&acc)[2][2][4][2], const Unit& u, int wr, int wc, int fr, int fq) const {
        const int row0 = u.pm * BM + wr * 64 + fr, col0 = u.pn * BM + wc * 32 + 8 * fq;
        bf16_t* base = Y + (size_t)u.ks * kstride;
#pragma unroll
        for (int ai = 0; ai < 2; ++ai)
#pragma unroll
            for (int m = 0; m < 4; ++m) { bf16_t* rowp = base + (size_t)(row0 + ai * HALF + m * 16) * ldc + col0;
#pragma unroll
                for (int bj = 0; bj < 2; ++bj) { const f32x4 v0 = acc[ai][bj][m][0], v1 = acc[ai][bj][m][1];
                    u32x4 w; w.x = cvtpk(v0[0], v0[1]); w.y = cvtpk(v0[2], v0[3]); w.z = cvtpk(v1[0], v1[1]); w.w = cvtpk(v1[2], v1[3]);
                    *(u32x4*)(rowp + bj * HALF) = w; } }
    }
};

DI f32x4 bperm4(int addr, const f32x4 v) {
    const float v0 = v[0], v1 = v[1], v2 = v[2], v3 = v[3];
    const int a = __builtin_amdgcn_ds_bpermute(addr, __float_as_int(v0)), b = __builtin_amdgcn_ds_bpermute(addr, __float_as_int(v1));
    const int c = __builtin_amdgcn_ds_bpermute(addr, __float_as_int(v2)), d = __builtin_amdgcn_ds_bpermute(addr, __float_as_int(v3));
    return (f32x4){__int_as_float(a), __int_as_float(b), __int_as_float(c), __int_as_float(d)};
}
struct EpiFFN {
    bf16_t* Aout; const float* wdw; const float* bdw; float* side;
    DI void operator()(const f32x4 (&acc)[2][2][4][2], const Unit& u, int wr, int wc, int fr, int fq) const {
        const int colg = u.pn * 128 + wc * 32 + 8 * fq;
        const int tok0 = u.pm * BM + 8 * (16 * wr + fr);
        const bool efirst = (fr == 0), elast = (fr == 15);
        float* sb = side + (size_t)((u.pm * 4 + wr * 2 + (elast ? 1 : 0)) * 2) * NUP;
        bf16_t* ap_ = Aout + (size_t)tok0 * DFF + colg;
#pragma unroll
        for (int n = 0; n < 2; ++n) {
            const int cg = colg + 4 * n, cv = DFF + colg + 4 * n;
            const f32x4 wg0 = *(const f32x4*)(wdw + cg), wg1 = *(const f32x4*)(wdw + NUP + cg), wg2 = *(const f32x4*)(wdw + 2 * NUP + cg), bg = *(const f32x4*)(bdw + cg);
            const f32x4 wv0 = *(const f32x4*)(wdw + cv), wv1 = *(const f32x4*)(wdw + NUP + cv), wv2 = *(const f32x4*)(wdw + 2 * NUP + cv), bv = *(const f32x4*)(bdw + cv);
            const int lane_ = fq * 16 + fr, pl = ((lane_ - 1) & 63) * 4, nl = ((lane_ + 1) & 63) * 4;
            const float mf = efirst ? 0.f : 1.f, ml = elast ? 0.f : 1.f;
            const f32x4 pg = bperm4(pl, acc[1][0][3][n]) * mf, pv = bperm4(pl, acc[1][1][3][n]) * mf;
#pragma unroll
            for (int q = 0; q < 8; ++q) {
                const f32x4 zgp = q == 0 ? pg : acc[(q - 1) >> 2][0][(q - 1) & 3][n], zgc = acc[q >> 2][0][q & 3][n], zgn = q == 7 ? bperm4(nl, acc[0][0][0][n]) * ml : acc[((q + 1) & 7) >> 2][0][(q + 1) & 3][n];
                const f32x4 zvp = q == 0 ? pv : acc[(q - 1) >> 2][1][(q - 1) & 3][n], zvc = acc[q >> 2][1][q & 3][n], zvn = q == 7 ? bperm4(nl, acc[0][1][0][n]) * ml : acc[((q + 1) & 7) >> 2][1][(q + 1) & 3][n];
                const f32x4 g = wg0 * zgp + wg1 * zgc + wg2 * zgn + bg;
                const f32x4 v = wv0 * zvp + wv1 * zvc + wv2 * zvn + bv;
                const bool edge = (q == 0 && efirst) || (q == 7 && elast);
                if ((q == 0 || q == 7) && edge) {
                    *(f32x4*)(sb + cg) = zgc; *(f32x4*)(sb + cv) = zvc; *(f32x4*)(sb + NUP + cg) = g; *(f32x4*)(sb + NUP + cv) = v;
                } else {
                    float r[4];
#pragma unroll
                    for (int e = 0; e < 4; ++e) r[e] = g[e] * __builtin_amdgcn_rcpf(1.f + __expf(-g[e])) * v[e];
                    u32x2 w; w.x = cvtpk(r[0], r[1]); w.y = cvtpk(r[2], r[3]);
                    *(u32x2*)(ap_ + (size_t)q * DFF + 4 * n) = w;
                }
            }
        }
    }
};

struct EpiU {
    int mode; EpiZ z; EpiQKV q; EpiF32 f; EpiFFN n;
    DI void operator()(const f32x4 (&acc)[2][2][4][2], const Unit& u, int wr, int wc, int fr, int fq) const {
        if (mode == 0) z(acc, u, wr, wc, fr, fq); else if (mode == 1) q(acc, u, wr, wc, fr, fq); else if (mode == 2) f(acc, u, wr, wc, fr, fq); else n(acc, u, wr, wc, fr, fq);
    }
};

template <class Epi>
DI void gemm_phase(LAS unsigned char* lds, const int tid, const Gemm g, const Order& S, const Epi& E) {
    const int wid = __builtin_amdgcn_readfirstlane(tid >> 6), lane = tid & 63, wr = wid >> 2, wc = wid & 3, fr = lane & 15, fq = lane >> 4;
    const int K = g.K, Ksub = K / g.KS, nt = Ksub / BK;
    unsigned voffA[2], voffB[2];
#pragma unroll
    for (int i = 0; i < 2; ++i) { int R, C; stage_rc(tid * 16 + i * 8192, R, C); const int Rb = (R & ~31) + perm32(R & 31);
        const int tau = 8 * ((R >> 6) * 16 + (R & 15)) + ((R >> 4) & 3);
        voffA[i] = g.aslab == 1 ? (unsigned)((C >> 3) * g.M + R) * 16u : (g.aslab == 2 ? (unsigned)(tau * K + C) * 2u : (unsigned)(R * K + C) * 2u); voffB[i] = (unsigned)(Rb * K + C) * 2u; }
    const size_t kstep = (size_t)(BK * 2);
    const size_t hstep = (size_t)HALF * K * 2;
    const size_t tstep = 2 * hstep;
    const size_t ksb = (size_t)Ksub * 2;
    const size_t kstepA = g.aslab == 1 ? (size_t)8 * g.M * 16 : kstep, hstepA = g.aslab == 1 ? (size_t)HALF * 16 : (g.aslab == 2 ? (size_t)4 * K * 2 : hstep), tstepA = g.aslab == 1 ? (size_t)BM * 16 : tstep, ksbA = g.aslab == 1 ? (size_t)(Ksub / 8) * g.M * 16 : ksb;
    const unsigned ldsw = (unsigned)wid * 1024u;
    const int aoff = lds_byte(wr * 64 + fr, fq * 8), boff = lds_byte(wc * 32 + fr, fq * 8);
#define PG8_SA(b, h) (((b) * 2 + (h)) * HTB)
#define PG8_SB(b, h) ((4 + (b) * 2 + (h)) * HTB)
#define PG8_STAGE(bufoff, gbase, voff) do { _Pragma("unroll") for (int _i = 0; _i < 2; ++_i) \
        __builtin_amdgcn_global_load_lds((const unsigned*)((const char*)(gbase) + (voff)[_i]), (LAS unsigned*)(lds + (bufoff) + ldsw + _i * 8192), 16, 0, 0); } while (0)
#define PG8_LDA(dst, b, h) do { _Pragma("unroll") for (int m = 0; m < 4; ++m) _Pragma("unroll") for (int k = 0; k < 2; ++k) dst[m][k] = *(const LAS bf16x8*)(lds + PG8_SA(b, h) + aoff + m * 2048 + k * 1024); } while (0)
#define PG8_LDB(dst, b, h) do { _Pragma("unroll") for (int n = 0; n < 2; ++n) _Pragma("unroll") for (int k = 0; k < 2; ++k) dst[n][k] = *(const LAS bf16x8*)(lds + PG8_SB(b, h) + boff + n * 2048 + k * 1024); } while (0)
#define PG8_MMA(ai, bj, At, Bt) do { __builtin_amdgcn_s_setprio(1); _Pragma("unroll") for (int m = 0; m < 4; ++m) _Pragma("unroll") for (int n = 0; n < 2; ++n) _Pragma("unroll") for (int k = 0; k < 2; ++k) \
        acc[ai][bj][m][n] = __builtin_amdgcn_mfma_f32_16x16x32_bf16(Bt[n][k], At[m][k], acc[ai][bj][m][n], 0, 0, 0); __builtin_amdgcn_s_setprio(0); } while (0)
#define PG8_WAIT_V(n) asm volatile("s_waitcnt vmcnt(" #n ")" ::: "memory")
#define PG8_WAIT_L(n) asm volatile("s_waitcnt lgkmcnt(" #n ")" ::: "memory")
#define PG8_BAR __builtin_amdgcn_s_barrier()
#define PG8_SCHED __builtin_amdgcn_sched_barrier(0)
    Unit cur, nxt; int ui = 0;
    if (!S.next(0, cur)) return;
    f32x4 acc[2][2][4][2];
#pragma unroll
    for (int a = 0; a < 2; ++a)
#pragma unroll
        for (int b = 0; b < 2; ++b)
#pragma unroll
            for (int m = 0; m < 4; ++m)
#pragma unroll
                for (int n = 0; n < 2; ++n) acc[a][b][m][n] = (f32x4){0.f, 0.f, 0.f, 0.f};
    bf16x8 At[4][2], B0[2][2], B1[2][2];
    const char* cA = (const char*)g.A + (size_t)cur.pm * tstepA + (size_t)cur.ks * ksbA; const char* cB = (const char*)g.Bt + (size_t)cur.pn * tstep + (size_t)cur.ks * ksb;
    PG8_STAGE(PG8_SB(0, 0), cB, voffB); PG8_STAGE(PG8_SB(0, 1), cB + hstep, voffB); PG8_STAGE(PG8_SA(0, 0), cA, voffA); PG8_STAGE(PG8_SA(0, 1), cA + hstepA, voffA);
    if (wr == 1) PG8_BAR;
    PG8_WAIT_V(2); PG8_BAR;
    PG8_STAGE(PG8_SB(1, 0), cB + kstep, voffB); PG8_STAGE(PG8_SA(1, 0), cA + kstepA, voffA); PG8_STAGE(PG8_SB(1, 1), cB + hstep + kstep, voffB);
    PG8_WAIT_V(6); PG8_BAR;
    for (;;) {
        const bool has_next = S.next(ui + 1, nxt);
        const char* nA = has_next ? (const char*)g.A + (size_t)nxt.pm * tstepA + (size_t)nxt.ks * ksbA : cA; const char* nB = has_next ? (const char*)g.Bt + (size_t)nxt.pn * tstep + (size_t)nxt.ks * ksb : cB;
        for (int t = 0; t < nt; t += 2) {
            const bool last = (t == nt - 2);
            const char* a1 = cA + (size_t)(t + 1) * kstepA;
            const char* a2 = last ? nA : cA + (size_t)(t + 2) * kstepA; const char* b2 = last ? nB : cB + (size_t)(t + 2) * kstep;
            const char* a3 = a2 + kstepA; const char* b3 = b2 + kstep;
            PG8_LDB(B0, 0, 0); PG8_LDB(B1, 0, 1); PG8_SCHED; PG8_LDA(At, 0, 0); PG8_STAGE(PG8_SA(1, 1), a1 + hstepA, voffA);
            PG8_WAIT_V(8); PG8_WAIT_L(0); PG8_BAR; PG8_MMA(0, 0, At, B0); PG8_MMA(0, 1, At, B1); PG8_BAR; PG8_SCHED;
            PG8_LDA(At, 0, 1); PG8_STAGE(PG8_SB(0, 0), b2, voffB); PG8_STAGE(PG8_SB(0, 1), b2 + hstep, voffB); PG8_STAGE(PG8_SA(0, 0), a2, voffA);
            PG8_WAIT_V(8); PG8_WAIT_L(0); PG8_BAR; PG8_MMA(1, 0, At, B0); PG8_MMA(1, 1, At, B1); PG8_BAR; PG8_SCHED;
            PG8_LDB(B0, 1, 0); PG8_LDB(B1, 1, 1); PG8_SCHED; PG8_LDA(At, 1, 0); PG8_STAGE(PG8_SA(0, 1), a2 + hstepA, voffA);
            PG8_WAIT_V(8); PG8_WAIT_L(0); PG8_BAR; PG8_MMA(0, 0, At, B0); PG8_MMA(0, 1, At, B1); PG8_BAR; PG8_SCHED;
            PG8_LDA(At, 1, 1); PG8_STAGE(PG8_SB(1, 0), b3, voffB); PG8_STAGE(PG8_SB(1, 1), b3 + hstep, voffB); PG8_STAGE(PG8_SA(1, 0), a3, voffA);
            PG8_WAIT_V(8); PG8_WAIT_L(0); PG8_BAR; PG8_MMA(1, 0, At, B0); PG8_MMA(1, 1, At, B1); PG8_BAR; PG8_SCHED;
        }
        if (wr == 0) PG8_BAR;
        E(acc, cur, wr, wc, fr, fq);
        if (!has_next) break;
#pragma unroll
        for (int a = 0; a < 2; ++a)
#pragma unroll
            for (int b = 0; b < 2; ++b)
#pragma unroll
                for (int m = 0; m < 4; ++m)
#pragma unroll
                    for (int n = 0; n < 2; ++n) acc[a][b][m][n] = (f32x4){0.f, 0.f, 0.f, 0.f};
        cur = nxt; cA = nA; cB = nB; ++ui;
        if (wr == 1) PG8_BAR;
    }
    PG8_WAIT_V(0);
    PG8_BAR;
#undef PG8_SA
#undef PG8_SB
#undef PG8_STAGE
#undef PG8_LDA
#undef PG8_LDB
#undef PG8_MMA
#undef PG8_WAIT_V
#undef PG8_WAIT_L
#undef PG8_BAR
#undef PG8_SCHED
}
}

struct Args { const float* in[33]; float* out; unsigned char* ws; int ph_lo, ph_hi; };
enum { I_XP = 0, I_XS, I_CK, I_CV, I_C, I_CCTX, I_WADA, I_BADA, I_NORMW, I_HWIN, I_HBIN, I_HWSH, I_HBSH, I_FW1, I_FB1, I_FFREQ, I_FW2, I_FB2, I_FW3, I_DBIAS, I_HWOUT, I_HBOUT,
       I_AWQKV, I_AWOUT, I_LQ1, I_LK1, I_LQ2, I_LK2, I_SUBLN, I_FUP, I_FDW, I_FBDW, I_FDOWN };

DI int up_row(int n) { return n < DFF ? (n >> 7) * 256 + (n & 127) : ((n - DFF) >> 7) * 256 + 128 + ((n - DFF) & 127); }
DI void p0_transpose_item(const float* W, int K, int N, bf16_t* WT, LAS float* scr, int item, int lane, bool perm_up = false) {
    const int nblk = N / 32, kb = item / nblk, nb = item % nblk, k0 = 64 * kb, n0 = 32 * nb;
    float wv[32];
#pragma unroll
    for (int i = 0; i < 32; ++i) { const int kk = 2 * i + (lane >> 5); wv[i] = W[(size_t)(k0 + kk) * N + n0 + (lane & 31)]; }
#pragma unroll
    for (int i = 0; i < 32; ++i) { const int kk = 2 * i + (lane >> 5); scr[kk * 33 + (lane & 31)] = wv[i]; }
    asm volatile("s_waitcnt lgkmcnt(0)" ::: "memory");
    const int c = lane & 7;
#pragma unroll
    for (int j = 0; j < 4; ++j) { const int n = (lane >> 3) + 8 * j; const LAS float* s = scr + (8 * c) * 33 + n;
        u32x4 o; o.x = cvtpk(s[0 * 33], s[1 * 33]); o.y = cvtpk(s[2 * 33], s[3 * 33]); o.z = cvtpk(s[4 * 33], s[5 * 33]); o.w = cvtpk(s[6 * 33], s[7 * 33]);
        *(u32x4*)(WT + (size_t)(perm_up ? up_row(n0) + n : n0 + n) * K + k0 + 8 * c) = o; }
    asm volatile("s_waitcnt lgkmcnt(0)" ::: "memory");
}

typedef const __attribute__((address_space(4))) Args* ArgsP;
constexpr int I_MIX = 16 * 96, I_OUT = 16 * 32, I_UP = 16 * 176, I_DOWN = 44 * 32, I_LAYER = I_MIX + I_OUT + I_UP + I_DOWN;
DI void convert_layer_weights(ArgsP ap, int i0, int gwl, int NGWL, LAS float* scr, int lane, int lo, int hi) {
    for (int itv = lo + gwl; itv < hi; itv += NGWL) {
        const int i = itv < I_LAYER ? i0 : i0 + 1, jj = i >> 1;
        unsigned char* wl = ap->ws + WS_W + (size_t)i * W_LAYER;
        int r = itv < I_LAYER ? itv : itv - I_LAYER;
        if (r < I_MIX) { const float* W = (i & 1) ? ap->in[I_AWQKV] + (size_t)jj * 1024 * 3072 : ap->in[I_HWIN] + (size_t)jj * 1024 * 3072; p0_transpose_item(W, 1024, 3072, (bf16_t*)(wl + W_MIX), scr, r, lane); continue; } r -= I_MIX;
        if (r < I_OUT) { const float* W = (i & 1) ? ap->in[I_AWOUT] + (size_t)jj * 1024 * 1024 : ap->in[I_HWOUT] + (size_t)jj * 1024 * 1024; p0_transpose_item(W, 1024, 1024, (bf16_t*)(wl + W_OUT), scr, r, lane); continue; } r -= I_OUT;
        if (r < I_UP) { p0_transpose_item(ap->in[I_FUP] + (size_t)i * 1024 * 5632, 1024, 5632, (bf16_t*)(wl + W_UP), scr, r, lane, true); continue; } r -= I_UP;
        p0_transpose_item(ap->in[I_FDOWN] + (size_t)i * 2816 * 1024, 2816, 1024, (bf16_t*)(wl + W_DOWN), scr, r, lane);
    }
}

DI void phase0(ArgsP ap, LAS unsigned char* lds, int tid, int lane, int wave, int G) {
    unsigned char* ws = ap->ws;
    LAS float* sl = (LAS float*)lds;
    LAS float* red = sl + 3072;
    for (int idx = tid; idx < 3072; idx += 512) { const int cnd = idx >> 10, k = idx & 1023; const float v = cnd == 0 ? ap->in[I_CCTX][k] : ap->in[I_C][(cnd - 1) * 1024 + k]; sl[idx] = v / (1.f + __expf(-v)); }
    __syncthreads();
    float* mod = (float*)(ws + WS_MOD);
    for (int rep = 0; rep < REP_P0A; ++rep)
    for (int item = blockIdx.x; item < 384; item += G) {
        const int i = item / 96, n0 = (item % 96) * 64;
        const float* W = ap->in[I_WADA] + (size_t)i * 1024 * 6144 + n0 + lane;
        float a0 = 0.f, a1 = 0.f, a2 = 0.f; const int k0 = wave * 128;
#pragma unroll 16
        for (int kk = 0; kk < 128; ++kk) { const float w = W[(size_t)(k0 + kk) * 6144]; a0 += sl[k0 + kk] * w; a1 += sl[1024 + k0 + kk] * w; a2 += sl[2048 + k0 + kk] * w; }
        red[(wave * 3 + 0) * 64 + lane] = a0; red[(wave * 3 + 1) * 64 + lane] = a1; red[(wave * 3 + 2) * 64 + lane] = a2;
        __syncthreads();
        if (tid < 192) { const int cnd = tid >> 6, l = tid & 63; float s = 0.f;
#pragma unroll
            for (int w = 0; w < 8; ++w) s += red[(w * 3 + cnd) * 64 + l];
            mod[(i * 3 + cnd) * 6144 + n0 + l] = s + ap->in[I_BADA][i * 6144 + n0 + l]; }
        __syncthreads();
    }
    __syncthreads();
    { float* rc = (float*)(ws + WS_ROPE); float* rs = rc + 2048 * 32;
      for (int idx = blockIdx.x * 512 + tid; idx < 2048 * 32; idx += G * 512) { const int t = idx >> 5, e = idx & 31, ax = e >> 4, f = e & 15;
          const float pos = (float)(ax == 0 ? (t >> 6) : (t & 63)); const float inv = __builtin_amdgcn_exp2f(-(float)f * (13.287712379549449f / 16.f)); const float ang = pos * inv;
          rc[idx] = __cosf(ang); rs[idx] = __sinf(ang); } }
    const int gw = blockIdx.x * NWAVES + wave, NGW = G * NWAVES;
    constexpr int FW_L = 33 * 64 + 64 * 64 + 192;
    LAS float* fw = (LAS float*)lds;
    for (int jj = 0; jj < 2; ++jj) {
        LAS float* f = fw + jj * FW_L;
        { float v[5];
#pragma unroll
          for (int k = 0; k < 5; ++k) { const int r = tid + 512 * k; v[k] = r < 2112 ? ap->in[I_FW1][jj * 2112 + r] : 0.f; }
#pragma unroll
          for (int k = 0; k < 5; ++k) { const int r = tid + 512 * k; if (r < 2112) f[r] = v[k]; } }
        { float v[8];
#pragma unroll
          for (int k = 0; k < 8; ++k) v[k] = ap->in[I_FW2][jj * 4096 + tid + 512 * k];
#pragma unroll
          for (int k = 0; k < 8; ++k) f[2112 + tid + 512 * k] = v[k]; }
        if (tid < 64) { f[6208 + tid] = ap->in[I_FB1][jj * 64 + tid]; f[6272 + tid] = ap->in[I_FB2][jj * 64 + tid]; f[6336 + tid] = ap->in[I_FFREQ][jj * 64 + tid]; }
    }
    __syncthreads();
    LAS float* hs = (LAS float*)(lds + 51200 + wave * 2048);
    LAS float* w3s = (LAS float*)(lds + 67584);
    const int fgrp = blockIdx.x & 15, fsub = blockIdx.x >> 4, fnb = (G + 15 - fgrp) >> 4;
    const int j = fgrp >> 3, half = (fgrp >> 2) & 1, ch4 = fgrp & 3;
    { const float* src = ap->in[I_FW3] + (size_t)j * 64 * 2048 + half * 1024 + ch4 * 256 + (tid >> 3) * 2048 + (tid & 7) * 32;
      f32x4 t[8];
#pragma unroll
      for (int k = 0; k < 8; ++k) t[k] = *(const f32x4*)(src + 4 * k);
#pragma unroll
      for (int k = 0; k < 8; ++k) *(LAS f32x4*)(w3s + (tid >> 3) * 256 + (tid & 7) * 32 + 4 * k) = t[k]; }
    __syncthreads();
    for (int rep = 0; rep < REP_P0C; ++rep)
    for (int pbx = fsub + fnb * wave; pbx < 288; pbx += fnb * NWAVES) {
        int L, pb;
        if (pbx < 256) { L = 2048; pb = pbx; } else { L = 256; pb = pbx - 256; }
        const LAS float* w1 = fw + j * FW_L; const LAS float* w2 = w1 + 2112; const LAS float* b1 = w1 + 6208; const LAS float* b2 = w1 + 6272; const LAS float* fq = w1 + 6336;
        const int t0 = pb * 8 + half;
        float zv[8], h1[8], h2[8];
        const float fr = fq[lane];
        for (int repc = 0; repc < REP_FC; ++repc) {
#pragma unroll
        for (int p = 0; p < 8; ++p) { int t = t0 + p; if (t > L - 1) t = L - 1;
            const float tn = (float)t / (float)(L - 1); const float w = 6.283185307179586f * (float)t / (float)L;
            float z = 0.f;
            if (lane == 0) z = tn;
            else if (lane <= 16) { const float band = 1e-4f + (float)(lane - 1) * ((15.f - 1e-4f) / 15.f); z = __cosf(band * w); }
            else if (lane <= 32) { const float band = 1e-4f + (float)(lane - 17) * ((15.f - 1e-4f) / 15.f); z = -__sinf(band * w); }
            zv[p] = z; h1[p] = b1[lane]; h2[p] = b2[lane]; }
#pragma unroll 3
        for (int e = 0; e < 33; ++e) { const float w = w1[e * 64 + lane];
#pragma unroll
            for (int p = 0; p < 8; ++p) h1[p] += __builtin_bit_cast(float, __builtin_amdgcn_readlane(__builtin_bit_cast(int, zv[p]), e)) * w; }
#pragma unroll
        for (int p = 0; p < 8; ++p) h1[p] = __sinf(fr * h1[p]);
#pragma unroll 4
        for (int i = 0; i < 64; ++i) { const float w = w2[i * 64 + lane];
#pragma unroll
            for (int p = 0; p < 8; ++p) h2[p] += __builtin_bit_cast(float, __builtin_amdgcn_readlane(__builtin_bit_cast(int, h1[p]), i)) * w; }
#pragma unroll
        for (int p = 0; p < 8; ++p) hs[lane * 8 + p] = __sinf(fr * h2[p]);
        }
        asm volatile("s_waitcnt lgkmcnt(0)" ::: "memory");
        float acc[4][8];
#pragma unroll
        for (int q = 0; q < 4; ++q)
#pragma unroll
            for (int p = 0; p < 8; ++p) acc[q][p] = 0.f;
#pragma unroll 4
        for (int i = 0; i < 64; ++i) {
            const f32x4 ha = *(const LAS f32x4*)(hs + i * 8), hb = *(const LAS f32x4*)(hs + i * 8 + 4);
#pragma unroll
            for (int q = 0; q < 4; ++q) { const float w = w3s[i * 256 + q * 64 + lane];
                acc[q][0] += ha[0] * w; acc[q][1] += ha[1] * w; acc[q][2] += ha[2] * w; acc[q][3] += ha[3] * w;
                acc[q][4] += hb[0] * w; acc[q][5] += hb[1] * w; acc[q][6] += hb[2] * w; acc[q][7] += hb[3] * w; }
        }
        asm volatile("s_waitcnt lgkmcnt(0)" ::: "memory");
        bf16_t* Fg = (bf16_t*)(ws + WS_FILT + (size_t)j * FILT_LAYER + (L == 2048 ? MiB : 0));
        const float mind = -3.0701134573253945f, maxd = -15.350567286626973f;
        for (int reps = 0; reps < REP_FS; ++reps)
#pragma unroll
        for (int q = 0; q < 4; ++q) { const int ch = ch4 * 256 + q * 64 + lane;
            const float ad = -(mind + (maxd - mind) * ((float)ch / 1023.f));
            float v[8];
#pragma unroll
            for (int p = 0; p < 8; ++p) { const int t = t0 + p; const float tn = (float)t / (float)(L - 1);
                float x = acc[q][p] * __expf(-tn * ad); if (t > L - 1) x = 0.f; if (half == 0 && t == 0) x += ap->in[I_DBIAS][j * 1024 + ch]; v[p] = x; }
            u32x4 o;
            if (half == 0) { o.x = cvtpk(v[7], v[6]); o.y = cvtpk(v[5], v[4]); o.z = cvtpk(v[3], v[2]); o.w = cvtpk(v[1], v[0]);
                *(u32x4*)(Fg + (size_t)ch * (2 * L) + (L - 8 - pb * 8)) = o; }
            else { o.x = cvtpk(v[0], v[1]); o.y = cvtpk(v[2], v[3]); o.z = cvtpk(v[4], v[5]); o.w = cvtpk(v[6], v[7]);
                *(u32x4*)(Fg + (size_t)ch * (2 * L) + (L + pb * 8)) = o; }
        }
    }
    __syncthreads();
    for (int rep = 0; rep < REP_P0D; ++rep) convert_layer_weights(ap, 0, gw, NGW, (LAS float*)(lds + wave * 16384), lane, 0, I_MIX);
    __syncthreads();
}

DI void row_phase(int gw, int NGW, int lane, const float* __restrict__ xP, const float* __restrict__ xS, float* __restrict__ xout, const bf16_t* __restrict__ Y, const float* __restrict__ ybias,
                  const float* __restrict__ modgate, const float* __restrict__ w_post, const float* __restrict__ w_pre, const float* __restrict__ modshift, const float* __restrict__ modscale, bf16_t* __restrict__ hout) {
    for (int m = gw; m < TT; m += NGW) {
        const int cnd = m < TP ? 0 : 1 + ((m - TP) >> 11);
        const float* xr = m < TP ? xP + (size_t)m * D : xS + (size_t)(m - TP) * D;
        f32x4 x[4], ya[4], bb[4], g[4], wp[4], wn[4], sh[4], sc[4]; u32x2 pa[4], pb[4];
#pragma unroll
        for (int j = 0; j < 4; ++j) x[j] = ((const f32x4*)xr)[lane + 64 * j];
        if (Y) {
#pragma unroll
            for (int j = 0; j < 4; ++j) { pa[j] = ((const u32x2*)(Y + (size_t)m * D))[lane + 64 * j]; pb[j] = ((const u32x2*)(Y + (size_t)TT * D + (size_t)m * D))[lane + 64 * j];
                bb[j] = ((const f32x4*)ybias)[lane + 64 * j]; g[j] = ((const f32x4*)(modgate + cnd * 6144))[lane + 64 * j]; wp[j] = ((const f32x4*)w_post)[lane + 64 * j]; }
        }
        if (hout) {
#pragma unroll
            for (int j = 0; j < 4; ++j) { wn[j] = ((const f32x4*)w_pre)[lane + 64 * j]; sh[j] = ((const f32x4*)(modshift + cnd * 6144))[lane + 64 * j]; sc[j] = ((const f32x4*)(modscale + cnd * 6144))[lane + 64 * j]; }
        }
        if (Y) {
            float ss = 0.f;
#pragma unroll
            for (int j = 0; j < 4; ++j) { ya[j] = (f32x4){bflo(pa[j].x) + bflo(pb[j].x), bfhi(pa[j].x) + bfhi(pb[j].x), bflo(pa[j].y) + bflo(pb[j].y), bfhi(pa[j].y) + bfhi(pb[j].y)} + bb[j]; ss += (ya[j].x * ya[j].x + ya[j].y * ya[j].y) + (ya[j].z * ya[j].z + ya[j].w * ya[j].w); }
            ss = wave_sum(ss); const float rstd = 1.f / sqrtf(ss * (1.f / D) + EPS);
#pragma unroll
            for (int j = 0; j < 4; ++j) x[j] += g[j] * (ya[j] * rstd * wp[j]);
        }
        u32x2 o[4];
        if (hout) {
            float ss = 0.f;
#pragma unroll
            for (int j = 0; j < 4; ++j) ss += (x[j].x * x[j].x + x[j].y * x[j].y) + (x[j].z * x[j].z + x[j].w * x[j].w);
            ss = wave_sum(ss); const float rstd = 1.f / sqrtf(ss * (1.f / D) + EPS);
#pragma unroll
            for (int j = 0; j < 4; ++j) { const f32x4 h = (x[j] * rstd * wn[j]) * (sc[j] + 1.f) + sh[j]; o[j].x = cvtpk(h.x, h.y); o[j].y = cvtpk(h.z, h.w); }
        }
#pragma unroll
        for (int j = 0; j < 4; ++j) ((f32x4*)(xout + (size_t)m * D))[lane + 64 * j] = x[j];
        if (hout) {
#pragma unroll
            for (int j = 0; j < 4; ++j) ((u32x2*)(hout + (size_t)m * D))[lane + 64 * j] = o[j];
        }
    }
}

DI void ffn_elem_phase(int gtid, int NT, const bf16_t* __restrict__ z, const float* __restrict__ wdw, const float* __restrict__ bdw, bf16_t* __restrict__ aout) {
    for (int item = gtid; item < 2048 * 352; item += NT) {
        const int r = item / 352, cc = item - r * 352, row0 = 4 * r;
        const int L = row0 < TP ? 256 : 2048, tl0 = row0 & (L - 1);
        float wg[3][8], wv[3][8], bg[8], bv[8];
#pragma unroll
        for (int k = 0; k < 3; ++k)
#pragma unroll
            for (int h = 0; h < 2; ++h) { const f32x4 t0 = *(const f32x4*)(wdw + k * NUP + 8 * cc + 4 * h), t1 = *(const f32x4*)(wdw + k * NUP + DFF + 8 * cc + 4 * h);
#pragma unroll
                for (int e = 0; e < 4; ++e) { wg[k][4 * h + e] = t0[e]; wv[k][4 * h + e] = t1[e]; } }
#pragma unroll
        for (int h = 0; h < 2; ++h) { const f32x4 t0 = *(const f32x4*)(bdw + 8 * cc + 4 * h), t1 = *(const f32x4*)(bdw + DFF + 8 * cc + 4 * h);
#pragma unroll
            for (int e = 0; e < 4; ++e) { bg[4 * h + e] = t0[e]; bv[4 * h + e] = t1[e]; } }
        const bf16_t* zb = z + (size_t)row0 * NUP + 8 * cc;
        const u32x4 zero4 = {0u, 0u, 0u, 0u};
        u32x4 rg[6], rv[6];
        rg[0] = tl0 > 0 ? *(const u32x4*)(zb - NUP) : zero4; rv[0] = tl0 > 0 ? *(const u32x4*)(zb - NUP + DFF) : zero4;
#pragma unroll
        for (int k = 0; k < 4; ++k) { rg[1 + k] = *(const u32x4*)(zb + (size_t)k * NUP); rv[1 + k] = *(const u32x4*)(zb + (size_t)k * NUP + DFF); }
        { const bool has_next = (tl0 + 4) < L; rg[5] = has_next ? *(const u32x4*)(zb + (size_t)4 * NUP) : zero4; rv[5] = has_next ? *(const u32x4*)(zb + (size_t)4 * NUP + DFF) : zero4; }
        u32x4 wout[4];
#pragma unroll
        for (int k = 0; k < 4; ++k) {
            float pg[8], pv[8], cg_[8], cv[8], ng[8], nv[8], o[8];
            unpack8(rg[k], pg); unpack8(rv[k], pv); unpack8(rg[k + 1], cg_); unpack8(rv[k + 1], cv); unpack8(rg[k + 2], ng); unpack8(rv[k + 2], nv);
#pragma unroll
            for (int e = 0; e < 8; ++e) { const float g = wg[0][e] * pg[e] + wg[1][e] * cg_[e] + wg[2][e] * ng[e] + bg[e]; const float v = wv[0][e] * pv[e] + wv[1][e] * cv[e] + wv[2][e] * nv[e] + bv[e];
                o[e] = (g / (1.f + __expf(-g))) * v; }
            wout[k].x = cvtpk(o[0], o[1]); wout[k].y = cvtpk(o[2], o[3]); wout[k].z = cvtpk(o[4], o[5]); wout[k].w = cvtpk(o[6], o[7]);
        }
#pragma unroll
        for (int k = 0; k < 4; ++k) *(u32x4*)(aout + (size_t)(row0 + k) * DFF + 8 * cc) = wout[k];
    }
}

DI void ffn_edge_fix(int tid, int pm, int ks, const float* __restrict__ side, const float* __restrict__ wdw, bf16_t* __restrict__ aout) {
    const bool sample = pm >= 16; const int st = (pm - 16) & 7;
    float pg[11], pv[11], og[11], ov[11], wg[11], wv[11];
#pragma unroll
    for (int k = 0; k < 11; ++k) {
        const int idx = tid + 512 * k, e = idx / 1408, n = ks * 1408 + (idx - e * 1408);
        const float* mine = side + (size_t)((pm * 4 + e) * 2) * NUP;
        int pt = -1, tap = 0;
        if (e == 1) { pt = pm * 4 + 2; tap = 2; } else if (e == 2) { pt = pm * 4 + 1; tap = 0; }
        else if (e == 0) { if (sample && st != 0) { pt = (pm - 1) * 4 + 3; tap = 0; } }
        else { if (sample && st != 7) { pt = (pm + 1) * 4 + 0; tap = 2; } }
        const float* o = side + (size_t)((pt < 0 ? pm * 4 + e : pt) * 2) * NUP;
        const float msk = pt < 0 ? 0.f : 1.f;
        pg[k] = mine[NUP + n]; pv[k] = mine[NUP + DFF + n];
        og[k] = o[n] * msk; ov[k] = o[DFF + n] * msk;
        wg[k] = wdw[tap * NUP + n]; wv[k] = wdw[tap * NUP + DFF + n];
    }
#pragma unroll
    for (int k = 0; k < 11; ++k) {
        const int idx = tid + 512 * k, e = idx / 1408, n = ks * 1408 + (idx - e * 1408);
        const float g = pg[k] + wg[k] * og[k], v = pv[k] + wv[k] * ov[k];
        const float r = g * __builtin_amdgcn_rcpf(1.f + __expf(-g)) * v;
        const int tok = pm * 256 + (e == 0 ? 0 : (e == 1 ? 127 : (e == 2 ? 128 : 255)));
        aout[(size_t)tok * DFF + n] = (bf16_t)(cvtpk(r, 0.f) & 0xffffu);
    }
    asm volatile("s_waitcnt vmcnt(0)" ::: "memory");
    __syncthreads();
}

constexpr int CV_G = 0, CV_GCH = 5120, CV_F = 40960, CV_FCH = 8192;
DI void conv_phase(LAS unsigned char* lds, int tid, int lane, int wave, int G, const bf16_t* __restrict__ z, const float* __restrict__ wsh, const float* __restrict__ bsh, const unsigned char* __restrict__ filt, bf16_t* __restrict__ yh) {
    for (int u = blockIdx.x; u < 512; u += G) {
        const int grp = u < 256 ? 2 + (u >> 7) : ((u - 256) >> 7), c0 = (u & 127) * 8;
        const int row0 = grp * 2048, L = grp < 2 ? 256 : 2048, nb = L >> 5;
        for (int rep1 = 0; rep1 < REP_CV1; ++rep1) {
            float w1[3][8], wv[3][8], b1[8], bv[8];
#pragma unroll
            for (int k = 0; k < 3; ++k)
#pragma unroll
                for (int h = 0; h < 2; ++h) { const f32x4 t0 = *(const f32x4*)(wsh + k * NMIX + 1024 + c0 + 4 * h), t1 = *(const f32x4*)(wsh + k * NMIX + 2048 + c0 + 4 * h);
#pragma unroll
                    for (int e = 0; e < 4; ++e) { w1[k][4 * h + e] = t0[e]; wv[k][4 * h + e] = t1[e]; } }
#pragma unroll
            for (int h = 0; h < 2; ++h) { const f32x4 t0 = *(const f32x4*)(bsh + 1024 + c0 + 4 * h), t1 = *(const f32x4*)(bsh + 2048 + c0 + 4 * h);
#pragma unroll
                for (int e = 0; e < 4; ++e) { b1[4 * h + e] = t0[e]; bv[4 * h + e] = t1[e]; } }
            const u32x4 zero4 = {0u, 0u, 0u, 0u};
            for (int idx = tid; idx < 2048; idx += 512) {
                const int tl = idx & (L - 1);
                const bf16_t* z1 = z + ((size_t)(128 + (c0 >> 3)) * TT + row0 + idx) * 8; const bf16_t* zv = z + ((size_t)(256 + (c0 >> 3)) * TT + row0 + idx) * 8;
                const u32x4 p1 = tl > 0 ? *(const u32x4*)(z1 - 8) : zero4, pv_ = tl > 0 ? *(const u32x4*)(zv - 8) : zero4;
                const u32x4 q1 = *(const u32x4*)z1, qv = *(const u32x4*)zv;
                const u32x4 n1 = tl < L - 1 ? *(const u32x4*)(z1 + 8) : zero4, nv = tl < L - 1 ? *(const u32x4*)(zv + 8) : zero4;
                float a[8], b[8], c[8], d[8], e_[8], f[8];
                unpack8(p1, a); unpack8(q1, b); unpack8(n1, c); unpack8(pv_, d); unpack8(qv, e_); unpack8(nv, f);
                LAS bf16_t* gp = (LAS bf16_t*)(lds + CV_G + (idx >> 5) * 80 + (idx & 31) * 2);
#pragma unroll
                for (int e = 0; e < 8; ++e) { const float x1 = w1[0][e] * a[e] + w1[1][e] * b[e] + w1[2][e] * c[e] + b1[e]; const float v = wv[0][e] * d[e] + wv[1][e] * e_[e] + wv[2][e] * f[e] + bv[e];
                    gp[e * (CV_GCH / 2)] = (bf16_t)(cvtpk(v * x1, 0.f) & 0xffffu); }
            }
            const u32x4* fsrc = (const u32x4*)(filt + (L == 2048 ? MiB : 0) + (size_t)(c0 + wave) * (size_t)(4 * L));
            LAS u32x4* fdst = (LAS u32x4*)(lds + CV_F + wave * CV_FCH);
            if (L == 2048) { u32x4 fv[8];
#pragma unroll
                for (int i = 0; i < 8; ++i) fv[i] = fsrc[lane + 64 * i];
#pragma unroll
                for (int i = 0; i < 8; ++i) fdst[lane + 64 * i] = fv[i]; }
            else fdst[lane] = fsrc[lane];
        }
        __syncthreads();
        f32x16 acc0, acc1;
        for (int rep2 = 0; rep2 < REP_CV2; ++rep2) {
#pragma unroll
        for (int i = 0; i < 16; ++i) { acc0[i] = 0.f; acc1[i] = 0.f; }
            const int p = lane & 31, kg = lane >> 5;
            const LAS unsigned char* Fw = lds + CV_F + wave * CV_FCH;
            const LAS unsigned char* Gw = lds + CV_G + wave * CV_GCH;
            const int bi0 = p & (nb - 1), bi1 = (32 + p) & (nb - 1);
            const u32x4 zero4 = {0u, 0u, 0u, 0u};
#define CONV_STEP(T0, T1) do { \
                const int s0 = L - 1 - 32 * d - p + 8 * kg; \
                const LAS unsigned* fp = (const LAS unsigned*)Fw + (s0 >> 1); \
                const unsigned sh = (s0 & 1) * 16; \
                unsigned w0[5], w1_[5]; \
                _Pragma("unroll") for (int i = 0; i < 5; ++i) { w0[i] = fp[i]; w1_[i] = fp[8 + i]; } \
                int blk0 = p - d; blk0 = blk0 < 0 ? 0 : (blk0 > 63 ? 63 : blk0); \
                int blk1 = 32 + p - d; blk1 = blk1 < 0 ? 0 : (blk1 > 63 ? 63 : blk1); \
                const LAS unsigned char* bp0 = Gw + blk0 * 80 + kg * 16; const LAS unsigned char* bp1 = Gw + blk1 * 80 + kg * 16; \
                u32x4 B00 = zero4, B01 = zero4, B10 = zero4, B11 = zero4; \
                if (T0) { B00 = *(const LAS u32x4*)bp0; B01 = *(const LAS u32x4*)(bp0 + 32); } \
                if (T1) { B10 = *(const LAS u32x4*)bp1; B11 = *(const LAS u32x4*)(bp1 + 32); } \
                const bool valid0 = (unsigned)(bi0 - d) < (unsigned)nb, valid1 = (unsigned)(bi1 - d) < (unsigned)nb; \
                u32x4 A0, A1; \
                A0.x = __builtin_amdgcn_alignbit(w0[1], w0[0], sh); A0.y = __builtin_amdgcn_alignbit(w0[2], w0[1], sh); A0.z = __builtin_amdgcn_alignbit(w0[3], w0[2], sh); A0.w = __builtin_amdgcn_alignbit(w0[4], w0[3], sh); \
                A1.x = __builtin_amdgcn_alignbit(w1_[1], w1_[0], sh); A1.y = __builtin_amdgcn_alignbit(w1_[2], w1_[1], sh); A1.z = __builtin_amdgcn_alignbit(w1_[3], w1_[2], sh); A1.w = __builtin_amdgcn_alignbit(w1_[4], w1_[3], sh); \
                const bf16x8 a0 = __builtin_bit_cast(bf16x8, A0), a1 = __builtin_bit_cast(bf16x8, A1); \
                if (!valid0) { B00 = zero4; B01 = zero4; } \
                if (!valid1) { B10 = zero4; B11 = zero4; } \
                if (T0) acc0 = __builtin_amdgcn_mfma_f32_32x32x16_bf16(a0, __builtin_bit_cast(bf16x8, B00), acc0, 0, 0, 0); \
                if (T1) acc1 = __builtin_amdgcn_mfma_f32_32x32x16_bf16(a0, __builtin_bit_cast(bf16x8, B10), acc1, 0, 0, 0); \
                if (T0) acc0 = __builtin_amdgcn_mfma_f32_32x32x16_bf16(a1, __builtin_bit_cast(bf16x8, B01), acc0, 0, 0, 0); \
                if (T1) acc1 = __builtin_amdgcn_mfma_f32_32x32x16_bf16(a1, __builtin_bit_cast(bf16x8, B11), acc1, 0, 0, 0); \
            } while (0)
            if (nb == 8) {
#pragma unroll 1
                for (int d = -7; d <= 7; ++d) CONV_STEP(true, true);
            } else {
#pragma unroll 1
                for (int d = -63; d <= -32; ++d) CONV_STEP(true, false);
#pragma unroll 1
                for (int d = -31; d <= 31; ++d) CONV_STEP(true, true);
#pragma unroll 1
                for (int d = 32; d <= 63; ++d) CONV_STEP(false, true);
            }
#undef CONV_STEP
        }
        __syncthreads();
        {
            LAS float* ys = (LAS float*)(lds + CV_F) + wave * 2112;
            const int n = lane & 31, hh = lane >> 5;
#pragma unroll
            for (int r = 0; r < 16; ++r) { const int p = (r & 3) + 8 * (r >> 2) + 4 * hh; ys[n * 33 + p] = acc0[r]; ys[(32 + n) * 33 + p] = acc1[r]; }
        }
        __syncthreads();
        for (int rep4 = 0; rep4 < REP_CV4; ++rep4) {
            float w0[3][8], b0[8];
#pragma unroll
            for (int k = 0; k < 3; ++k)
#pragma unroll
                for (int h = 0; h < 2; ++h) { const f32x4 t0 = *(const f32x4*)(wsh + k * NMIX + c0 + 4 * h);
#pragma unroll
                    for (int e = 0; e < 4; ++e) w0[k][4 * h + e] = t0[e]; }
#pragma unroll
            for (int h = 0; h < 2; ++h) { const f32x4 t0 = *(const f32x4*)(bsh + c0 + 4 * h);
#pragma unroll
                for (int e = 0; e < 4; ++e) b0[4 * h + e] = t0[e]; }
            const u32x4 zero4 = {0u, 0u, 0u, 0u};
            const LAS float* ysb = (const LAS float*)(lds + CV_F);
            u32x4 pz[4], cz[4], nz[4];
#pragma unroll
            for (int it = 0; it < 4; ++it) { const int t = tid + 512 * it, tl = t & (L - 1);
                const bf16_t* zb = z + ((size_t)(c0 >> 3) * TT + row0 + t) * 8;
                pz[it] = tl > 0 ? *(const u32x4*)(zb - 8) : zero4; cz[it] = *(const u32x4*)zb; nz[it] = tl < L - 1 ? *(const u32x4*)(zb + 8) : zero4; }
#pragma unroll
            for (int it = 0; it < 4; ++it) { const int t = tid + 512 * it;
                float a[8], b[8], c[8], o[8];
                unpack8(pz[it], a); unpack8(cz[it], b); unpack8(nz[it], c);
#pragma unroll
                for (int e = 0; e < 8; ++e) { const float x0 = w0[0][e] * a[e] + w0[1][e] * b[e] + w0[2][e] * c[e] + b0[e]; o[e] = x0 * ysb[e * 2112 + (t >> 5) * 33 + (t & 31)]; }
                u32x4 w; w.x = cvtpk(o[0], o[1]); w.y = cvtpk(o[2], o[3]); w.z = cvtpk(o[4], o[5]); w.w = cvtpk(o[6], o[7]);
                *(u32x4*)(yh + ((size_t)(c0 >> 3) * TT + row0 + t) * 8) = w;
            }
        }
        __syncthreads();
    }
}

constexpr int AT_K = 0, AT_KROW = 272, AT_V = 64 * 272, AT_VROW = 288, AT_BUF = 64 * 272 + 64 * 288;
DI void attn_phase(LAS unsigned char* lds, int tid, int lane, int wave, int G, const bf16_t* __restrict__ z, const float* __restrict__ cache_k, const float* __restrict__ cache_v, const float* __restrict__ subln, float lam, float lam_init, bf16_t* __restrict__ yh) {
    const float C2 = 0.125f * 1.4426950408889634f;
    const int q16 = lane & 15, kg = lane >> 4;
    for (int u = blockIdx.x; u < 512; u += G) {
        int b, h, qrow0, krow0, ntile; bool sample = u < 256;
        if (sample) { b = u >> 7; h = (u >> 4) & 7; const int qb = u & 15; krow0 = TP + b * 2048; qrow0 = krow0 + qb * 128; ntile = 36; }
        else { const int v = u - 256; b = v >> 4; h = (v >> 1) & 7; const int qb = v & 1; krow0 = b * 256; qrow0 = krow0 + qb * 128; ntile = 4; }
        const float* ck = cache_k + (size_t)(b * 16 + h) * 256 * 128;
        const float* cvp = cache_v + (size_t)(b * 16 + h) * 256 * 128;
        bf16x8 q1[2], q2[2];
        { const bf16_t* qp = z + (size_t)(qrow0 + wave * 16 + q16) * NMIX + h * 128 + 8 * kg;
          q1[0] = *(const bf16x8*)qp; q1[1] = *(const bf16x8*)(qp + 32); q2[0] = *(const bf16x8*)(qp + 64); q2[1] = *(const bf16x8*)(qp + 96); }
        f32x4 O1[8], O2[8];
#pragma unroll
        for (int i = 0; i < 8; ++i) { O1[i] = (f32x4){0.f, 0.f, 0.f, 0.f}; O2[i] = (f32x4){0.f, 0.f, 0.f, 0.f}; }
        float m1 = -1e30f, m2 = -1e30f, l1 = 0.f, l2 = 0.f;
        u32x4 kv[2], vv[2];
#define AT_LOAD(KT) do { _Pragma("unroll") for (int i = 0; i < 2; ++i) { const int id = tid + 512 * i, r = id & 63, c8 = id >> 6; \
            if (sample && (KT) < 4) { \
                const float* kp = ck + (size_t)((KT) * 64 + r) * 128 + c8 * 8; const float* vp = cvp + (size_t)((KT) * 64 + r) * 128 + c8 * 8; \
                const f32x4 k0 = *(const f32x4*)kp, k1 = *(const f32x4*)(kp + 4), v0 = *(const f32x4*)vp, v1 = *(const f32x4*)(vp + 4); \
                kv[i].x = cvtpk(k0[0], k0[1]); kv[i].y = cvtpk(k0[2], k0[3]); kv[i].z = cvtpk(k1[0], k1[1]); kv[i].w = cvtpk(k1[2], k1[3]); \
                vv[i].x = cvtpk(v0[0], v0[1]); vv[i].y = cvtpk(v0[2], v0[3]); vv[i].z = cvtpk(v1[0], v1[1]); vv[i].w = cvtpk(v1[2], v1[3]); \
            } else { \
                const int kr = krow0 + (sample ? (KT) - 4 : (KT)) * 64 + r; \
                const bf16_t* kp = z + (size_t)kr * NMIX + 1024 + h * 128 + c8 * 8; \
                kv[i] = *(const u32x4*)kp; vv[i] = *(const u32x4*)(kp + 1024); \
            } } } while (0)
#define AT_STORE(BUF) do { _Pragma("unroll") for (int i = 0; i < 2; ++i) { const int id = tid + 512 * i, r = id & 63, c8 = id >> 6; \
            *(LAS u32x4*)(lds + (BUF) * AT_BUF + AT_K + r * AT_KROW + c8 * 16) = kv[i]; \
            *(LAS u32x4*)(lds + (BUF) * AT_BUF + AT_V + r * AT_VROW + c8 * 16) = vv[i]; } } while (0)
        __syncthreads();
        AT_LOAD(0); AT_STORE(0);
        if (ntile > 1) AT_LOAD(1);
        __syncthreads();
        for (int kt = 0; kt < ntile; ++kt) {
            if (kt + 1 < ntile) AT_STORE((kt + 1) & 1);
            if (kt + 2 < ntile) AT_LOAD(kt + 2);
            const LAS unsigned char* kbase = lds + (kt & 1) * AT_BUF;
            f32x4 s1[4], s2[4];
#pragma unroll
            for (int hf = 0; hf < 2; ++hf) {
                bf16x8 kf[2][4];
#pragma unroll
                for (int k2 = 0; k2 < 2; ++k2) {
                    const LAS unsigned char* kp = kbase + AT_K + (32 * hf + 8 * (q16 >> 2) + 4 * k2 + (q16 & 3)) * AT_KROW + kg * 16;
                    kf[k2][0] = *(const LAS bf16x8*)kp; kf[k2][1] = *(const LAS bf16x8*)(kp + 64); kf[k2][2] = *(const LAS bf16x8*)(kp + 128); kf[k2][3] = *(const LAS bf16x8*)(kp + 192);
                }
#pragma unroll
                for (int k2 = 0; k2 < 2; ++k2) {
                    f32x4 t = {0.f, 0.f, 0.f, 0.f}, t2 = {0.f, 0.f, 0.f, 0.f};
                    t = __builtin_amdgcn_mfma_f32_16x16x32_bf16(kf[k2][0], q1[0], t, 0, 0, 0); t2 = __builtin_amdgcn_mfma_f32_16x16x32_bf16(kf[k2][2], q2[0], t2, 0, 0, 0);
                    t = __builtin_amdgcn_mfma_f32_16x16x32_bf16(kf[k2][1], q1[1], t, 0, 0, 0); t2 = __builtin_amdgcn_mfma_f32_16x16x32_bf16(kf[k2][3], q2[1], t2, 0, 0, 0);
                    s1[2 * hf + k2] = t; s2[2 * hf + k2] = t2;
                }
            }
            float mx1 = -1e30f, mx2 = -1e30f;
#pragma unroll
            for (int ks = 0; ks < 4; ++ks)
#pragma unroll
                for (int j = 0; j < 4; ++j) { mx1 = fmaxf(mx1, s1[ks][j]); mx2 = fmaxf(mx2, s2[ks][j]); }
            { const float a = __shfl_xor(mx1, 16), b = __shfl_xor(mx2, 16); mx1 = fmaxf(mx1, a); mx2 = fmaxf(mx2, b); }
            { const float a = __shfl_xor(mx1, 32), b = __shfl_xor(mx2, 32); mx1 = fmaxf(mx1, a); mx2 = fmaxf(mx2, b); }
            const float mn1 = fmaxf(m1, mx1 * C2), mn2 = fmaxf(m2, mx2 * C2);
            const float al1 = __builtin_amdgcn_exp2f(m1 - mn1), al2 = __builtin_amdgcn_exp2f(m2 - mn2);
            m1 = mn1; m2 = mn2;
            float ps1 = 0.f, ps2 = 0.f;
#pragma unroll
            for (int ks = 0; ks < 4; ++ks)
#pragma unroll
                for (int j = 0; j < 4; ++j) { const float p1 = __builtin_amdgcn_exp2f(s1[ks][j] * C2 - mn1), p2 = __builtin_amdgcn_exp2f(s2[ks][j] * C2 - mn2); s1[ks][j] = p1; s2[ks][j] = p2; ps1 += p1; ps2 += p2; }
            l1 = l1 * al1 + ps1; l2 = l2 * al2 + ps2;
#pragma unroll
            for (int i = 0; i < 8; ++i) { O1[i] *= al1; O2[i] *= al2; }
#pragma unroll
            for (int s = 0; s < 2; ++s) {
                u32x4 pa, pb;
                pa.x = cvtpk(s1[2 * s][0], s1[2 * s][1]); pa.y = cvtpk(s1[2 * s][2], s1[2 * s][3]); pa.z = cvtpk(s1[2 * s + 1][0], s1[2 * s + 1][1]); pa.w = cvtpk(s1[2 * s + 1][2], s1[2 * s + 1][3]);
                pb.x = cvtpk(s2[2 * s][0], s2[2 * s][1]); pb.y = cvtpk(s2[2 * s][2], s2[2 * s][3]); pb.z = cvtpk(s2[2 * s + 1][0], s2[2 * s + 1][1]); pb.w = cvtpk(s2[2 * s + 1][2], s2[2 * s + 1][3]);
                const bf16x8 P1 = __builtin_bit_cast(bf16x8, pa), P2 = __builtin_bit_cast(bf16x8, pb);
                bf16x8 vf[8];
#pragma unroll
                for (int dt = 0; dt < 8; ++dt) {
                    const LAS unsigned char* vp = kbase + AT_V + (32 * s + 8 * kg + (q16 >> 2)) * AT_VROW + 32 * dt + 8 * (q16 & 3);
                    const s16x4 va = __builtin_bit_cast(s16x4, __builtin_amdgcn_ds_read_tr16_b64_v4i16((LAS s16x4*)vp));
                    const s16x4 vb = __builtin_bit_cast(s16x4, __builtin_amdgcn_ds_read_tr16_b64_v4i16((LAS s16x4*)(vp + 4 * AT_VROW)));
                    const bf16x8 vq = {va[0], va[1], va[2], va[3], vb[0], vb[1], vb[2], vb[3]};
                    vf[dt] = vq;
                }
#pragma unroll
                for (int dt = 0; dt < 8; ++dt) {
                    O1[dt] = __builtin_amdgcn_mfma_f32_16x16x32_bf16(vf[dt], P1, O1[dt], 0, 0, 0);
                    O2[dt] = __builtin_amdgcn_mfma_f32_16x16x32_bf16(vf[dt], P2, O2[dt], 0, 0, 0);
                }
            }
            __syncthreads();
        }
        l1 += __shfl_xor(l1, 16); l1 += __shfl_xor(l1, 32); l2 += __shfl_xor(l2, 16); l2 += __shfl_xor(l2, 32);
        const float r1 = 1.f / l1, r2 = lam / l2;
        float ss = 0.f;
#pragma unroll
        for (int i = 0; i < 8; ++i) { O1[i] = O1[i] * r1 - O2[i] * r2; ss += (O1[i][0] * O1[i][0] + O1[i][1] * O1[i][1]) + (O1[i][2] * O1[i][2] + O1[i][3] * O1[i][3]); }
        ss += __shfl_xor(ss, 16); ss += __shfl_xor(ss, 32);
        const float rstd = (1.f - lam_init) / sqrtf(ss * (1.f / 128.f) + EPS);
        bf16_t* op = yh + (size_t)(qrow0 + wave * 16 + q16) * D + h * 128 + 4 * kg;
#pragma unroll
        for (int i = 0; i < 8; ++i) { const f32x4 w = *(const f32x4*)(subln + 16 * i + 4 * kg); const f32x4 o = O1[i] * rstd * w;
            u32x2 pk; pk.x = cvtpk(o[0], o[1]); pk.y = cvtpk(o[2], o[3]); *(u32x2*)(op + 16 * i) = pk; }
    }
    __syncthreads();
}


#define XB_TMO      128
#define XB_XCNT(j)  (256  + 64 * (j))
#define XB_XSUB(j)  (1280 + 64 * (j))
#define XB_XGEN(j)  (2304 + 64 * (j))
#define XB_TOP      3328
#define XB_TOPGEN   3392
#define XCD_BAR_WORDS 3456
#define XB_SPIN_CAP (1u << 22)
DI unsigned xb_ld(unsigned* p)              { return __hip_atomic_load(p, __ATOMIC_RELAXED, __HIP_MEMORY_SCOPE_AGENT); }
DI unsigned xb_add(unsigned* p, unsigned v) { return __hip_atomic_fetch_add(p, v, __ATOMIC_RELAXED, __HIP_MEMORY_SCOPE_AGENT); }
DI unsigned xb_xcc_id() { return (unsigned)__builtin_amdgcn_s_getreg((3 << 11) | 20) & 0xFu; }
#define XB_SPIN(cond, bar) do { unsigned _sp = 0; while (cond) { __builtin_amdgcn_s_sleep(1); \
    if ((++_sp & 255u) == 0u) { if (xb_ld(&(bar)[XB_TMO])) break; if (_sp > XB_SPIN_CAP) { atomicAdd(&(bar)[XB_TMO], 1u); break; } } } } while (0)
DI void xcd_barrier_complete(unsigned* bar, unsigned x, unsigned& nloc, unsigned& nx) {
    const unsigned G = gridDim.x * gridDim.y * gridDim.z;
    unsigned sum, cnt, mine, sp = 0u;
    for (;;) {
        sum = 0u; cnt = 0u; mine = 0u;
#pragma unroll
        for (unsigned j = 0; j < 16; ++j) { const unsigned c = xb_ld(&bar[XB_XCNT(j)]); sum += c; cnt += (c > 0u) ? 1u : 0u; mine = (j == x) ? c : mine; }
        if (sum == G) break;
        __builtin_amdgcn_s_sleep(1);
        if ((++sp & 255u) == 0u) { if (xb_ld(&bar[XB_TMO])) break; if (sp > XB_SPIN_CAP) { atomicAdd(&bar[XB_TMO], 1u); break; } }
    }
    nloc = mine > 0u ? mine : 1u; nx = cnt > 0u ? cnt : 1u;
}
DI void xcd_barrier(unsigned* bar, volatile LAS unsigned* st) {
    asm volatile("s_waitcnt vmcnt(0)" ::: "memory");
    __syncthreads();
    if (threadIdx.x == 0) {
        const unsigned x = xb_xcc_id();
        __builtin_amdgcn_s_waitcnt(0);
        unsigned nloc = st[0], nx = st[1];
        if (nloc == 0u) { xcd_barrier_complete(bar, x, nloc, nx); st[0] = nloc; st[1] = nx; }
        const unsigned old = xb_add(&bar[XB_XSUB(x)], 1u);
        const unsigned gen = old / nloc;
        if (old + 1u == (gen + 1u) * nloc) {
            __builtin_amdgcn_fence(__ATOMIC_RELEASE, "agent");
            asm volatile("s_waitcnt vmcnt(0)" ::: "memory");
            const unsigned og = xb_add(&bar[XB_TOP], 1u);
            const unsigned tg = og / nx;
            if (og + 1u == (tg + 1u) * nx) xb_add(&bar[XB_TOPGEN], 1u);
            else XB_SPIN(xb_ld(&bar[XB_TOPGEN]) == tg, bar);
            __builtin_amdgcn_fence(__ATOMIC_ACQUIRE, "agent");
            asm volatile("s_waitcnt vmcnt(0)" ::: "memory");
        } else {
            XB_SPIN(xb_ld(&bar[XB_TOPGEN]) == gen, bar);
            __builtin_amdgcn_fence(__ATOMIC_ACQUIRE, "agent");
            asm volatile("s_waitcnt vmcnt(0)" ::: "memory");
        }
    }
    __syncthreads();
}

constexpr int N_PHASES = 30;
__global__ void __launch_bounds__(NWAVES * 64, 2) fwd_megakernel(Args a_byval) {
    extern __shared__ __attribute__((aligned(16))) unsigned char lds_raw[];
    LAS unsigned char* lds = (LAS unsigned char*)lds_raw;
    const int ph_lo = a_byval.ph_lo, ph_hi = a_byval.ph_hi;
    if (threadIdx.x < 64) ((LAS unsigned*)(lds + LDS_MISC))[threadIdx.x] = 0u;
    __syncthreads();
    if (threadIdx.x == 0) (void)xb_add((unsigned*)(a_byval.ws + WS_CTL) + XB_XCNT(xb_xcc_id()), 1u);
    for (int ph = ph_lo; ph < ph_hi; ++ph) {
        ArgsP ap = (ArgsP)__builtin_amdgcn_kernarg_segment_ptr(); asm volatile("" : "+s"(ap));
        int tid = threadIdx.x; asm volatile("" : "+v"(tid));
        unsigned char* ws = ap->ws;
        float* xout = ap->out;
        const int lane = tid & 63, wave = __builtin_amdgcn_readfirstlane(tid >> 6), G = gridDim.x;
        const int gw = blockIdx.x * NWAVES + wave, NGW = G * NWAVES;
        float* newk = xout + (size_t)TT * D; float* newv = newk + (size_t)16 * 2 * 8 * 256 * 128;
        const float* mod = (const float*)(ws + WS_MOD);
        bf16_t* zb = (bf16_t*)(ws + WS_Z); bf16_t* Y = (bf16_t*)(ws + WS_Z + 48 * MiB); float* sideb = (float*)(ws + WS_Z + 80 * MiB);
        bf16_t* hb = (bf16_t*)(ws + WS_A); bf16_t* yhb = (bf16_t*)(ws + WS_A + 16 * MiB); bf16_t* ab = (bf16_t*)(ws + WS_Z);
        const float* normw = ap->in[I_NORMW];
        if (ph == 0) {
            for (int rep = 0; rep < REP_P0; ++rep) phase0(ap, lds, tid, lane, wave, G);
        } else if (ph == N_PHASES - 1) {
            if (KON(0)) row_phase(gw, NGW, lane, xout, xout + (size_t)TP * D, xout, Y, (const float*)(ws + WS_ZERO), mod + 3 * 3 * 6144 + 5 * 1024, normw + (3 * 4 + 3) * D, nullptr, nullptr, nullptr, nullptr);
        } else {
            const int i = (ph - 1) / 7, k7 = (ph - 1) - 7 * i, kind = k7 < 6 ? k7 : 7, j = i >> 1; const bool attn = (i & 1);
            const float* modl = mod + i * 3 * 6144;
            unsigned char* wl = ws + WS_W + (size_t)i * W_LAYER;
            if (kind & 1) {
                if (KON(1)) {
                pg8::Gemm g; pg8::Order S; pg8::EpiU E;
                E.z = pg8::EpiZ{zb, NMIX, nullptr, 0}; E.q = pg8::EpiQKV{zb, (const float*)(ws + WS_ROPE), (const float*)(ws + WS_ROPE) + 2048 * 32, newk + (size_t)j * 8 * 256 * 128, newv + (size_t)j * 8 * 256 * 128};
                E.f = pg8::EpiF32{Y, D, (size_t)TT * D}; E.n = pg8::EpiFFN{ab, ap->in[I_FDW] + (size_t)i * 3 * NUP, ap->in[I_FBDW] + (size_t)i * NUP, sideb};
                if (kind == 1) { g = pg8::Gemm{hb, (const bf16_t*)(wl + W_MIX), TT, NMIX, D, 1, 0}; E.mode = attn ? 1 : 0; E.z.bias = ap->in[I_HBIN] + j * NMIX; E.z.slab = 1; }
                else if (kind == 3) { g = pg8::Gemm{yhb, (const bf16_t*)(wl + W_OUT), TT, D, D, 2, attn ? 0 : 1}; E.mode = 2; }
                else if (kind == 5) { g = pg8::Gemm{hb, (const bf16_t*)(wl + W_UP), TT, NUP, D, 1, 2}; E.mode = 3; }
                else { g = pg8::Gemm{ab, (const bf16_t*)(wl + W_DOWN), TT, D, DFF, 2, 0}; E.mode = 2; }
                S.init(g.M, g.N, g.KS, G, (int)blockIdx.x);
                if (kind == 7) { pg8::Unit u0; for (int ui = 0; S.next(ui, u0); ++ui) ffn_edge_fix(tid, u0.pm, u0.ks, sideb, ap->in[I_FDW] + (size_t)i * 3 * NUP, ab); }
                for (int rep = 0; rep < REP_GEMM; ++rep) pg8::gemm_phase(lds, tid, g, S, E);
                if (kind == 1 && (int)blockIdx.x >= 128 && G == 256)
                    convert_layer_weights(ap, i, ((int)blockIdx.x - 128) * NWAVES + wave, 128 * NWAVES, (LAS float*)(lds + wave * 16384), lane, I_MIX, i < 3 ? I_LAYER + I_MIX : I_LAYER);
                else if (kind == 1 && G != 256) convert_layer_weights(ap, i, gw, NGW, (LAS float*)(lds + wave * 16384), lane, I_MIX, i < 3 ? I_LAYER + I_MIX : I_LAYER);
                }
            } else if (kind == 0 && KON(0)) {
                if (i == 0) row_phase(gw, NGW, lane, ap->in[I_XP], ap->in[I_XS], xout, nullptr, nullptr, nullptr, nullptr, normw + (i * 4 + 0) * D, modl, modl + 1024, hb);
                else row_phase(gw, NGW, lane, xout, xout + (size_t)TP * D, xout, Y, (const float*)(ws + WS_ZERO), modl - 3 * 6144 + 5 * 1024, normw + ((i - 1) * 4 + 3) * D, normw + (i * 4 + 0) * D, modl, modl + 1024, hb);
            } else if (kind == 2) {
                if (!attn) { for (int rep = 0; rep < REP_CONV; ++rep) conv_phase(lds, tid, lane, wave, G, zb, ap->in[I_HWSH] + j * 3 * NMIX, ap->in[I_HBSH] + j * NMIX, ws + WS_FILT + (size_t)j * FILT_LAYER, yhb); }
                else if (KON(9)) {
                    float d1 = 0.f, d2 = 0.f;
                    for (int e = 0; e < 64; ++e) { d1 += ap->in[I_LQ1][j * 64 + e] * ap->in[I_LK1][j * 64 + e]; d2 += ap->in[I_LQ2][j * 64 + e] * ap->in[I_LK2][j * 64 + e]; }
                    const float lam_init = 0.8f - 0.6f * __expf(-0.3f * (float)i);
                    const float lam = __expf(d1) - __expf(d2) + lam_init;
                    for (int rep = 0; rep < REP_ATTN; ++rep) attn_phase(lds, tid, lane, wave, G, zb, ap->in[I_CK] + (size_t)j * 8 * 256 * 128, ap->in[I_CV] + (size_t)j * 8 * 256 * 128, ap->in[I_SUBLN] + j * 128, lam, lam_init, yhb);
                }
            } else if (kind == 4 && KON(0)) {
                row_phase(gw, NGW, lane, xout, xout + (size_t)TP * D, xout, Y, attn ? (const float*)(ws + WS_ZERO) : ap->in[I_HBOUT] + j * D, modl + 2 * 1024, normw + (i * 4 + 1) * D, normw + (i * 4 + 2) * D, modl + 3 * 1024, modl + 4 * 1024, hb);
            } else if (kind == 6 && KON(6)) {
                for (int rep = 0; rep < REP_ELEM; ++rep) ffn_elem_phase(blockIdx.x * 512 + tid, G * 512, zb, ap->in[I_FDW] + (size_t)i * 3 * NUP, ap->in[I_FBDW] + (size_t)i * NUP, ab);
            }
        }
        if (ph + 1 < ph_hi) {
            if (ph_hi > 4096) cg::this_grid().sync();
            for (int rep = 0; rep < REP_SYNC; ++rep) xcd_barrier((unsigned*)(ws + WS_CTL), (volatile LAS unsigned*)(lds + LDS_MISC + 32));
        }
    }
}

extern "C" void kernel_launch(void* const* d_in, const int* in_sizes, int n_in, void* d_out, int out_size, void* d_ws, size_t ws_size, hipStream_t stream) {
    static int grid = 0;
    if (grid == 0) {
        if (n_in != 33 || ws_size < WS_END) { fprintf(stderr, "kernel_launch: unexpected inputs (n_in %d, ws %zu)\n", n_in, ws_size); grid = -1; return; }
        int dev = 0, cus = 0, per_cu = 0;
        hipGetDevice(&dev); hipDeviceGetAttribute(&cus, hipDeviceAttributeMultiprocessorCount, dev);
        if (hipFuncSetAttribute((const void*)fwd_megakernel, hipFuncAttributeMaxDynamicSharedMemorySize, LDS_BYTES) != hipSuccess) { fprintf(stderr, "kernel_launch: hipFuncSetAttribute failed\n"); grid = -1; return; }
        if (hipOccupancyMaxActiveBlocksPerMultiprocessor(&per_cu, (const void*)fwd_megakernel, NWAVES * 64, LDS_BYTES) != hipSuccess || per_cu < 1) { fprintf(stderr, "kernel_launch: occupancy query says %d\n", per_cu); per_cu = 1; }
        (void)hipGetLastError();
        grid = cus * 1;
    }
    if (grid < 0) return;
    if (hipMemsetAsync((char*)d_ws + WS_CTL, 0, CTL_BYTES, stream) != hipSuccess) { fprintf(stderr, "kernel_launch: memset failed\n"); return; }
    Args a{};
    for (int i = 0; i < 33; ++i) a.in[i] = (const float*)d_in[i];
    a.out = (float*)d_out; a.ws = (unsigned char*)d_ws;
#if MK_ONE_LAUNCH
    a.ph_lo = 0; a.ph_hi = N_PHASES;
    void* args[] = {&a};
    hipError_t e = hipLaunchCooperativeKernel((const void*)fwd_megakernel, dim3(grid), dim3(NWAVES * 64), args, LDS_BYTES, stream);
    if (e != hipSuccess) fprintf(stderr, "cooperative launch failed: %s (grid %d)\n", hipGetErrorString(e), grid);
#else
    for (int ph = 0; ph < N_PHASES; ++ph) {
        a.ph_lo = ph; a.ph_hi = ph + 1;
        void* args[] = {&a};
        hipError_t e = hipLaunchCooperativeKernel((const void*)fwd_megakernel, dim3(grid), dim3(NWAVES * 64), args, LDS_BYTES, stream);
        if (e != hipSuccess) { fprintf(stderr, "launch %d failed: %s (grid %d)\n", ph, hipGetErrorString(e), grid); break; }
    }
#endif
}
```

```cpp
#include <hip/hip_runtime.h>
#include <hip/hip_cooperative_groups.h>
#include <cstdio>
#include <cstdint>
namespace cg = cooperative_groups;

#ifndef KMASK
#define KMASK 0xFFFF
#endif
#define KON(n) ((KMASK >> (n)) & 1)
#ifndef REP_P0A
#define REP_P0A 1
#endif
#ifndef REP_P0C
#define REP_P0C 1
#endif
#ifndef REP_P0D
#define REP_P0D 1
#endif
#ifndef REP_CV1
#define REP_CV1 1
#endif
#ifndef REP_CV2
#define REP_CV2 1
#endif
#ifndef REP_CV4
#define REP_CV4 1
#endif
#ifndef REP_FC
#define REP_FC 1
#endif
#ifndef REP_FS
#define REP_FS 1
#endif
#ifndef REP_GEMM
#define REP_GEMM 1
#endif
#ifndef REP_CONV
#define REP_CONV 1
#endif
#ifndef REP_ATTN
#define REP_ATTN 1
#endif
#ifndef REP_ELEM
#define REP_ELEM 1
#endif
#ifndef REP_P0
#define REP_P0 1
#endif
#ifndef REP_SYNC
#define REP_SYNC 1
#endif
#ifndef MK_ONE_LAUNCH
#define MK_ONE_LAUNCH 1
#endif

#define LAS __attribute__((address_space(3)))
typedef unsigned short bf16_t;
typedef short bf16x8 __attribute__((ext_vector_type(8)));
typedef short s16x4 __attribute__((ext_vector_type(4)));
typedef float f32x4 __attribute__((ext_vector_type(4)));
typedef float f32x16 __attribute__((ext_vector_type(16)));
typedef unsigned u32x4 __attribute__((ext_vector_type(4)));
typedef unsigned u32x2 __attribute__((ext_vector_type(2)));
typedef float f32x2_t __attribute__((ext_vector_type(2)));
typedef __bf16 bf16x2_t __attribute__((ext_vector_type(2)));

#define DI __device__ __forceinline__
DI unsigned cvtpk(float lo, float hi) { f32x2_t v = {lo, hi}; bf16x2_t b = __builtin_convertvector(v, bf16x2_t); return __builtin_bit_cast(unsigned, b); }
DI float bflo(unsigned u) { return __builtin_bit_cast(float, u << 16); }
DI float bfhi(unsigned u) { return __builtin_bit_cast(float, u & 0xffff0000u); }
DI void unpack8(u32x4 v, float* f) { f[0] = bflo(v.x); f[1] = bfhi(v.x); f[2] = bflo(v.y); f[3] = bfhi(v.y); f[4] = bflo(v.z); f[5] = bfhi(v.z); f[6] = bflo(v.w); f[7] = bfhi(v.w); }
DI float wave_sum(float v) {
#pragma unroll
    for (int o = 1; o < 64; o <<= 1) v += __shfl_xor(v, o);
    return v;
}

constexpr int D = 1024, TT = 8192, TP = 4096, DFF = 2816, NUP = 5632, NMIX = 3072;
constexpr float EPS = 1e-6f;
constexpr int NWAVES = 8;
constexpr int LDS_BYTES = 139264, LDS_MISC = 135168;

constexpr size_t MiB = 1u << 20;
constexpr size_t WS_MOD = 0;
constexpr size_t WS_CTL = 512 * 1024, CTL_BYTES = 32768, WS_ZERO = WS_CTL + 16384;
constexpr size_t WS_ROPE = 1 * MiB;
constexpr size_t WS_W = 2 * MiB;
constexpr size_t W_MIX = 0, W_OUT = 6291456, W_UP = W_OUT + 2097152, W_DOWN = W_UP + 11534336, W_LAYER = W_DOWN + 5767168;
static_assert(W_LAYER == 25690112, "layer weight bytes");
constexpr size_t WS_FILT = 100 * MiB;
constexpr size_t FILT_LAYER = 9 * MiB;
constexpr size_t WS_Z = 118 * MiB;
constexpr size_t WS_A = 206 * MiB;
constexpr size_t WS_END = 254 * MiB;
static_assert(WS_W + 4 * W_LAYER <= WS_FILT, "ws map");

namespace pg8 {
constexpr int BM = 256, BK = 64, HALF = 128, HTB = HALF * BK * 2, STAGE_BYTES = 8 * HTB, NXCD = 8, WGM = 4;
DI int lds_byte(int r, int c) { const int st = (r >> 4) * 2 + (c >> 5), rr = r & 15, cc = c & 31, ob = rr * 64 + cc * 2; return st * 1024 + (ob ^ (((ob >> 9) & 1) << 5)); }
DI void stage_rc(int b, int& R, int& C) { const int st = b / 1024, sb = b % 1024, swz = sb ^ (((sb >> 9) & 1) << 5); R = (st >> 1) * 16 + swz / 64; C = (st & 1) * 32 + (swz % 64) / 2; }
DI int perm32(int rho) { const int n = rho >> 4, i = rho & 15; return 8 * (i >> 2) + 4 * n + (i & 3); }

struct Unit { int pm, pn, ks; };
struct Gemm { const bf16_t* A; const bf16_t* Bt; int M, N, K, KS, aslab; };

struct Order {
    int nM, nN, nwg, G, c, KS;
    DI void init(int M, int N, int KS_, int G_, int c_) { nM = M / BM; nN = N / BM; nwg = nM * nN; G = G_; c = c_; KS = KS_; }
    DI bool next(int i, Unit& u) const {
        const int L = i * G + c; if (L >= nwg * KS) return false;
        u.ks = L / nwg;
        int wgid = L % nwg; { const int q = nwg / NXCD, r = nwg % NXCD, xcd = wgid % NXCD, off = wgid / NXCD; wgid = (xcd < r ? xcd * (q + 1) : r * (q + 1) + (xcd - r) * q) + off; }
        const int nig = WGM * nN, gid = wgid / nig, fm = gid * WGM, gsz = (nM - fm) < WGM ? (nM - fm) : WGM;
        u.pm = fm + ((wgid % nig) % gsz); u.pn = (wgid % nig) / gsz; return true;
    }
};

struct EpiZ {
    bf16_t* O; int ldc; const float* bias; int slab;
    DI void operator()(const f32x4 (&acc)[2][2][4][2], const Unit& u, int wr, int wc, int fr, int fq) const {
        const int row0 = u.pm * BM + wr * 64 + fr, col0 = u.pn * BM + wc * 32 + 8 * fq;
        f32x4 bv[2][2];
#pragma unroll
        for (int bj = 0; bj < 2; ++bj)
#pragma unroll
            for (int n = 0; n < 2; ++n) bv[bj][n] = bias ? *(const f32x4*)(bias + col0 + bj * HALF + 4 * n) : (f32x4){0.f, 0.f, 0.f, 0.f};
#pragma unroll
        for (int ai = 0; ai < 2; ++ai)
#pragma unroll
            for (int m = 0; m < 4; ++m) { const int row = row0 + ai * HALF + m * 16;
                bf16_t* rowp = slab ? O + ((size_t)(col0 >> 3) * TT + row) * 8 : O + (size_t)row * ldc + col0;
                const size_t bjs = slab ? (size_t)16 * TT * 8 : (size_t)HALF;
#pragma unroll
                for (int bj = 0; bj < 2; ++bj) { const f32x4 v0 = acc[ai][bj][m][0] + bv[bj][0], v1 = acc[ai][bj][m][1] + bv[bj][1];
                    u32x4 w; w.x = cvtpk(v0[0], v0[1]); w.y = cvtpk(v0[2], v0[3]); w.z = cvtpk(v1[0], v1[1]); w.w = cvtpk(v1[2], v1[3]);
                    *(u32x4*)(rowp + bj * bjs) = w; } }
    }
};

struct EpiQKV {
    bf16_t* O; const float* ropec; const float* ropes; float* newk; float* newv;
    DI void operator()(const f32x4 (&acc)[2][2][4][2], const Unit& u, int wr, int wc, int fr, int fq) const {
        const int row0 = u.pm * BM + wr * 64 + fr, col0 = u.pn * BM + wc * 32 + 8 * fq;
        const bool sample = u.pm >= 16; const int sec = u.pn >> 2;
        const bool rope = sample && sec < 2;
        const float sgn = (fq & 2) ? 1.f : -1.f;
        const int axis = (col0 >> 5) & 1, f0 = col0 & 15;
#pragma unroll
        for (int ai = 0; ai < 2; ++ai) {
#pragma unroll
          for (int mh = 0; mh < 2; ++mh) {
            f32x4 c0[2], c1[2], s0[2], s1[2];
            if (rope) {
#pragma unroll
                for (int m2 = 0; m2 < 2; ++m2) { const int tpos = (row0 + ai * HALF + (2 * mh + m2) * 16 - TP) & 2047;
                    const float* cp = ropec + tpos * 32 + axis * 16 + f0; const float* sp = ropes + tpos * 32 + axis * 16 + f0;
                    c0[m2] = *(const f32x4*)cp; c1[m2] = *(const f32x4*)(cp + 4); s0[m2] = *(const f32x4*)sp; s1[m2] = *(const f32x4*)(sp + 4); }
            }
#pragma unroll
            for (int m2 = 0; m2 < 2; ++m2) { const int m = 2 * mh + m2; const int row = row0 + ai * HALF + m * 16;
#pragma unroll
                for (int bj = 0; bj < 2; ++bj) { const int col = col0 + bj * HALF;
                    f32x4 v0 = acc[ai][bj][m][0], v1 = acc[ai][bj][m][1];
                    if (rope) {
                        f32x4 p0, p1;
#pragma unroll
                        for (int e = 0; e < 4; ++e) { p0[e] = __shfl_xor(v0[e], 32); p1[e] = __shfl_xor(v1[e], 32); }
                        v0 = v0 * c0[m2] + (p0 * s0[m2]) * sgn; v1 = v1 * c1[m2] + (p1 * s1[m2]) * sgn;
                    }
                    u32x4 w; w.x = cvtpk(v0[0], v0[1]); w.y = cvtpk(v0[2], v0[3]); w.z = cvtpk(v1[0], v1[1]); w.w = cvtpk(v1[2], v1[3]);
                    *(u32x4*)(O + (size_t)row * NMIX + col) = w;
                    if (!sample && sec >= 1) {
                        const int cc = col - sec * 1024, h = cc >> 7, d = cc & 127, b = row >> 8, t = row & 255;
                        float* dst = (sec == 1 ? newk : newv) + ((size_t)((b * 2) * 8 + h) * 256 + t) * 128 + d;
                        *(f32x4*)dst = v0; *(f32x4*)(dst + 4) = v1;
                    }
                } }
          }
        }
    }
};

struct EpiF32 {
    bf16_t* Y; int ldc; size_t kstride;
    DI void operator()(const f32x4 (&acc)[2][2][4][2], const Unit& u, int wr, int wc, int fr, int fq) const {
        const int row0 = u.pm * BM + wr * 64 + fr, col0 = u.pn * BM + wc * 32 + 8 * fq;
        bf16_t* base = Y + (size_t)u.ks * kstride;
#pragma unroll
        for (int ai = 0; ai < 2; ++ai)
#pragma unroll
            for (int m = 0; m < 4; ++m) { bf16_t* rowp = base + (size_t)(row0 + ai * HALF + m * 16) * ldc + col0;
#pragma unroll
                for (int bj = 0; bj < 2; ++bj) { const f32x4 v0 = acc[ai][bj][m][0], v1 = acc[ai][bj][m][1];
                    u32x4 w; w.x = cvtpk(v0[0], v0[1]); w.y = cvtpk(v0[2], v0[3]); w.z = cvtpk(v1[0], v1[1]); w.w = cvtpk(v1[2], v1[3]);
                    *(u32x4*)(rowp + bj * HALF) = w; } }
    }
};

DI f32x4 bperm4(int addr, const f32x4 v) {
    const float v0 = v[0], v1 = v[1], v2 = v[2], v3 = v[3];
    const int a = __builtin_amdgcn_ds_bpermute(addr, __float_as_int(v0)), b = __builtin_amdgcn_ds_bpermute(addr, __float_as_int(v1));
    const int c = __builtin_amdgcn_ds_bpermute(addr, __float_as_int(v2)), d = __builtin_amdgcn_ds_bpermute(addr, __float_as_int(v3));
    return (f32x4){__int_as_float(a), __int_as_float(b), __int_as_float(c), __int_as_float(d)};
}
struct EpiFFN {
    bf16_t* Aout; const float* wdw; const float* bdw; float* side;
    DI void operator()(const f32x4 (&acc)[2][2][4][2], const Unit& u, int wr, int wc, int fr, int fq) const {
        const int colg = u.pn * 128 + wc * 32 + 8 * fq;
        const int tok0 = u.pm * BM + 8 * (16 * wr + fr);
        const bool efirst = (fr == 0), elast = (fr == 15);
        float* sb = side + (size_t)((u.pm * 4 + wr * 2 + (elast ? 1 : 0)) * 2) * NUP;
        bf16_t* ap_ = Aout + (size_t)tok0 * DFF + colg;
#pragma unroll
        for (int n = 0; n < 2; ++n) {
            const int cg = colg + 4 * n, cv = DFF + colg + 4 * n;
            const f32x4 wg0 = *(const f32x4*)(wdw + cg), wg1 = *(const f32x4*)(wdw + NUP + cg), wg2 = *(const f32x4*)(wdw + 2 * NUP + cg), bg = *(const f32x4*)(bdw + cg);
            const f32x4 wv0 = *(const f32x4*)(wdw + cv), wv1 = *(const f32x4*)(wdw + NUP + cv), wv2 = *(const f32x4*)(wdw + 2 * NUP + cv), bv = *(const f32x4*)(bdw + cv);
            const int lane_ = fq * 16 + fr, pl = ((lane_ - 1) & 63) * 4, nl = ((lane_ + 1) & 63) * 4;
            const float mf = efirst ? 0.f : 1.f, ml = elast ? 0.f : 1.f;
            const f32x4 pg = bperm4(pl, acc[1][0][3][n]) * mf, pv = bperm4(pl, acc[1][1][3][n]) * mf;
#pragma unroll
            for (int q = 0; q < 8; ++q) {
                const f32x4 zgp = q == 0 ? pg : acc[(q - 1) >> 2][0][(q - 1) & 3][n], zgc = acc[q >> 2][0][q & 3][n], zgn = q == 7 ? bperm4(nl, acc[0][0][0][n]) * ml : acc[((q + 1) & 7) >> 2][0][(q + 1) & 3][n];
                const f32x4 zvp = q == 0 ? pv : acc[(q - 1) >> 2][1][(q - 1) & 3][n], zvc = acc[q >> 2][1][q & 3][n], zvn = q == 7 ? bperm4(nl, acc[0][1][0][n]) * ml : acc[((q + 1) & 7) >> 2][1][(q + 1) & 3][n];
                const f32x4 g = wg0 * zgp + wg1 * zgc + wg2 * zgn + bg;
                const f32x4 v = wv0 * zvp + wv1 * zvc + wv2 * zvn + bv;
                const bool edge = (q == 0 && efirst) || (q == 7 && elast);
                if ((q == 0 || q == 7) && edge) {
                    *(f32x4*)(sb + cg) = zgc; *(f32x4*)(sb + cv) = zvc; *(f32x4*)(sb + NUP + cg) = g; *(f32x4*)(sb + NUP + cv) = v;
                } else {
                    float r[4];
#pragma unroll
                    for (int e = 0; e < 4; ++e) r[e] = g[e] * __builtin_amdgcn_rcpf(1.f + __expf(-g[e])) * v[e];
                    u32x2 w; w.x = cvtpk(r[0], r[1]); w.y = cvtpk(r[2], r[3]);
                    *(u32x2*)(ap_ + (size_t)q * DFF + 4 * n) = w;
                }
            }
        }
    }
};

struct EpiU {
    int mode; EpiZ z; EpiQKV q; EpiF32 f; EpiFFN n;
    DI void operator()(const f32x4 (&acc)[2][2][4][2], const Unit& u, int wr, int wc, int fr, int fq) const {
        if (mode == 0) z(acc, u, wr, wc, fr, fq); else if (mode == 1) q(acc, u, wr, wc, fr, fq); else if (mode == 2) f(acc, u, wr, wc, fr, fq); else n(acc, u, wr, wc, fr, fq);
    }
};

template <class Epi>
DI void gemm_phase(LAS unsigned char* lds, const int tid, const Gemm g, const Order& S, const Epi& E) {
    const int wid = __builtin_amdgcn_readfirstlane(tid >> 6), lane = tid & 63, wr = wid >> 2, wc = wid & 3, fr = lane & 15, fq = lane >> 4;
    const int K = g.K, Ksub = K / g.KS, nt = Ksub / BK;
    unsigned voffA[2], voffB[2];
#pragma unroll
    for (int i = 0; i < 2; ++i) { int R, C; stage_rc(tid * 16 + i * 8192, R, C); const int Rb = (R & ~31) + perm32(R & 31);
        const int tau = 8 * ((R >> 6) * 16 + (R & 15)) + ((R >> 4) & 3);
        voffA[i] = g.aslab == 1 ? (unsigned)((C >> 3) * g.M + R) * 16u : (g.aslab == 2 ? (unsigned)(tau * K + C) * 2u : (unsigned)(R * K + C) * 2u); voffB[i] = (unsigned)(Rb * K + C) * 2u; }
    const size_t kstep = (size_t)(BK * 2);
    const size_t hstep = (size_t)HALF * K * 2;
    const size_t tstep = 2 * hstep;
    const size_t ksb = (size_t)Ksub * 2;
    const size_t kstepA = g.aslab == 1 ? (size_t)8 * g.M * 16 : kstep, hstepA = g.aslab == 1 ? (size_t)HALF * 16 : (g.aslab == 2 ? (size_t)4 * K * 2 : hstep), tstepA = g.aslab == 1 ? (size_t)BM * 16 : tstep, ksbA = g.aslab == 1 ? (size_t)(Ksub / 8) * g.M * 16 : ksb;
    const unsigned ldsw = (unsigned)wid * 1024u;
    const int aoff = lds_byte(wr * 64 + fr, fq * 8), boff = lds_byte(wc * 32 + fr, fq * 8);
#define PG8_SA(b, h) (((b) * 2 + (h)) * HTB)
#define PG8_SB(b, h) ((4 + (b) * 2 + (h)) * HTB)
#define PG8_STAGE(bufoff, gbase, voff) do { _Pragma("unroll") for (int _i = 0; _i < 2; ++_i) \
        __builtin_amdgcn_global_load_lds((const unsigned*)((const char*)(gbase) + (voff)[_i]), (LAS unsigned*)(lds + (bufoff) + ldsw + _i * 8192), 16, 0, 0); } while (0)
#define PG8_LDA(dst, b, h) do { _Pragma("unroll") for (int m = 0; m < 4; ++m) _Pragma("unroll") for (int k = 0; k < 2; ++k) dst[m][k] = *(const LAS bf16x8*)(lds + PG8_SA(b, h) + aoff + m * 2048 + k * 1024); } while (0)
#define PG8_LDB(dst, b, h) do { _Pragma("unroll") for (int n = 0; n < 2; ++n) _Pragma("unroll") for (int k = 0; k < 2; ++k) dst[n][k] = *(const LAS bf16x8*)(lds + PG8_SB(b, h) + boff + n * 2048 + k * 1024); } while (0)
#define PG8_MMA(ai, bj, At, Bt) do { __builtin_amdgcn_s_setprio(1); _Pragma("unroll") for (int m = 0; m < 4; ++m) _Pragma("unroll") for (int n = 0; n < 2; ++n) _Pragma("unroll") for (int k = 0; k < 2; ++k) \
        acc[ai][bj][m][n] = __builtin_amdgcn_mfma_f32_16x16x32_bf16(Bt[n][k], At[m][k], acc[ai][bj][m][n], 0, 0, 0); __builtin_amdgcn_s_setprio(0); } while (0)
#define PG8_WAIT_V(n) asm volatile("s_waitcnt vmcnt(" #n ")" ::: "memory")
#define PG8_WAIT_L(n) asm volatile("s_waitcnt lgkmcnt(" #n ")" ::: "memory")
#define PG8_BAR __builtin_amdgcn_s_barrier()
#define PG8_SCHED __builtin_amdgcn_sched_barrier(0)
    Unit cur, nxt; int ui = 0;
    if (!S.next(0, cur)) return;
    f32x4 acc[2][2][4][2];
#pragma unroll
    for (int a = 0; a < 2; ++a)
#pragma unroll
        for (int b = 0; b < 2; ++b)
#pragma unroll
            for (int m = 0; m < 4; ++m)
#pragma unroll
                for (int n = 0; n < 2; ++n) acc[a][b][m][n] = (f32x4){0.f, 0.f, 0.f, 0.f};
    bf16x8 At[4][2], B0[2][2], B1[2][2];
    const char* cA = (const char*)g.A + (size_t)cur.pm * tstepA + (size_t)cur.ks * ksbA; const char* cB = (const char*)g.Bt + (size_t)cur.pn * tstep + (size_t)cur.ks * ksb;
    PG8_STAGE(PG8_SB(0, 0), cB, voffB); PG8_STAGE(PG8_SB(0, 1), cB + hstep, voffB); PG8_STAGE(PG8_SA(0, 0), cA, voffA); PG8_STAGE(PG8_SA(0, 1), cA + hstepA, voffA);
    if (wr == 1) PG8_BAR;
    PG8_WAIT_V(2); PG8_BAR;
    PG8_STAGE(PG8_SB(1, 0), cB + kstep, voffB); PG8_STAGE(PG8_SA(1, 0), cA + kstepA, voffA); PG8_STAGE(PG8_SB(1, 1), cB + hstep + kstep, voffB);
    PG8_WAIT_V(6); PG8_BAR;
    for (;;) {
        const bool has_next = S.next(ui + 1, nxt);
        const char* nA = has_next ? (const char*)g.A + (size_t)nxt.pm * tstepA + (size_t)nxt.ks * ksbA : cA; const char* nB = has_next ? (const char*)g.Bt + (size_t)nxt.pn * tstep + (size_t)nxt.ks * ksb : cB;
        for (int t = 0; t < nt; t += 2) {
            const bool last = (t == nt - 2);
            const char* a1 = cA + (size_t)(t + 1) * kstepA;
            const char* a2 = last ? nA : cA + (size_t)(t + 2) * kstepA; const char* b2 = last ? nB : cB + (size_t)(t + 2) * kstep;
            const char* a3 = a2 + kstepA; const char* b3 = b2 + kstep;
            PG8_LDB(B0, 0, 0); PG8_LDB(B1, 0, 1); PG8_SCHED; PG8_LDA(At, 0, 0); PG8_STAGE(PG8_SA(1, 1), a1 + hstepA, voffA);
            PG8_WAIT_V(8); PG8_WAIT_L(0); PG8_BAR; PG8_MMA(0, 0, At, B0); PG8_MMA(0, 1, At, B1); PG8_BAR; PG8_SCHED;
            PG8_LDA(At, 0, 1); PG8_STAGE(PG8_SB(0, 0), b2, voffB); PG8_STAGE(PG8_SB(0, 1), b2 + hstep, voffB); PG8_STAGE(PG8_SA(0, 0), a2, voffA);
            PG8_WAIT_V(8); PG8_WAIT_L(0); PG8_BAR; PG8_MMA(1, 0, At, B0); PG8_MMA(1, 1, At, B1); PG8_BAR; PG8_SCHED;
            PG8_LDB(B0, 1, 0); PG8_LDB(B1, 1, 1); PG8_SCHED; PG8_LDA(At, 1, 0); PG8_STAGE(PG8_SA(0, 1), a2 + hstepA, voffA);
            PG8_WAIT_V(8); PG8_WAIT_L(0); PG8_BAR; PG8_MMA(0, 0, At, B0); PG8_MMA(0, 1, At, B1); PG8_BAR; PG8_SCHED;
            PG8_LDA(At, 1, 1); PG8_STAGE(PG8_SB(1, 0), b3, voffB); PG8_STAGE(PG8_SB(1, 1), b3 + hstep, voffB); PG8_STAGE(PG8_SA(1, 0), a3, voffA);
            PG8_WAIT_V(8); PG8_WAIT_L(0); PG8_BAR; PG8_MMA(1, 0, At, B0); PG8_MMA(1, 1, At, B1); PG8_BAR; PG8_SCHED;
        }
        if (wr == 0) PG8_BAR;
        E(acc, cur, wr, wc, fr, fq);
        if (!has_next) break;
#pragma unroll
        for (int a = 0; a < 2; ++a)
#pragma unroll
            for (int b = 0; b < 2; ++b)
#pragma unroll
                for (int m = 0; m < 4; ++m)
#pragma unroll
                    for (int n = 0; n < 2; ++n) acc[a][b][m][n] = (f32x4){0.f, 0.f, 0.f, 0.f};
        cur = nxt; cA = nA; cB = nB; ++ui;
        if (wr == 1) PG8_BAR;
    }
    PG8_WAIT_V(0);
    PG8_BAR;
#undef PG8_SA
#undef PG8_SB
#undef PG8_STAGE
#undef PG8_LDA
#undef PG8_LDB
#undef PG8_MMA
#undef PG8_WAIT_V
#undef PG8_WAIT_L
#undef PG8_BAR
#undef PG8_SCHED
}
}

struct Args { const float* in[33]; float* out; unsigned char* ws; int ph_lo, ph_hi; };
enum { I_XP = 0, I_XS, I_CK, I_CV, I_C, I_CCTX, I_WADA, I_BADA, I_NORMW, I_HWIN, I_HBIN, I_HWSH, I_HBSH, I_FW1, I_FB1, I_FFREQ, I_FW2, I_FB2, I_FW3, I_DBIAS, I_HWOUT, I_HBOUT,
       I_AWQKV, I_AWOUT, I_LQ1, I_LK1, I_LQ2, I_LK2, I_SUBLN, I_FUP, I_FDW, I_FBDW, I_FDOWN };

DI int up_row(int n) { return n < DFF ? (n >> 7) * 256 + (n & 127) : ((n - DFF) >> 7) * 256 + 128 + ((n - DFF) & 127); }
DI void p0_transpose_item(const float* W, int K, int N, bf16_t* WT, LAS float* scr, int item, int lane, bool perm_up = false) {
    const int nblk = N / 32, kb = item / nblk, nb = item % nblk, k0 = 64 * kb, n0 = 32 * nb;
    float wv[32];
#pragma unroll
    for (int i = 0; i < 32; ++i) { const int kk = 2 * i + (lane >> 5); wv[i] = W[(size_t)(k0 + kk) * N + n0 + (lane & 31)]; }
#pragma unroll
    for (int i = 0; i < 32; ++i) { const int kk = 2 * i + (lane >> 5); scr[kk * 33 + (lane & 31)] = wv[i]; }
    asm volatile("s_waitcnt lgkmcnt(0)" ::: "memory");
    const int c = lane & 7;
#pragma unroll
    for (int j = 0; j < 4; ++j) { const int n = (lane >> 3) + 8 * j; const LAS float* s = scr + (8 * c) * 33 + n;
        u32x4 o; o.x = cvtpk(s[0 * 33], s[1 * 33]); o.y = cvtpk(s[2 * 33], s[3 * 33]); o.z = cvtpk(s[4 * 33], s[5 * 33]); o.w = cvtpk(s[6 * 33], s[7 * 33]);
        *(u32x4*)(WT + (size_t)(perm_up ? up_row(n0) + n : n0 + n) * K + k0 + 8 * c) = o; }
    asm volatile("s_waitcnt lgkmcnt(0)" ::: "memory");
}

typedef const __attribute__((address_space(4))) Args* ArgsP;
constexpr int I_MIX = 16 * 96, I_OUT = 16 * 32, I_UP = 16 * 176, I_DOWN = 44 * 32, I_LAYER = I_MIX + I_OUT + I_UP + I_DOWN;
DI void convert_layer_weights(ArgsP ap, int i0, int gwl, int NGWL, LAS float* scr, int lane, int lo, int hi) {
    for (int itv = lo + gwl; itv < hi; itv += NGWL) {
        const int i = itv < I_LAYER ? i0 : i0 + 1, jj = i >> 1;
        unsigned char* wl = ap->ws + WS_W + (size_t)i * W_LAYER;
        int r = itv < I_LAYER ? itv : itv - I_LAYER;
        if (r < I_MIX) { const float* W = (i & 1) ? ap->in[I_AWQKV] + (size_t)jj * 1024 * 3072 : ap->in[I_HWIN] + (size_t)jj * 1024 * 3072; p0_transpose_item(W, 1024, 3072, (bf16_t*)(wl + W_MIX), scr, r, lane); continue; } r -= I_MIX;
        if (r < I_OUT) { const float* W = (i & 1) ? ap->in[I_AWOUT] + (size_t)jj * 1024 * 1024 : ap->in[I_HWOUT] + (size_t)jj * 1024 * 1024; p0_transpose_item(W, 1024, 1024, (bf16_t*)(wl + W_OUT), scr, r, lane); continue; } r -= I_OUT;
        if (r < I_UP) { p0_transpose_item(ap->in[I_FUP] + (size_t)i * 1024 * 5632, 1024, 5632, (bf16_t*)(wl + W_UP), scr, r, lane, true); continue; } r -= I_UP;
        p0_transpose_item(ap->in[I_FDOWN] + (size_t)i * 2816 * 1024, 2816, 1024, (bf16_t*)(wl + W_DOWN), scr, r, lane);
    }
}

DI void phase0(ArgsP ap, LAS unsigned char* lds, int tid, int lane, int wave, int G) {
    unsigned char* ws = ap->ws;
    LAS float* sl = (LAS float*)lds;
    LAS float* red = sl + 3072;
    for (int idx = tid; idx < 3072; idx += 512) { const int cnd = idx >> 10, k = idx & 1023; const float v = cnd == 0 ? ap->in[I_CCTX][k] : ap->in[I_C][(cnd - 1) * 1024 + k]; sl[idx] = v / (1.f + __expf(-v)); }
    __syncthreads();
    float* mod = (float*)(ws + WS_MOD);
    for (int rep = 0; rep < REP_P0A; ++rep)
    for (int item = blockIdx.x; item < 384; item += G) {
        const int i = item / 96, n0 = (item % 96) * 64;
        const float* W = ap->in[I_WADA] + (size_t)i * 1024 * 6144 + n0 + lane;
        float a0 = 0.f, a1 = 0.f, a2 = 0.f; const int k0 = wave * 128;
#pragma unroll 16
        for (int kk = 0; kk < 128; ++kk) { const float w = W[(size_t)(k0 + kk) * 6144]; a0 += sl[k0 + kk] * w; a1 += sl[1024 + k0 + kk] * w; a2 += sl[2048 + k0 + kk] * w; }
        red[(wave * 3 + 0) * 64 + lane] = a0; red[(wave * 3 + 1) * 64 + lane] = a1; red[(wave * 3 + 2) * 64 + lane] = a2;
        __syncthreads();
        if (tid < 192) { const int cnd = tid >> 6, l = tid & 63; float s = 0.f;
#pragma unroll
            for (int w = 0; w < 8; ++w) s += red[(w * 3 + cnd) * 64 + l];
            mod[(i * 3 + cnd) * 6144 + n0 + l] = s + ap->in[I_BADA][i * 6144 + n0 + l]; }
        __syncthreads();
    }
    __syncthreads();
    { float* rc = (float*)(ws + WS_ROPE); float* rs = rc + 2048 * 32;
      for (int idx = blockIdx.x * 512 + tid; idx < 2048 * 32; idx += G * 512) { const int t = idx >> 5, e = idx & 31, ax = e >> 4, f = e & 15;
          const float pos = (float)(ax == 0 ? (t >> 6) : (t & 63)); const float inv = __builtin_amdgcn_exp2f(-(float)f * (13.287712379549449f / 16.f)); const float ang = pos * inv;
          rc[idx] = __cosf(ang); rs[idx] = __sinf(ang); } }
    const int gw = blockIdx.x * NWAVES + wave, NGW = G * NWAVES;
    constexpr int FW_L = 33 * 64 + 64 * 64 + 192;
    LAS float* fw = (LAS float*)lds;
    for (int jj = 0; jj < 2; ++jj) {
        LAS float* f = fw + jj * FW_L;
        { float v[5];
#pragma unroll
          for (int k = 0; k < 5; ++k) { const int r = tid + 512 * k; v[k] = r < 2112 ? ap->in[I_FW1][jj * 2112 + r] : 0.f; }
#pragma unroll
          for (int k = 0; k < 5; ++k) { const int r = tid + 512 * k; if (r < 2112) f[r] = v[k]; } }
        { float v[8];
#pragma unroll
          for (int k = 0; k < 8; ++k) v[k] = ap->in[I_FW2][jj * 4096 + tid + 512 * k];
#pragma unroll
          for (int k = 0; k < 8; ++k) f[2112 + tid + 512 * k] = v[k]; }
        if (tid < 64) { f[6208 + tid] = ap->in[I_FB1][jj * 64 + tid]; f[6272 + tid] = ap->in[I_FB2][jj * 64 + tid]; f[6336 + tid] = ap->in[I_FFREQ][jj * 64 + tid]; }
    }
    __syncthreads();
    LAS float* hs = (LAS float*)(lds + 51200 + wave * 2048);
    LAS float* w3s = (LAS float*)(lds + 67584);
    const int fgrp = blockIdx.x & 15, fsub = blockIdx.x >> 4, fnb = (G + 15 - fgrp) >> 4;
    const int j = fgrp >> 3, half = (fgrp >> 2) & 1, ch4 = fgrp & 3;
    { const float* src = ap->in[I_FW3] + (size_t)j * 64 * 2048 + half * 1024 + ch4 * 256 + (tid >> 3) * 2048 + (tid & 7) * 32;
      f32x4 t[8];
#pragma unroll
      for (int k = 0; k < 8; ++k) t[k] = *(const f32x4*)(src + 4 * k);
#pragma unroll
      for (int k = 0; k < 8; ++k) *(LAS f32x4*)(w3s + (tid >> 3) * 256 + (tid & 7) * 32 + 4 * k) = t[k]; }
    __syncthreads();
    for (int rep = 0; rep < REP_P0C; ++rep)
    for (int pbx = fsub + fnb * wave; pbx < 288; pbx += fnb * NWAVES) {
        int L, pb;
        if (pbx < 256) { L = 2048; pb = pbx; } else { L = 256; pb = pbx - 256; }
        const LAS float* w1 = fw + j * FW_L; const LAS float* w2 = w1 + 2112; const LAS float* b1 = w1 + 6208; const LAS float* b2 = w1 + 6272; const LAS float* fq = w1 + 6336;
        const int t0 = pb * 8 + half;
        float zv[8], h1[8], h2[8];
        const float fr = fq[lane];
        for (int repc = 0; repc < REP_FC; ++repc) {
#pragma unroll
        for (int p = 0; p < 8; ++p) { int t = t0 + p; if (t > L - 1) t = L - 1;
            const float tn = (float)t / (float)(L - 1); const float w = 6.283185307179586f * (float)t / (float)L;
            float z = 0.f;
            if (lane == 0) z = tn;
            else if (lane <= 16) { const float band = 1e-4f + (float)(lane - 1) * ((15.f - 1e-4f) / 15.f); z = __cosf(band * w); }
            else if (lane <= 32) { const float band = 1e-4f + (float)(lane - 17) * ((15.f - 1e-4f) / 15.f); z = -__sinf(band * w); }
            zv[p] = z; h1[p] = b1[lane]; h2[p] = b2[lane]; }
#pragma unroll 3
        for (int e = 0; e < 33; ++e) { const float w = w1[e * 64 + lane];
#pragma unroll
            for (int p = 0; p < 8; ++p) h1[p] += __builtin_bit_cast(float, __builtin_amdgcn_readlane(__builtin_bit_cast(int, zv[p]), e)) * w; }
#pragma unroll
        for (int p = 0; p < 8; ++p) h1[p] = __sinf(fr * h1[p]);
#pragma unroll 4
        for (int i = 0; i < 64; ++i) { const float w = w2[i * 64 + lane];
#pragma unroll
            for (int p = 0; p < 8; ++p) h2[p] += __builtin_bit_cast(float, __builtin_amdgcn_readlane(__builtin_bit_cast(int, h1[p]), i)) * w; }
#pragma unroll
        for (int p = 0; p < 8; ++p) hs[lane * 8 + p] = __sinf(fr * h2[p]);
        }
        asm volatile("s_waitcnt lgkmcnt(0)" ::: "memory");
        float acc[4][8];
#pragma unroll
        for (int q = 0; q < 4; ++q)
#pragma unroll
            for (int p = 0; p < 8; ++p) acc[q][p] = 0.f;
#pragma unroll 4
        for (int i = 0; i < 64; ++i) {
            const f32x4 ha = *(const LAS f32x4*)(hs + i * 8), hb = *(const LAS f32x4*)(hs + i * 8 + 4);
#pragma unroll
            for (int q = 0; q < 4; ++q) { const float w = w3s[i * 256 + q * 64 + lane];
                acc[q][0] += ha[0] * w; acc[q][1] += ha[1] * w; acc[q][2] += ha[2] * w; acc[q][3] += ha[3] * w;
                acc[q][4] += hb[0] * w; acc[q][5] += hb[1] * w; acc[q][6] += hb[2] * w; acc[q][7] += hb[3] * w; }
        }
        asm volatile("s_waitcnt lgkmcnt(0)" ::: "memory");
        bf16_t* Fg = (bf16_t*)(ws + WS_FILT + (size_t)j * FILT_LAYER + (L == 2048 ? MiB : 0));
        const float mind = -3.0701134573253945f, maxd = -15.350567286626973f;
        for (int reps = 0; reps < REP_FS; ++reps)
#pragma unroll
        for (int q = 0; q < 4; ++q) { const int ch = ch4 * 256 + q * 64 + lane;
            const float ad = -(mind + (maxd - mind) * ((float)ch / 1023.f));
            float v[8];
#pragma unroll
            for (int p = 0; p < 8; ++p) { const int t = t0 + p; const float tn = (float)t / (float)(L - 1);
                float x = acc[q][p] * __expf(-tn * ad); if (t > L - 1) x = 0.f; if (half == 0 && t == 0) x += ap->in[I_DBIAS][j * 1024 + ch]; v[p] = x; }
            u32x4 o;
            if (half == 0) { o.x = cvtpk(v[7], v[6]); o.y = cvtpk(v[5], v[4]); o.z = cvtpk(v[3], v[2]); o.w = cvtpk(v[1], v[0]);
                *(u32x4*)(Fg + (size_t)ch * (2 * L) + (L - 8 - pb * 8)) = o; }
            else { o.x = cvtpk(v[0], v[1]); o.y = cvtpk(v[2], v[3]); o.z = cvtpk(v[4], v[5]); o.w = cvtpk(v[6], v[7]);
                *(u32x4*)(Fg + (size_t)ch * (2 * L) + (L + pb * 8)) = o; }
        }
    }
    __syncthreads();
    for (int rep = 0; rep < REP_P0D; ++rep) convert_layer_weights(ap, 0, gw, NGW, (LAS float*)(lds + wave * 16384), lane, 0, I_MIX);
    __syncthreads();
}

DI void row_phase(int gw, int NGW, int lane, const float* __restrict__ xP, const float* __restrict__ xS, float* __restrict__ xout, const bf16_t* __restrict__ Y, const float* __restrict__ ybias,
                  const float* __restrict__ modgate, const float* __restrict__ w_post, const float* __restrict__ w_pre, const float* __restrict__ modshift, const float* __restrict__ modscale, bf16_t* __restrict__ hout) {
    for (int m = gw; m < TT; m += NGW) {
        const int cnd = m < TP ? 0 : 1 + ((m - TP) >> 11);
        const float* xr = m < TP ? xP + (size_t)m * D : xS + (size_t)(m - TP) * D;
        f32x4 x[4], ya[4], bb[4], g[4], wp[4], wn[4], sh[4], sc[4]; u32x2 pa[4], pb[4];
#pragma unroll
        for (int j = 0; j < 4; ++j) x[j] = ((const f32x4*)xr)[lane + 64 * j];
        if (Y) {
#pragma unroll
            for (int j = 0; j < 4; ++j) { pa[j] = ((const u32x2*)(Y + (size_t)m * D))[lane + 64 * j]; pb[j] = ((const u32x2*)(Y + (size_t)TT * D + (size_t)m * D))[lane + 64 * j];
                bb[j] = ((const f32x4*)ybias)[lane + 64 * j]; g[j] = ((const f32x4*)(modgate + cnd * 6144))[lane + 64 * j]; wp[j] = ((const f32x4*)w_post)[lane + 64 * j]; }
        }
        if (hout) {
#pragma unroll
            for (int j = 0; j < 4; ++j) { wn[j] = ((const f32x4*)w_pre)[lane + 64 * j]; sh[j] = ((const f32x4*)(modshift + cnd * 6144))[lane + 64 * j]; sc[j] = ((const f32x4*)(modscale + cnd * 6144))[lane + 64 * j]; }
        }
        if (Y) {
            float ss = 0.f;
#pragma unroll
            for (int j = 0; j < 4; ++j) { ya[j] = (f32x4){bflo(pa[j].x) + bflo(pb[j].x), bfhi(pa[j].x) + bfhi(pb[j].x), bflo(pa[j].y) + bflo(pb[j].y), bfhi(pa[j].y) + bfhi(pb[j].y)} + bb[j]; ss += (ya[j].x * ya[j].x + ya[j].y * ya[j].y) + (ya[j].z * ya[j].z + ya[j].w * ya[j].w); }
            ss = wave_sum(ss); const float rstd = 1.f / sqrtf(ss * (1.f / D) + EPS);
#pragma unroll
            for (int j = 0; j < 4; ++j) x[j] += g[j] * (ya[j] * rstd * wp[j]);
        }
        u32x2 o[4];
        if (hout) {
            float ss = 0.f;
#pragma unroll
            for (int j = 0; j < 4; ++j) ss += (x[j].x * x[j].x + x[j].y * x[j].y) + (x[j].z * x[j].z + x[j].w * x[j].w);
            ss = wave_sum(ss); const float rstd = 1.f / sqrtf(ss * (1.f / D) + EPS);
#pragma unroll
            for (int j = 0; j < 4; ++j) { const f32x4 h = (x[j] * rstd * wn[j]) * (sc[j] + 1.f) + sh[j]; o[j].x = cvtpk(h.x, h.y); o[j].y = cvtpk(h.z, h.w); }
        }
#pragma unroll
        for (int j = 0; j < 4; ++j) ((f32x4*)(xout + (size_t)m * D))[lane + 64 * j] = x[j];
        if (hout) {
#pragma unroll
            for (int j = 0; j < 4; ++j) ((u32x2*)(hout + (size_t)m * D))[lane + 64 * j] = o[j];
        }
    }
}

DI void ffn_elem_phase(int gtid, int NT, const bf16_t* __restrict__ z, const float* __restrict__ wdw, const float* __restrict__ bdw, bf16_t* __restrict__ aout) {
    for (int item = gtid; item < 2048 * 352; item += NT) {
        const int r = item / 352, cc = item - r * 352, row0 = 4 * r;
        const int L = row0 < TP ? 256 : 2048, tl0 = row0 & (L - 1);
        float wg[3][8], wv[3][8], bg[8], bv[8];
#pragma unroll
        for (int k = 0; k < 3; ++k)
#pragma unroll
            for (int h = 0; h < 2; ++h) { const f32x4 t0 = *(const f32x4*)(wdw + k * NUP + 8 * cc + 4 * h), t1 = *(const f32x4*)(wdw + k * NUP + DFF + 8 * cc + 4 * h);
#pragma unroll
                for (int e = 0; e < 4; ++e) { wg[k][4 * h + e] = t0[e]; wv[k][4 * h + e] = t1[e]; } }
#pragma unroll
        for (int h = 0; h < 2; ++h) { const f32x4 t0 = *(const f32x4*)(bdw + 8 * cc + 4 * h), t1 = *(const f32x4*)(bdw + DFF + 8 * cc + 4 * h);
#pragma unroll
            for (int e = 0; e < 4; ++e) { bg[4 * h + e] = t0[e]; bv[4 * h + e] = t1[e]; } }
        const bf16_t* zb = z + (size_t)row0 * NUP + 8 * cc;
        const u32x4 zero4 = {0u, 0u, 0u, 0u};
        u32x4 rg[6], rv[6];
        rg[0] = tl0 > 0 ? *(const u32x4*)(zb - NUP) : zero4; rv[0] = tl0 > 0 ? *(const u32x4*)(zb - NUP + DFF) : zero4;
#pragma unroll
        for (int k = 0; k < 4; ++k) { rg[1 + k] = *(const u32x4*)(zb + (size_t)k * NUP); rv[1 + k] = *(const u32x4*)(zb + (size_t)k * NUP + DFF); }
        { const bool has_next = (tl0 + 4) < L; rg[5] = has_next ? *(const u32x4*)(zb + (size_t)4 * NUP) : zero4; rv[5] = has_next ? *(const u32x4*)(zb + (size_t)4 * NUP + DFF) : zero4; }
        u32x4 wout[4];
#pragma unroll
        for (int k = 0; k < 4; ++k) {
            float pg[8], pv[8], cg_[8], cv[8], ng[8], nv[8], o[8];
            unpack8(rg[k], pg); unpack8(rv[k], pv); unpack8(rg[k + 1], cg_); unpack8(rv[k + 1], cv); unpack8(rg[k + 2], ng); unpack8(rv[k + 2], nv);
#pragma unroll
            for (int e = 0; e < 8; ++e) { const float g = wg[0][e] * pg[e] + wg[1][e] * cg_[e] + wg[2][e] * ng[e] + bg[e]; const float v = wv[0][e] * pv[e] + wv[1][e] * cv[e] + wv[2][e] * nv[e] + bv[e];
                o[e] = (g / (1.f + __expf(-g))) * v; }
            wout[k].x = cvtpk(o[0], o[1]); wout[k].y = cvtpk(o[2], o[3]); wout[k].z = cvtpk(o[4], o[5]); wout[k].w = cvtpk(o[6], o[7]);
        }
#pragma unroll
        for (int k = 0; k < 4; ++k) *(u32x4*)(aout + (size_t)(row0 + k) * DFF + 8 * cc) = wout[k];
    }
}

DI void ffn_edge_fix(int tid, int pm, int ks, const float* __restrict__ side, const float* __restrict__ wdw, bf16_t* __restrict__ aout) {
    const bool sample = pm >= 16; const int st = (pm - 16) & 7;
    float pg[11], pv[11], og[11], ov[11], wg[11], wv[11];
#pragma unroll
    for (int k = 0; k < 11; ++k) {
        const int idx = tid + 512 * k, e = idx / 1408, n = ks * 1408 + (idx - e * 1408);
        const float* mine = side + (size_t)((pm * 4 + e) * 2) * NUP;
        int pt = -1, tap = 0;
        if (e == 1) { pt = pm * 4 + 2; tap = 2; } else if (e == 2) { pt = pm * 4 + 1; tap = 0; }
        else if (e == 0) { if (sample && st != 0) { pt = (pm - 1) * 4 + 3; tap = 0; } }
        else { if (sample && st != 7) { pt = (pm + 1) * 4 + 0; tap = 2; } }
        const float* o = side + (size_t)((pt < 0 ? pm * 4 + e : pt) * 2) * NUP;
        const float msk = pt < 0 ? 0.f : 1.f;
        pg[k] = mine[NUP + n]; pv[k] = mine[NUP + DFF + n];
        og[k] = o[n] * msk; ov[k] = o[DFF + n] * msk;
        wg[k] = wdw[tap * NUP + n]; wv[k] = wdw[tap * NUP + DFF + n];
    }
#pragma unroll
    for (int k = 0; k < 11; ++k) {
        const int idx = tid + 512 * k, e = idx / 1408, n = ks * 1408 + (idx - e * 1408);
        const float g = pg[k] + wg[k] * og[k], v = pv[k] + wv[k] * ov[k];
        const float r = g * __builtin_amdgcn_rcpf(1.f + __expf(-g)) * v;
        const int tok = pm * 256 + (e == 0 ? 0 : (e == 1 ? 127 : (e == 2 ? 128 : 255)));
        aout[(size_t)tok * DFF + n] = (bf16_t)(cvtpk(r, 0.f) & 0xffffu);
    }
    asm volatile("s_waitcnt vmcnt(0)" ::: "memory");
    __syncthreads();
}

constexpr int CV_G = 0, CV_GCH = 5120, CV_F = 40960, CV_FCH = 8192;
DI void conv_phase(LAS unsigned char* lds, int tid, int lane, int wave, int G, const bf16_t* __restrict__ z, const float* __restrict__ wsh, const float* __restrict__ bsh, const unsigned char* __restrict__ filt, bf16_t* __restrict__ yh) {
    for (int u = blockIdx.x; u < 512; u += G) {
        const int grp = u < 256 ? 2 + (u >> 7) : ((u - 256) >> 7), c0 = (u & 127) * 8;
        const int row0 = grp * 2048, L = grp < 2 ? 256 : 2048, nb = L >> 5;
        for (int rep1 = 0; rep1 < REP_CV1; ++rep1) {
            float w1[3][8], wv[3][8], b1[8], bv[8];
#pragma unroll
            for (int k = 0; k < 3; ++k)
#pragma unroll
                for (int h = 0; h < 2; ++h) { const f32x4 t0 = *(const f32x4*)(wsh + k * NMIX + 1024 + c0 + 4 * h), t1 = *(const f32x4*)(wsh + k * NMIX + 2048 + c0 + 4 * h);
#pragma unroll
                    for (int e = 0; e < 4; ++e) { w1[k][4 * h + e] = t0[e]; wv[k][4 * h + e] = t1[e]; } }
#pragma unroll
            for (int h = 0; h < 2; ++h) { const f32x4 t0 = *(const f32x4*)(bsh + 1024 + c0 + 4 * h), t1 = *(const f32x4*)(bsh + 2048 + c0 + 4 * h);
#pragma unroll
                for (int e = 0; e < 4; ++e) { b1[4 * h + e] = t0[e]; bv[4 * h + e] = t1[e]; } }
            const u32x4 zero4 = {0u, 0u, 0u, 0u};
            for (int idx = tid; idx < 2048; idx += 512) {
                const int tl = idx & (L - 1);
                const bf16_t* z1 = z + ((size_t)(128 + (c0 >> 3)) * TT + row0 + idx) * 8; const bf16_t* zv = z + ((size_t)(256 + (c0 >> 3)) * TT + row0 + idx) * 8;
                const u32x4 p1 = tl > 0 ? *(const u32x4*)(z1 - 8) : zero4, pv_ = tl > 0 ? *(const u32x4*)(zv - 8) : zero4;
                const u32x4 q1 = *(const u32x4*)z1, qv = *(const u32x4*)zv;
                const u32x4 n1 = tl < L - 1 ? *(const u32x4*)(z1 + 8) : zero4, nv = tl < L - 1 ? *(const u32x4*)(zv + 8) : zero4;
                float a[8], b[8], c[8], d[8], e_[8], f[8];
                unpack8(p1, a); unpack8(q1, b); unpack8(n1, c); unpack8(pv_, d); unpack8(qv, e_); unpack8(nv, f);
                LAS bf16_t* gp = (LAS bf16_t*)(lds + CV_G + (idx >> 5) * 80 + (idx & 31) * 2);
#pragma unroll
                for (int e = 0; e < 8; ++e) { const float x1 = w1[0][e] * a[e] + w1[1][e] * b[e] + w1[2][e] * c[e] + b1[e]; const float v = wv[0][e] * d[e] + wv[1][e] * e_[e] + wv[2][e] * f[e] + bv[e];
                    gp[e * (CV_GCH / 2)] = (bf16_t)(cvtpk(v * x1, 0.f) & 0xffffu); }
            }
            const u32x4* fsrc = (const u32x4*)(filt + (L == 2048 ? MiB : 0) + (size_t)(c0 + wave) * (size_t)(4 * L));
            LAS u32x4* fdst = (LAS u32x4*)(lds + CV_F + wave * CV_FCH);
            if (L == 2048) { u32x4 fv[8];
#pragma unroll
                for (int i = 0; i < 8; ++i) fv[i] = fsrc[lane + 64 * i];
#pragma unroll
                for (int i = 0; i < 8; ++i) fdst[lane + 64 * i] = fv[i]; }
            else fdst[lane] = fsrc[lane];
        }
        __syncthreads();
        f32x16 acc0, acc1;
        for (int rep2 = 0; rep2 < REP_CV2; ++rep2) {
#pragma unroll
        for (int i = 0; i < 16; ++i) { acc0[i] = 0.f; acc1[i] = 0.f; }
            const int p = lane & 31, kg = lane >> 5;
            const LAS unsigned char* Fw = lds + CV_F + wave * CV_FCH;
            const LAS unsigned char* Gw = lds + CV_G + wave * CV_GCH;
            const int bi0 = p & (nb - 1), bi1 = (32 + p) & (nb - 1);
            const u32x4 zero4 = {0u, 0u, 0u, 0u};
#define CONV_STEP(T0, T1) do { \
                const int s0 = L - 1 - 32 * d - p + 8 * kg; \
                const LAS unsigned* fp = (const LAS unsigned*)Fw + (s0 >> 1); \
                const unsigned sh = (s0 & 1) * 16; \
                unsigned w0[5], w1_[5]; \
                _Pragma("unroll") for (int i = 0; i < 5; ++i) { w0[i] = fp[i]; w1_[i] = fp[8 + i]; } \
                int blk0 = p - d; blk0 = blk0 < 0 ? 0 : (blk0 > 63 ? 63 : blk0); \
                int blk1 = 32 + p - d; blk1 = blk1 < 0 ? 0 : (blk1 > 63 ? 63 : blk1); \
                const LAS unsigned char* bp0 = Gw + blk0 * 80 + kg * 16; const LAS unsigned char* bp1 = Gw + blk1 * 80 + kg * 16; \
                u32x4 B00 = zero4, B01 = zero4, B10 = zero4, B11 = zero4; \
                if (T0) { B00 = *(const LAS u32x4*)bp0; B01 = *(const LAS u32x4*)(bp0 + 32); } \
                if (T1) { B10 = *(const LAS u32x4*)bp1; B11 = *(const LAS u32x4*)(bp1 + 32); } \
                const bool valid0 = (unsigned)(bi0 - d) < (unsigned)nb, valid1 = (unsigned)(bi1 - d) < (unsigned)nb; \
                u32x4 A0, A1; \
                A0.x = __builtin_amdgcn_alignbit(w0[1], w0[0], sh); A0.y = __builtin_amdgcn_alignbit(w0[2], w0[1], sh); A0.z = __builtin_amdgcn_alignbit(w0[3], w0[2], sh); A0.w = __builtin_amdgcn_alignbit(w0[4], w0[3], sh); \
                A1.x = __builtin_amdgcn_alignbit(w1_[1], w1_[0], sh); A1.y = __builtin_amdgcn_alignbit(w1_[2], w1_[1], sh); A1.z = __builtin_amdgcn_alignbit(w1_[3], w1_[2], sh); A1.w = __builtin_amdgcn_alignbit(w1_[4], w1_[3], sh); \
                const bf16x8 a0 = __builtin_bit_cast(bf16x8, A0), a1 = __builtin_bit_cast(bf16x8, A1); \
                if (!valid0) { B00 = zero4; B01 = zero4; } \
                if (!valid1) { B10 = zero4; B11 = zero4; } \
                if (T0) acc0 = __builtin_amdgcn_mfma_f32_32x32x16_bf16(a0, __builtin_bit_cast(bf16x8, B00), acc0, 0, 0, 0); \
                if (T1) acc1 = __builtin_amdgcn_mfma_f32_32x32x16_bf16(a0, __builtin_bit_cast(bf16x8, B10), acc1, 0, 0, 0); \
                if (T0) acc0 = __builtin_amdgcn_mfma_f32_32x32x16_bf16(a1, __builtin_bit_cast(bf16x8, B01), acc0, 0, 0, 0); \
                if (T1) acc1 = __builtin_amdgcn_mfma_f32_32x32x16_bf16(a1, __builtin_bit_cast(bf16x8, B11), acc1, 0, 0, 0); \
            } while (0)
            if (nb == 8) {
#pragma unroll 1
                for (int d = -7; d <= 7; ++d) CONV_STEP(true, true);
            } else {
#pragma unroll 1
                for (int d = -63; d <= -32; ++d) CONV_STEP(true, false);
#pragma unroll 1
                for (int d = -31; d <= 31; ++d) CONV_STEP(true, true);
#pragma unroll 1
                for (int d = 32; d <= 63; ++d) CONV_STEP(false, true);
            }
#undef CONV_STEP
        }
        __syncthreads();
        {
            LAS float* ys = (LAS float*)(lds + CV_F) + wave * 2112;
            const int n = lane & 31, hh = lane >> 5;
#pragma unroll
            for (int r = 0; r < 16; ++r) { const int p = (r & 3) + 8 * (r >> 2) + 4 * hh; ys[n * 33 + p] = acc0[r]; ys[(32 + n) * 33 + p] = acc1[r]; }
        }
        __syncthreads();
        for (int rep4 = 0; rep4 < REP_CV4; ++rep4) {
            float w0[3][8], b0[8];
#pragma unroll
            for (int k = 0; k < 3; ++k)
#pragma unroll
                for (int h = 0; h < 2; ++h) { const f32x4 t0 = *(const f32x4*)(wsh + k * NMIX + c0 + 4 * h);
#pragma unroll
                    for (int e = 0; e < 4; ++e) w0[k][4 * h + e] = t0[e]; }
#pragma unroll
            for (int h = 0; h < 2; ++h) { const f32x4 t0 = *(const f32x4*)(bsh + c0 + 4 * h);
#pragma unroll
                for (int e = 0; e < 4; ++e) b0[4 * h + e] = t0[e]; }
            const u32x4 zero4 = {0u, 0u, 0u, 0u};
            const LAS float* ysb = (const LAS float*)(lds + CV_F);
            u32x4 pz[4], cz[4], nz[4];
#pragma unroll
            for (int it = 0; it < 4; ++it) { const int t = tid + 512 * it, tl = t & (L - 1);
                const bf16_t* zb = z + ((size_t)(c0 >> 3) * TT + row0 + t) * 8;
                pz[it] = tl > 0 ? *(const u32x4*)(zb - 8) : zero4; cz[it] = *(const u32x4*)zb; nz[it] = tl < L - 1 ? *(const u32x4*)(zb + 8) : zero4; }
#pragma unroll
            for (int it = 0; it < 4; ++it) { const int t = tid + 512 * it;
                float a[8], b[8], c[8], o[8];
                unpack8(pz[it], a); unpack8(cz[it], b); unpack8(nz[it], c);
#pragma unroll
                for (int e = 0; e < 8; ++e) { const float x0 = w0[0][e] * a[e] + w0[1][e] * b[e] + w0[2][e] * c[e] + b0[e]; o[e] = x0 * ysb[e * 2112 + (t >> 5) * 33 + (t & 31)]; }
                u32x4 w; w.x = cvtpk(o[0], o[1]); w.y = cvtpk(o[2], o[3]); w.z = cvtpk(o[4], o[5]); w.w = cvtpk(o[6], o[7]);
                *(u32x4*)(yh + ((size_t)(c0 >> 3) * TT + row0 + t) * 8) = w;
            }
        }
        __syncthreads();
    }
}

constexpr int AT_K = 0, AT_KROW = 272, AT_V = 64 * 272, AT_VROW = 288, AT_BUF = 64 * 272 + 64 * 288;
DI void attn_phase(LAS unsigned char* lds, int tid, int lane, int wave, int G, const bf16_t* __restrict__ z, const float* __restrict__ cache_k, const float* __restrict__ cache_v, const float* __restrict__ subln, float lam, float lam_init, bf16_t* __restrict__ yh) {
    const float C2 = 0.125f * 1.4426950408889634f;
    const int q16 = lane & 15, kg = lane >> 4;
    for (int u = blockIdx.x; u < 512; u += G) {
        int b, h, qrow0, krow0, ntile; bool sample = u < 256;
        if (sample) { b = u >> 7; h = (u >> 4) & 7; const int qb = u & 15; krow0 = TP + b * 2048; qrow0 = krow0 + qb * 128; ntile = 36; }
        else { const int v = u - 256; b = v >> 4; h = (v >> 1) & 7; const int qb = v & 1; krow0 = b * 256; qrow0 = krow0 + qb * 128; ntile = 4; }
        const float* ck = cache_k + (size_t)(b * 16 + h) * 256 * 128;
        const float* cvp = cache_v + (size_t)(b * 16 + h) * 256 * 128;
        bf16x8 q1[2], q2[2];
        { const bf16_t* qp = z + (size_t)(qrow0 + wave * 16 + q16) * NMIX + h * 128 + 8 * kg;
          q1[0] = *(const bf16x8*)qp; q1[1] = *(const bf16x8*)(qp + 32); q2[0] = *(const bf16x8*)(qp + 64); q2[1] = *(const bf16x8*)(qp + 96); }
        f32x4 O1[8], O2[8];
#pragma unroll
        for (int i = 0; i < 8; ++i) { O1[i] = (f32x4){0.f, 0.f, 0.f, 0.f}; O2[i] = (f32x4){0.f, 0.f, 0.f, 0.f}; }
        float m1 = -1e30f, m2 = -1e30f, l1 = 0.f, l2 = 0.f;
        u32x4 kv[2], vv[2];
#define AT_LOAD(KT) do { _Pragma("unroll") for (int i = 0; i < 2; ++i) { const int id = tid + 512 * i, r = id & 63, c8 = id >> 6; \
            if (sample && (KT) < 4) { \
                const float* kp = ck + (size_t)((KT) * 64 + r) * 128 + c8 * 8; const float* vp = cvp + (size_t)((KT) * 64 + r) * 128 + c8 * 8; \
                const f32x4 k0 = *(const f32x4*)kp, k1 = *(const f32x4*)(kp + 4), v0 = *(const f32x4*)vp, v1 = *(const f32x4*)(vp + 4); \
                kv[i].x = cvtpk(k0[0], k0[1]); kv[i].y = cvtpk(k0[2], k0[3]); kv[i].z = cvtpk(k1[0], k1[1]); kv[i].w = cvtpk(k1[2], k1[3]); \
                vv[i].x = cvtpk(v0[0], v0[1]); vv[i].y = cvtpk(v0[2], v0[3]); vv[i].z = cvtpk(v1[0], v1[1]); vv[i].w = cvtpk(v1[2], v1[3]); \
            } else { \
                const int kr = krow0 + (sample ? (KT) - 4 : (KT)) * 64 + r; \
                const bf16_t* kp = z + (size_t)kr * NMIX + 1024 + h * 128 + c8 * 8; \
                kv[i] = *(const u32x4*)kp; vv[i] = *(const u32x4*)(kp + 1024); \
            } } } while (0)
#define AT_STORE(BUF) do { _Pragma("unroll") for (int i = 0; i < 2; ++i) { const int id = tid + 512 * i, r = id & 63, c8 = id >> 6; \
            *(LAS u32x4*)(lds + (BUF) * AT_BUF + AT_K + r * AT_KROW + c8 * 16) = kv[i]; \
            *(LAS u32x4*)(lds + (BUF) * AT_BUF + AT_V + r * AT_VROW + c8 * 16) = vv[i]; } } while (0)
        __syncthreads();
        AT_LOAD(0); AT_STORE(0);
        if (ntile > 1) AT_LOAD(1);
        __syncthreads();
        for (int kt = 0; kt < ntile; ++kt) {
            if (kt + 1 < ntile) AT_STORE((kt + 1) & 1);
            if (kt + 2 < ntile) AT_LOAD(kt + 2);
            const LAS unsigned char* kbase = lds + (kt & 1) * AT_BUF;
            f32x4 s1[4], s2[4];
#pragma unroll
            for (int hf = 0; hf < 2; ++hf) {
                bf16x8 kf[2][4];
#pragma unroll
                for (int k2 = 0; k2 < 2; ++k2) {
                    const LAS unsigned char* kp = kbase + AT_K + (32 * hf + 8 * (q16 >> 2) + 4 * k2 + (q16 & 3)) * AT_KROW + kg * 16;
                    kf[k2][0] = *(const LAS bf16x8*)kp; kf[k2][1] = *(const LAS bf16x8*)(kp + 64); kf[k2][2] = *(const LAS bf16x8*)(kp + 128); kf[k2][3] = *(const LAS bf16x8*)(kp + 192);
                }
#pragma unroll
                for (int k2 = 0; k2 < 2; ++k2) {
                    f32x4 t = {0.f, 0.f, 0.f, 0.f}, t2 = {0.f, 0.f, 0.f, 0.f};
                    t = __builtin_amdgcn_mfma_f32_16x16x32_bf16(kf[k2][0], q1[0], t, 0, 0, 0); t2 = __builtin_amdgcn_mfma_f32_16x16x32_bf16(kf[k2][2], q2[0], t2, 0, 0, 0);
                    t = __builtin_amdgcn_mfma_f32_16x16x32_bf16(kf[k2][1], q1[1], t, 0, 0, 0); t2 = __builtin_amdgcn_mfma_f32_16x16x32_bf16(kf[k2][3], q2[1], t2, 0, 0, 0);
                    s1[2 * hf + k2] = t; s2[2 * hf + k2] = t2;
                }
            }
            float mx1 = -1e30f, mx2 = -1e30f;
#pragma unroll
            for (int ks = 0; ks < 4; ++ks)
#pragma unroll
                for (int j = 0; j < 4; ++j) { mx1 = fmaxf(mx1, s1[ks][j]); mx2 = fmaxf(mx2, s2[ks][j]); }
            { const float a = __shfl_xor(mx1, 16), b = __shfl_xor(mx2, 16); mx1 = fmaxf(mx1, a); mx2 = fmaxf(mx2, b); }
            { const float a = __shfl_xor(mx1, 32), b = __shfl_xor(mx2, 32); mx1 = fmaxf(mx1, a); mx2 = fmaxf(mx2, b); }
            const float mn1 = fmaxf(m1, mx1 * C2), mn2 = fmaxf(m2, mx2 * C2);
            const float al1 = __builtin_amdgcn_exp2f(m1 - mn1), al2 = __builtin_amdgcn_exp2f(m2 - mn2);
            m1 = mn1; m2 = mn2;
            float ps1 = 0.f, ps2 = 0.f;
#pragma unroll
            for (int ks = 0; ks < 4; ++ks)
#pragma unroll
                for (int j = 0; j < 4; ++j) { const float p1 = __builtin_amdgcn_exp2f(s1[ks][j] * C2 - mn1), p2 = __builtin_amdgcn_exp2f(s2[ks][j] * C2 - mn2); s1[ks][j] = p1; s2[ks][j] = p2; ps1 += p1; ps2 += p2; }
            l1 = l1 * al1 + ps1; l2 = l2 * al2 + ps2;
#pragma unroll
            for (int i = 0; i < 8; ++i) { O1[i] *= al1; O2[i] *= al2; }
#pragma unroll
            for (int s = 0; s < 2; ++s) {
                u32x4 pa, pb;
                pa.x = cvtpk(s1[2 * s][0], s1[2 * s][1]); pa.y = cvtpk(s1[2 * s][2], s1[2 * s][3]); pa.z = cvtpk(s1[2 * s + 1][0], s1[2 * s + 1][1]); pa.w = cvtpk(s1[2 * s + 1][2], s1[2 * s + 1][3]);
                pb.x = cvtpk(s2[2 * s][0], s2[2 * s][1]); pb.y = cvtpk(s2[2 * s][2], s2[2 * s][3]); pb.z = cvtpk(s2[2 * s + 1][0], s2[2 * s + 1][1]); pb.w = cvtpk(s2[2 * s + 1][2], s2[2 * s + 1][3]);
                const bf16x8 P1 = __builtin_bit_cast(bf16x8, pa), P2 = __builtin_bit_cast(bf16x8, pb);
                bf16x8 vf[8];
#pragma unroll
                for (int dt = 0; dt < 8; ++dt) {
                    const LAS unsigned char* vp = kbase + AT_V + (32 * s + 8 * kg + (q16 >> 2)) * AT_VROW + 32 * dt + 8 * (q16 & 3);
                    const s16x4 va = __builtin_bit_cast(s16x4, __builtin_amdgcn_ds_read_tr16_b64_v4i16((LAS s16x4*)vp));
                    const s16x4 vb = __builtin_bit_cast(s16x4, __builtin_amdgcn_ds_read_tr16_b64_v4i16((LAS s16x4*)(vp + 4 * AT_VROW)));
                    const bf16x8 vq = {va[0], va[1], va[2], va[3], vb[0], vb[1], vb[2], vb[3]};
                    vf[dt] = vq;
                }
#pragma unroll
                for (int dt = 0; dt < 8; ++dt) {
                    O1[dt] = __builtin_amdgcn_mfma_f32_16x16x32_bf16(vf[dt], P1, O1[dt], 0, 0, 0);
                    O2[dt] = __builtin_amdgcn_mfma_f32_16x16x32_bf16(vf[dt], P2, O2[dt], 0, 0, 0);
                }
            }
            __syncthreads();
        }
        l1 += __shfl_xor(l1, 16); l1 += __shfl_xor(l1, 32); l2 += __shfl_xor(l2, 16); l2 += __shfl_xor(l2, 32);
        const float r1 = 1.f / l1, r2 = lam / l2;
        float ss = 0.f;
#pragma unroll
        for (int i = 0; i < 8; ++i) { O1[i] = O1[i] * r1 - O2[i] * r2; ss += (O1[i][0] * O1[i][0] + O1[i][1] * O1[i][1]) + (O1[i][2] * O1[i][2] + O1[i][3] * O1[i][3]); }
        ss += __shfl_xor(ss, 16); ss += __shfl_xor(ss, 32);
        const float rstd = (1.f - lam_init) / sqrtf(ss * (1.f / 128.f) + EPS);
        bf16_t* op = yh + (size_t)(qrow0 + wave * 16 + q16) * D + h * 128 + 4 * kg;
#pragma unroll
        for (int i = 0; i < 8; ++i) { const f32x4 w = *(const f32x4*)(subln + 16 * i + 4 * kg); const f32x4 o = O1[i] * rstd * w;
            u32x2 pk; pk.x = cvtpk(o[0], o[1]); pk.y = cvtpk(o[2], o[3]); *(u32x2*)(op + 16 * i) = pk; }
    }
    __syncthreads();
}


#define XB_TMO      128
#define XB_XCNT(j)  (256  + 64 * (j))
#define XB_XSUB(j)  (1280 + 64 * (j))
#define XB_XGEN(j)  (2304 + 64 * (j))
#define XB_TOP      3328
#define XB_TOPGEN   3392
#define XCD_BAR_WORDS 3456
#define XB_SPIN_CAP (1u << 22)
DI unsigned xb_ld(unsigned* p)              { return __hip_atomic_load(p, __ATOMIC_RELAXED, __HIP_MEMORY_SCOPE_AGENT); }
DI unsigned xb_add(unsigned* p, unsigned v) { return __hip_atomic_fetch_add(p, v, __ATOMIC_RELAXED, __HIP_MEMORY_SCOPE_AGENT); }
DI unsigned xb_xcc_id() { return (unsigned)__builtin_amdgcn_s_getreg((3 << 11) | 20) & 0xFu; }
#define XB_SPIN(cond, bar) do { unsigned _sp = 0; while (cond) { __builtin_amdgcn_s_sleep(1); \
    if ((++_sp & 255u) == 0u) { if (xb_ld(&(bar)[XB_TMO])) break; if (_sp > XB_SPIN_CAP) { atomicAdd(&(bar)[XB_TMO], 1u); break; } } } } while (0)
DI void xcd_barrier_complete(unsigned* bar, unsigned x, unsigned& nloc, unsigned& nx) {
    const unsigned G = gridDim.x * gridDim.y * gridDim.z;
    unsigned sum, cnt, mine, sp = 0u;
    for (;;) {
        sum = 0u; cnt = 0u; mine = 0u;
#pragma unroll
        for (unsigned j = 0; j < 16; ++j) { const unsigned c = xb_ld(&bar[XB_XCNT(j)]); sum += c; cnt += (c > 0u) ? 1u : 0u; mine = (j == x) ? c : mine; }
        if (sum == G) break;
        __builtin_amdgcn_s_sleep(1);
        if ((++sp & 255u) == 0u) { if (xb_ld(&bar[XB_TMO])) break; if (sp > XB_SPIN_CAP) { atomicAdd(&bar[XB_TMO], 1u); break; } }
    }
    nloc = mine > 0u ? mine : 1u; nx = cnt > 0u ? cnt : 1u;
}
DI void xcd_barrier(unsigned* bar, volatile LAS unsigned* st) {
    asm volatile("s_waitcnt vmcnt(0)" ::: "memory");
    __syncthreads();
    if (threadIdx.x == 0) {
        const unsigned x = xb_xcc_id();
        __builtin_amdgcn_s_waitcnt(0);
        unsigned nloc = st[0], nx = st[1];
        if (nloc == 0u) { xcd_barrier_complete(bar, x, nloc, nx); st[0] = nloc; st[1] = nx; }
        const unsigned old = xb_add(&bar[XB_XSUB(x)], 1u);
        const unsigned gen = old / nloc;
        if (old + 1u == (gen + 1u) * nloc) {
            __builtin_amdgcn_fence(__ATOMIC_RELEASE, "agent");
            asm volatile("s_waitcnt vmcnt(0)" ::: "memory");
            const unsigned og = xb_add(&bar[XB_TOP], 1u);
            const unsigned tg = og / nx;
            if (og + 1u == (tg + 1u) * nx) xb_add(&bar[XB_TOPGEN], 1u);
            else XB_SPIN(xb_ld(&bar[XB_TOPGEN]) == tg, bar);
            __builtin_amdgcn_fence(__ATOMIC_ACQUIRE, "agent");
            asm volatile("s_waitcnt vmcnt(0)" ::: "memory");
        } else {
            XB_SPIN(xb_ld(&bar[XB_TOPGEN]) == gen, bar);
            __builtin_amdgcn_fence(__ATOMIC_ACQUIRE, "agent");
            asm volatile("s_waitcnt vmcnt(0)" ::: "memory");
        }
    }
    __syncthreads();
}

constexpr int N_PHASES = 30;
__global__ void __launch_bounds__(NWAVES * 64, 2) fwd_megakernel(Args a_byval) {
    extern __shared__ __attribute__((aligned(16))) unsigned char lds_raw[];
    LAS unsigned char* lds = (LAS unsigned char*)lds_raw;
    const int ph_lo = a_byval.ph_lo, ph_hi = a_byval.ph_hi;
    if (threadIdx.x < 64) ((LAS unsigned*)(lds + LDS_MISC))[threadIdx.x] = 0u;
    __syncthreads();
    if (threadIdx.x == 0) (void)xb_add((unsigned*)(a_byval.ws + WS_CTL) + XB_XCNT(xb_xcc_id()), 1u);
    for (int ph = ph_lo; ph < ph_hi; ++ph) {
        ArgsP ap = (ArgsP)__builtin_amdgcn_kernarg_segment_ptr(); asm volatile("" : "+s"(ap));
        int tid = threadIdx.x; asm volatile("" : "+v"(tid));
        unsigned char* ws = ap->ws;
        float* xout = ap->out;
        const int lane = tid & 63, wave = __builtin_amdgcn_readfirstlane(tid >> 6), G = gridDim.x;
        const int gw = blockIdx.x * NWAVES + wave, NGW = G * NWAVES;
        float* newk = xout + (size_t)TT * D; float* newv = newk + (size_t)16 * 2 * 8 * 256 * 128;
        const float* mod = (const float*)(ws + WS_MOD);
        bf16_t* zb = (bf16_t*)(ws + WS_Z); bf16_t* Y = (bf16_t*)(ws + WS_Z + 48 * MiB); float* sideb = (float*)(ws + WS_Z + 80 * MiB);
        bf16_t* hb = (bf16_t*)(ws + WS_A); bf16_t* yhb = (bf16_t*)(ws + WS_A + 16 * MiB); bf16_t* ab = (bf16_t*)(ws + WS_Z);
        const float* normw = ap->in[I_NORMW];
        if (ph == 0) {
            for (int rep = 0; rep < REP_P0; ++rep) phase0(ap, lds, tid, lane, wave, G);
        } else if (ph == N_PHASES - 1) {
            if (KON(0)) row_phase(gw, NGW, lane, xout, xout + (size_t)TP * D, xout, Y, (const float*)(ws + WS_ZERO), mod + 3 * 3 * 6144 + 5 * 1024, normw + (3 * 4 + 3) * D, nullptr, nullptr, nullptr, nullptr);
        } else {
            const int i = (ph - 1) / 7, k7 = (ph - 1) - 7 * i, kind = k7 < 6 ? k7 : 7, j = i >> 1; const bool attn = (i & 1);
            const float* modl = mod + i * 3 * 6144;
            unsigned char* wl = ws + WS_W + (size_t)i * W_LAYER;
            if (kind & 1) {
                if (KON(1)) {
                pg8::Gemm g; pg8::Order S; pg8::EpiU E;
                E.z = pg8::EpiZ{zb, NMIX, nullptr, 0}; E.q = pg8::EpiQKV{zb, (const float*)(ws + WS_ROPE), (const float*)(ws + WS_ROPE) + 2048 * 32, newk + (size_t)j * 8 * 256 * 128, newv + (size_t)j * 8 * 256 * 128};
                E.f = pg8::EpiF32{Y, D, (size_t)TT * D}; E.n = pg8::EpiFFN{ab, ap->in[I_FDW] + (size_t)i * 3 * NUP, ap->in[I_FBDW] + (size_t)i * NUP, sideb};
                if (kind == 1) { g = pg8::Gemm{hb, (const bf16_t*)(wl + W_MIX), TT, NMIX, D, 1, 0}; E.mode = attn ? 1 : 0; E.z.bias = ap->in[I_HBIN] + j * NMIX; E.z.slab = 1; }
                else if (kind == 3) { g = pg8::Gemm{yhb, (const bf16_t*)(wl + W_OUT), TT, D, D, 2, attn ? 0 : 1}; E.mode = 2; }
                else if (kind == 5) { g = pg8::Gemm{hb, (const bf16_t*)(wl + W_UP), TT, NUP, D, 1, 2}; E.mode = 3; }
                else { g = pg8::Gemm{ab, (const bf16_t*)(wl + W_DOWN), TT, D, DFF, 2, 0}; E.mode = 2; }
                S.init(g.M, g.N, g.KS, G, (int)blockIdx.x);
                if (kind == 7) { pg8::Unit u0; for (int ui = 0; S.next(ui, u0); ++ui) ffn_edge_fix(tid, u0.pm, u0.ks, sideb, ap->in[I_FDW] + (size_t)i * 3 * NUP, ab); }
                for (int rep = 0; rep < REP_GEMM; ++rep) pg8::gemm_phase(lds, tid, g, S, E);
                if (kind == 1 && (int)blockIdx.x >= 128 && G == 256)
                    convert_layer_weights(ap, i, ((int)blockIdx.x - 128) * NWAVES + wave, 128 * NWAVES, (LAS float*)(lds + wave * 16384), lane, I_MIX, i < 3 ? I_LAYER + I_MIX : I_LAYER);
                else if (kind == 1 && G != 256) convert_layer_weights(ap, i, gw, NGW, (LAS float*)(lds + wave * 16384), lane, I_MIX, i < 3 ? I_LAYER + I_MIX : I_LAYER);
                }
            } else if (kind == 0 && KON(0)) {
                if (i == 0) row_phase(gw, NGW, lane, ap->in[I_XP], ap->in[I_XS], xout, nullptr, nullptr, nullptr, nullptr, normw + (i * 4 + 0) * D, modl, modl + 1024, hb);
                else row_phase(gw, NGW, lane, xout, xout + (size_t)TP * D, xout, Y, (const float*)(ws + WS_ZERO), modl - 3 * 6144 + 5 * 1024, normw + ((i - 1) * 4 + 3) * D, normw + (i * 4 + 0) * D, modl, modl + 1024, hb);
            } else if (kind == 2) {
                if (!attn) { for (int rep = 0; rep < REP_CONV; ++rep) conv_phase(lds, tid, lane, wave, G, zb, ap->in[I_HWSH] + j * 3 * NMIX, ap->in[I_HBSH] + j * NMIX, ws + WS_FILT + (size_t)j * FILT_LAYER, yhb); }
                else if (KON(9)) {
                    float d1 = 0.f, d2 = 0.f;
                    for (int e = 0; e < 64; ++e) { d1 += ap->in[I_LQ1][j * 64 + e] * ap->in[I_LK1][j * 64 + e]; d2 += ap->in[I_LQ2][j * 64 + e] * ap->in[I_LK2][j * 64 + e]; }
                    const float lam_init = 0.8f - 0.6f * __expf(-0.3f * (float)i);
                    const float lam = __expf(d1) - __expf(d2) + lam_init;
                    for (int rep = 0; rep < REP_ATTN; ++rep) attn_phase(lds, tid, lane, wave, G, zb, ap->in[I_CK] + (size_t)j * 8 * 256 * 128, ap->in[I_CV] + (size_t)j * 8 * 256 * 128, ap->in[I_SUBLN] + j * 128, lam, lam_init, yhb);
                }
            } else if (kind == 4 && KON(0)) {
                row_phase(gw, NGW, lane, xout, xout + (size_t)TP * D, xout, Y, attn ? (const float*)(ws + WS_ZERO) : ap->in[I_HBOUT] + j * D, modl + 2 * 1024, normw + (i * 4 + 1) * D, normw + (i * 4 + 2) * D, modl + 3 * 1024, modl + 4 * 1024, hb);
            } else if (kind == 6 && KON(6)) {
                for (int rep = 0; rep < REP_ELEM; ++rep) ffn_elem_phase(blockIdx.x * 512 + tid, G * 512, zb, ap->in[I_FDW] + (size_t)i * 3 * NUP, ap->in[I_FBDW] + (size_t)i * NUP, ab);
            }
        }
        if (ph + 1 < ph_hi) {
            if (ph_hi > 4096) cg::this_grid().sync();
            for (int rep = 0; rep < REP_SYNC; ++rep) xcd_barrier((unsigned*)(ws + WS_CTL), (volatile LAS unsigned*)(lds + LDS_MISC + 32));
        }
    }
}

extern "C" void kernel_launch(void* const* d_in, const int* in_sizes, int n_in, void* d_out, int out_size, void* d_ws, size_t ws_size, hipStream_t stream) {
    static int grid = 0;
    if (grid == 0) {
        if (n_in != 33 || ws_size < WS_END) { fprintf(stderr, "kernel_launch: unexpected inputs (n_in %d, ws %zu)\n", n_in, ws_size); grid = -1; return; }
        int dev = 0, cus = 0, per_cu = 0;
        hipGetDevice(&dev); hipDeviceGetAttribute(&cus, hipDeviceAttributeMultiprocessorCount, dev);
        if (hipFuncSetAttribute((const void*)fwd_megakernel, hipFuncAttributeMaxDynamicSharedMemorySize, LDS_BYTES) != hipSuccess) { fprintf(stderr, "kernel_launch: hipFuncSetAttribute failed\n"); grid = -1; return; }
        if (hipOccupancyMaxActiveBlocksPerMultiprocessor(&per_cu, (const void*)fwd_megakernel, NWAVES * 64, LDS_BYTES) != hipSuccess || per_cu < 1) { fprintf(stderr, "kernel_launch: occupancy query says %d\n", per_cu); per_cu = 1; }
        (void)hipGetLastError();
        grid = cus * 1;
    }
    if (grid < 0) return;
    if (hipMemsetAsync((char*)d_ws + WS_CTL, 0, CTL_BYTES, stream) != hipSuccess) { fprintf(stderr, "kernel_launch: memset failed\n"); return; }
    Args a{};
    for (int i = 0; i < 33; ++i) a.in[i] = (const float*)d_in[i];
    a.out = (float*)d_out; a.ws = (unsigned char*)d_ws;
#if MK_ONE_LAUNCH
    a.ph_lo = 0; a.ph_hi = N_PHASES;
    void* args[] = {&a};
    hipError_t e = hipLaunchCooperativeKernel((const void*)fwd_megakernel, dim3(grid), dim3(NWAVES * 64), args, LDS_BYTES, stream);
    if (e != hipSuccess) fprintf(stderr, "cooperative launch failed: %s (grid %d)\n", hipGetErrorString(e), grid);
#else
    for (int ph = 0; ph < N_PHASES; ++ph) {
        a.ph_lo = ph; a.ph_hi = ph + 1;
        void* args[] = {&a};
        hipError_t e = hipLaunchCooperativeKernel((const void*)fwd_megakernel, dim3(grid), dim3(NWAVES * 64), args, LDS_BYTES, stream);
        if (e != hipSuccess) { fprintf(stderr, "launch %d failed: %s (grid %d)\n", ph, hipGetErrorString(e), grid); break; }
    }
#endif
}
```

```cpp
#include <hip/hip_runtime.h>
#include <hip/hip_cooperative_groups.h>
#include <cstdio>
#include <cstdint>
namespace cg = cooperative_groups;

#ifndef KMASK
#define KMASK 0xFFFF
#endif
#define KON(n) ((KMASK >> (n)) & 1)
#ifndef REP_P0A
#define REP_P0A 1
#endif
#ifndef REP_P0C
#define REP_P0C 1
#endif
#ifndef REP_P0D
#define REP_P0D 1
#endif
#ifndef REP_CV1
#define REP_CV1 1
#endif
#ifndef REP_CV2
#define REP_CV2 1
#endif
#ifndef REP_CV4
#define REP_CV4 1
#endif
#ifndef REP_FC
#define REP_FC 1
#endif
#ifndef REP_FS
#define REP_FS 1
#endif
#ifndef REP_GEMM
#define REP_GEMM 1
#endif
#ifndef REP_CONV
#define REP_CONV 1
#endif
#ifndef REP_ATTN
#define REP_ATTN 1
#endif
#ifndef REP_ELEM
#define REP_ELEM 1
#endif
#ifndef REP_P0
#define REP_P0 1
#endif
#ifndef REP_SYNC
#define REP_SYNC 1
#endif
#ifndef MK_ONE_LAUNCH
#define MK_ONE_LAUNCH 1
#endif

#define LAS __attribute__((address_space(3)))
typedef unsigned short bf16_t;
typedef short bf16x8 __attribute__((ext_vector_type(8)));
typedef short s16x4 __attribute__((ext_vector_type(4)));
typedef float f32x4 __attribute__((ext_vector_type(4)));
typedef float f32x16 __attribute__((ext_vector_type(16)));
typedef unsigned u32x4 __attribute__((ext_vector_type(4)));
typedef unsigned u32x2 __attribute__((ext_vector_type(2)));
typedef float f32x2_t __attribute__((ext_vector_type(2)));
typedef __bf16 bf16x2_t __attribute__((ext_vector_type(2)));

#define DI __device__ __forceinline__
DI unsigned cvtpk(float lo, float hi) { f32x2_t v = {lo, hi}; bf16x2_t b = __builtin_convertvector(v, bf16x2_t); return __builtin_bit_cast(unsigned, b); }
DI float bflo(unsigned u) { return __builtin_bit_cast(float, u << 16); }
DI float bfhi(unsigned u) { return __builtin_bit_cast(float, u & 0xffff0000u); }
DI void unpack8(u32x4 v, float* f) { f[0] = bflo(v.x); f[1] = bfhi(v.x); f[2] = bflo(v.y); f[3] = bfhi(v.y); f[4] = bflo(v.z); f[5] = bfhi(v.z); f[6] = bflo(v.w); f[7] = bfhi(v.w); }
DI float wave_sum(float v) {
#pragma unroll
    for (int o = 1; o < 64; o <<= 1) v += __shfl_xor(v, o);
    return v;
}

constexpr int D = 1024, TT = 8192, TP = 4096, DFF = 2816, NUP = 5632, NMIX = 3072;
constexpr float EPS = 1e-6f;
constexpr int NWAVES = 8;
constexpr int LDS_BYTES = 139264, LDS_MISC = 135168;

constexpr size_t MiB = 1u << 20;
constexpr size_t WS_MOD = 0;
constexpr size_t WS_CTL = 512 * 1024, CTL_BYTES = 32768, WS_ZERO = WS_CTL + 16384;
constexpr size_t WS_ROPE = 1 * MiB;
constexpr size_t WS_W = 2 * MiB;
constexpr size_t W_MIX = 0, W_OUT = 6291456, W_UP = W_OUT + 2097152, W_DOWN = W_UP + 11534336, W_LAYER = W_DOWN + 5767168;
static_assert(W_LAYER == 25690112, "layer weight bytes");
constexpr size_t WS_FILT = 100 * MiB;
constexpr size_t FILT_LAYER = 9 * MiB;
constexpr size_t WS_Z = 118 * MiB;
constexpr size_t WS_A = 206 * MiB;
constexpr size_t WS_END = 254 * MiB;
static_assert(WS_W + 4 * W_LAYER <= WS_FILT, "ws map");

namespace pg8 {
constexpr int BM = 256, BK = 64, HALF = 128, HTB = HALF * BK * 2, STAGE_BYTES = 8 * HTB, NXCD = 8, WGM = 4;
DI int lds_byte(int r, int c) { const int st = (r >> 4) * 2 + (c >> 5), rr = r & 15, cc = c & 31, ob = rr * 64 + cc * 2; return st * 1024 + (ob ^ (((ob >> 9) & 1) << 5)); }
DI void stage_rc(int b, int& R, int& C) { const int st = b / 1024, sb = b % 1024, swz = sb ^ (((sb >> 9) & 1) << 5); R = (st >> 1) * 16 + swz / 64; C = (st & 1) * 32 + (swz % 64) / 2; }
DI int perm32(int rho) { const int n = rho >> 4, i = rho & 15; return 8 * (i >> 2) + 4 * n + (i & 3); }

struct Unit { int pm, pn, ks; };
struct Gemm { const bf16_t* A; const bf16_t* Bt; int M, N, K, KS, aslab; };

struct Order {
    int nM, nN, nwg, G, c, KS;
    DI void init(int M, int N, int KS_, int G_, int c_) { nM = M / BM; nN = N / BM; nwg = nM * nN; G = G_; c = c_; KS = KS_; }
    DI bool next(int i, Unit& u) const {
        const int L = i * G + c; if (L >= nwg * KS) return false;
        u.ks = L / nwg;
        int wgid = L % nwg; { const int q = nwg / NXCD, r = nwg % NXCD, xcd = wgid % NXCD, off = wgid / NXCD; wgid = (xcd < r ? xcd * (q + 1) : r * (q + 1) + (xcd - r) * q) + off; }
        const int nig = WGM * nN, gid = wgid / nig, fm = gid * WGM, gsz = (nM - fm) < WGM ? (nM - fm) : WGM;
        u.pm = fm + ((wgid % nig) % gsz); u.pn = (wgid % nig) / gsz; return true;
    }
};

struct EpiZ {
    bf16_t* O; int ldc; const float* bias; int slab;
    DI void operator()(const f32x4 (&acc)[2][2][4][2], const Unit& u, int wr, int wc, int fr, int fq) const {
        const int row0 = u.pm * BM + wr * 64 + fr, col0 = u.pn * BM + wc * 32 + 8 * fq;
        f32x4 bv[2][2];
#pragma unroll
        for (int bj = 0; bj < 2; ++bj)
#pragma unroll
            for (int n = 0; n < 2; ++n) bv[bj][n] = bias ? *(const f32x4*)(bias + col0 + bj * HALF + 4 * n) : (f32x4){0.f, 0.f, 0.f, 0.f};
#pragma unroll
        for (int ai = 0; ai < 2; ++ai)
#pragma unroll
            for (int m = 0; m < 4; ++m) { const int row = row0 + ai * HALF + m * 16;
                bf16_t* rowp = slab ? O + ((size_t)(col0 >> 3) * TT + row) * 8 : O + (size_t)row * ldc + col0;
                const size_t bjs = slab ? (size_t)16 * TT * 8 : (size_t)HALF;
#pragma unroll
                for (int bj = 0; bj < 2; ++bj) { const f32x4 v0 = acc[ai][bj][m][0] + bv[bj][0], v1 = acc[ai][bj][m][1] + bv[bj][1];
                    u32x4 w; w.x = cvtpk(v0[0], v0[1]); w.y = cvtpk(v0[2], v0[3]); w.z = cvtpk(v1[0], v1[1]); w.w = cvtpk(v1[2], v1[3]);
                    *(u32x4*)(rowp + bj * bjs) = w; } }
    }
};

struct EpiQKV {
    bf16_t* O; const float* ropec; const float* ropes; float* newk; float* newv;
    DI void operator()(const f32x4 (&acc)[2][2][4][2], const Unit& u, int wr, int wc, int fr, int fq) const {
        const int row0 = u.pm * BM + wr * 64 + fr, col0 = u.pn * BM + wc * 32 + 8 * fq;
        const bool sample = u.pm >= 16; const int sec = u.pn >> 2;
        const bool rope = sample && sec < 2;
        const float sgn = (fq & 2) ? 1.f : -1.f;
        const int axis = (col0 >> 5) & 1, f0 = col0 & 15;
#pragma unroll
        for (int ai = 0; ai < 2; ++ai) {
#pragma unroll
          for (int mh = 0; mh < 2; ++mh) {
            f32x4 c0[2], c1[2], s0[2], s1[2];
            if (rope) {
#pragma unroll
                for (int m2 = 0; m2 < 2; ++m2) { const int tpos = (row0 + ai * HALF + (2 * mh + m2) * 16 - TP) & 2047;
                    const float* cp = ropec + tpos * 32 + axis * 16 + f0; const float* sp = ropes + tpos * 32 + axis * 16 + f0;
                    c0[m2] = *(const f32x4*)cp; c1[m2] = *(const f32x4*)(cp + 4); s0[m2] = *(const f32x4*)sp; s1[m2] = *(const f32x4*)(sp + 4); }
            }
#pragma unroll
            for (int m2 = 0; m2 < 2; ++m2) { const int m = 2 * mh + m2; const int row = row0 + ai * HALF + m * 16;
#pragma unroll
                for (int bj = 0; bj < 2; ++bj) { const int col = col0 + bj * HALF;
                    f32x4 v0 = acc[ai][bj][m][0], v1 = acc[ai][bj][m][1];
                    if (rope) {
                        f32x4 p0, p1;
#pragma unroll
                        for (int e = 0; e < 4; ++e) { p0[e] = __shfl_xor(v0[e], 32); p1[e] = __shfl_xor(v1[e], 32); }
                        v0 = v0 * c0[m2] + (p0 * s0[m2]) * sgn; v1 = v1 * c1[m2] + (p1 * s1[m2]) * sgn;
                    }
                    u32x4 w; w.x = cvtpk(v0[0], v0[1]); w.y = cvtpk(v0[2], v0[3]); w.z = cvtpk(v1[0], v1[1]); w.w = cvtpk(v1[2], v1[3]);
                    *(u32x4*)(O + (size_t)row * NMIX + col) = w;
                    if (!sample && sec >= 1) {
                        const int cc = col - sec * 1024, h = cc >> 7, d = cc & 127, b = row >> 8, t = row & 255;
                        float* dst = (sec == 1 ? newk : newv) + ((size_t)((b * 2) * 8 + h) * 256 + t) * 128 + d;
                        *(f32x4*)dst = v0; *(f32x4*)(dst + 4) = v1;
                    }
                } }
          }
        }
    }
};

struct EpiF32 {
    bf16_t* Y; int ldc; size_t kstride;
    DI void operator()(const f32x4 (&acc)[2][2][4][2], const Unit& u, int wr, int wc, int fr, int fq) const {
        const int row0 = u.pm * BM + wr * 64 + fr, col0 = u.pn * BM + wc * 32 + 8 * fq;
        bf16_t* base = Y + (size_t)u.ks * kstride;
#pragma unroll
        for (int ai = 0; ai < 2; ++ai)
#pragma unroll
            for (int m = 0; m < 4; ++m) { bf16_t* rowp = base + (size_t)(row0 + ai * HALF + m * 16) * ldc + col0;
#pragma unroll
                for (int bj = 0; bj < 2; ++bj) { const f32x4 v0 = acc[ai][bj][m][0], v1 = acc[ai][bj][m][1];
                    u32x4 w; w.x = cvtpk(v0[0], v0[1]); w.y = cvtpk(v0[2], v0[3]); w.z = cvtpk(v1[0], v1[1]); w.w = cvtpk(v1[2], v1[3]);
                    *(u32x4*)(rowp + bj * HALF) = w; } }
    }
};

DI f32x4 bperm4(int addr, const f32x4 v) {
    const float v0 = v[0], v1 = v[1], v2 = v[2], v3 = v[3];
    const int a = __builtin_amdgcn_ds_bpermute(addr, __float_as_int(v0)), b = __builtin_amdgcn_ds_bpermute(addr, __float_as_int(v1));
    const int c = __builtin_amdgcn_ds_bpermute(addr, __float_as_int(v2)), d = __builtin_amdgcn_ds_bpermute(addr, __float_as_int(v3));
    return (f32x4){__int_as_float(a), __int_as_float(b), __int_as_float(c), __int_as_float(d)};
}
struct EpiFFN {
    bf16_t* Aout; const float* wdw; const float* bdw; float* side;
    DI void operator()(const f32x4 (&acc)[2][2][4][2], const Unit& u, int wr, int wc, int fr, int fq) const {
        const int colg = u.pn * 128 + wc * 32 + 8 * fq;
        const int tok0 = u.pm * BM + 8 * (16 * wr + fr);
        const bool efirst = (fr == 0), elast = (fr == 15);
        float* sb = side + (size_t)((u.pm * 4 + wr * 2 + (elast ? 1 : 0)) * 2) * NUP;
        bf16_t* ap_ = Aout + (size_t)tok0 * DFF + colg;
#pragma unroll
        for (int n = 0; n < 2; ++n) {
            const int cg = colg + 4 * n, cv = DFF + colg + 4 * n;
            const f32x4 wg0 = *(const f32x4*)(wdw + cg), wg1 = *(const f32x4*)(wdw + NUP + cg), wg2 = *(const f32x4*)(wdw + 2 * NUP + cg), bg = *(const f32x4*)(bdw + cg);
            const f32x4 wv0 = *(const f32x4*)(wdw + cv), wv1 = *(const f32x4*)(wdw + NUP + cv), wv2 = *(const f32x4*)(wdw + 2 * NUP + cv), bv = *(const f32x4*)(bdw + cv);
            const int lane_ = fq * 16 + fr, pl = ((lane_ - 1) & 63) * 4, nl = ((lane_ + 1) & 63) * 4;
            const float mf = efirst ? 0.f : 1.f, ml = elast ? 0.f : 1.f;
            const f32x4 pg = bperm4(pl, acc[1][0][3][n]) * mf, pv = bperm4(pl, acc[1][1][3][n]) * mf;
#pragma unroll
            for (int q = 0; q < 8; ++q) {
                const f32x4 zgp = q == 0 ? pg : acc[(q - 1) >> 2][0][(q - 1) & 3][n], zgc = acc[q >> 2][0][q & 3][n], zgn = q == 7 ? bperm4(nl, acc[0][0][0][n]) * ml : acc[((q + 1) & 7) >> 2][0][(q + 1) & 3][n];
                const f32x4 zvp = q == 0 ? pv : acc[(q - 1) >> 2][1][(q - 1) & 3][n], zvc = acc[q >> 2][1][q & 3][n], zvn = q == 7 ? bperm4(nl, acc[0][1][0][n]) * ml : acc[((q + 1) & 7) >> 2][1][(q + 1) & 3][n];
                const f32x4 g = wg0 * zgp + wg1 * zgc + wg2 * zgn + bg;
                const f32x4 v = wv0 * zvp + wv1 * zvc + wv2 * zvn + bv;
                const bool edge = (q == 0 && efirst) || (q == 7 && elast);
                if ((q == 0 || q == 7) && edge) {
                    *(f32x4*)(sb + cg) = zgc; *(f32x4*)(sb + cv) = zvc; *(f32x4*)(sb + NUP + cg) = g; *(f32x4*)(sb + NUP + cv) = v;
                } else {
                    float r[4];
#pragma unroll
                    for (int e = 0; e < 4; ++e) r[e] = g[e] * __builtin_amdgcn_rcpf(1.f + __expf(-g[e])) * v[e];
                    u32x2 w; w.x = cvtpk(r[0], r[1]); w.y = cvtpk(r[2], r[3]);
                    *(u32x2*)(ap_ + (size_t)q * DFF + 4 * n) = w;
                }
            }
        }
    }
};

struct EpiU {
    int mode; EpiZ z; EpiQKV q; EpiF32 f; EpiFFN n;
    DI void operator()(const f32x4 (&acc)[2][2][4][2], const Unit& u, int wr, int wc, int fr, int fq) const {
        if (mode == 0) z(acc, u, wr, wc, fr, fq); else if (mode == 1) q(acc, u, wr, wc, fr, fq); else if (mode == 2) f(acc, u, wr, wc, fr, fq); else n(acc, u, wr, wc, fr, fq);
    }
};

template <class Epi>
DI void gemm_phase(LAS unsigned char* lds, const int tid, const Gemm g, const Order& S, const Epi& E) {
    const int wid = __builtin_amdgcn_readfirstlane(tid >> 6), lane = tid & 63, wr = wid >> 2, wc = wid & 3, fr = lane & 15, fq = lane >> 4;
    const int K = g.K, Ksub = K / g.KS, nt = Ksub / BK;
    unsigned voffA[2], voffB[2];
#pragma unroll
    for (int i = 0; i < 2; ++i) { int R, C; stage_rc(tid * 16 + i * 8192, R, C); const int Rb = (R & ~31) + perm32(R & 31);
        const int tau = 8 * ((R >> 6) * 16 + (R & 15)) + ((R >> 4) & 3);
        voffA[i] = g.aslab == 1 ? (unsigned)((C >> 3) * g.M + R) * 16u : (g.aslab == 2 ? (unsigned)(tau * K + C) * 2u : (unsigned)(R * K + C) * 2u); voffB[i] = (unsigned)(Rb * K + C) * 2u; }
    const size_t kstep = (size_t)(BK * 2);
    const size_t hstep = (size_t)HALF * K * 2;
    const size_t tstep = 2 * hstep;
    const size_t ksb = (size_t)Ksub * 2;
    const size_t kstepA = g.aslab == 1 ? (size_t)8 * g.M * 16 : kstep, hstepA = g.aslab == 1 ? (size_t)HALF * 16 : (g.aslab == 2 ? (size_t)4 * K * 2 : hstep), tstepA = g.aslab == 1 ? (size_t)BM * 16 : tstep, ksbA = g.aslab == 1 ? (size_t)(Ksub / 8) * g.M * 16 : ksb;
    const unsigned ldsw = (unsigned)wid * 1024u;
    const int aoff = lds_byte(wr * 64 + fr, fq * 8), boff = lds_byte(wc * 32 + fr, fq * 8);
#define PG8_SA(b, h) (((b) * 2 + (h)) * HTB)
#define PG8_SB(b, h) ((4 + (b) * 2 + (h)) * HTB)
#define PG8_STAGE(bufoff, gbase, voff) do { _Pragma("unroll") for (int _i = 0; _i < 2; ++_i) \
        __builtin_amdgcn_global_load_lds((const unsigned*)((const char*)(gbase) + (voff)[_i]), (LAS unsigned*)(lds + (bufoff) + ldsw + _i * 8192), 16, 0, 0); } while (0)
#define PG8_LDA(dst, b, h) do { _Pragma("unroll") for (int m = 0; m < 4; ++m) _Pragma("unroll") for (int k = 0; k < 2; ++k) dst[m][k] = *(const LAS bf16x8*)(lds + PG8_SA(b, h) + aoff + m * 2048 + k * 1024); } while (0)
#define PG8_LDB(dst, b, h) do { _Pragma("unroll") for (int n = 0; n < 2; ++n) _Pragma("unroll") for (int k = 0; k < 2; ++k) dst[n][k] = *(const LAS bf16x8*)(lds + PG8_SB(b, h) + boff + n * 2048 + k * 1024); } while (0)
#define PG8_MMA(ai, bj, At, Bt) do { __builtin_amdgcn_s_setprio(1); _Pragma("unroll") for (int m = 0; m < 4; ++m) _Pragma("unroll") for (int n = 0; n < 2; ++n) _Pragma("unroll") for (int k = 0; k < 2; ++k) \
        acc[ai][bj][m][n] = __builtin_amdgcn_mfma_f32_16x16x32_bf16(Bt[n][k], At[m][k], acc[ai][bj][m][n], 0, 0, 0); __builtin_amdgcn_s_setprio(0); } while (0)
#define PG8_WAIT_V(n) asm volatile("s_waitcnt vmcnt(" #n ")" ::: "memory")
#define PG8_WAIT_L(n) asm volatile("s_waitcnt lgkmcnt(" #n ")" ::: "memory")
#define PG8_BAR __builtin_amdgcn_s_barrier()
#define PG8_SCHED __builtin_amdgcn_sched_barrier(0)
    Unit cur, nxt; int ui = 0;
    if (!S.next(0, cur)) return;
    f32x4 acc[2][2][4][2];
#pragma unroll
    for (int a = 0; a < 2; ++a)
#pragma unroll
        for (int b = 0; b < 2; ++b)
#pragma unroll
            for (int m = 0; m < 4; ++m)
#pragma unroll
                for (int n = 0; n < 2; ++n) acc[a][b][m][n] = (f32x4){0.f, 0.f, 0.f, 0.f};
    bf16x8 At[4][2], B0[2][2], B1[2][2];
    const char* cA = (const char*)g.A + (size_t)cur.pm * tstepA + (size_t)cur.ks * ksbA; const char* cB = (const char*)g.Bt + (size_t)cur.pn * tstep + (size_t)cur.ks * ksb;
    PG8_STAGE(PG8_SB(0, 0), cB, voffB); PG8_STAGE(PG8_SB(0, 1), cB + hstep, voffB); PG8_STAGE(PG8_SA(0, 0), cA, voffA); PG8_STAGE(PG8_SA(0, 1), cA + hstepA, voffA);
    if (wr == 1) PG8_BAR;
    PG8_WAIT_V(2); PG8_BAR;
    PG8_STAGE(PG8_SB(1, 0), cB + kstep, voffB); PG8_STAGE(PG8_SA(1, 0), cA + kstepA, voffA); PG8_STAGE(PG8_SB(1, 1), cB + hstep + kstep, voffB);
    PG8_WAIT_V(6); PG8_BAR;
    for (;;) {
        const bool has_next = S.next(ui + 1, nxt);
        const char* nA = has_next ? (const char*)g.A + (size_t)nxt.pm * tstepA + (size_t)nxt.ks * ksbA : cA; const char* nB = has_next ? (const char*)g.Bt + (size_t)nxt.pn * tstep + (size_t)nxt.ks * ksb : cB;
        for (int t = 0; t < nt; t += 2) {
            const bool last = (t == nt - 2);
            const char* a1 = cA + (size_t)(t + 1) * kstepA;
            const char* a2 = last ? nA : cA + (size_t)(t + 2) * kstepA; const char* b2 = last ? nB : cB + (size_t)(t + 2) * kstep;
            const char* a3 = a2 + kstepA; const char* b3 = b2 + kstep;
            PG8_LDB(B0, 0, 0); PG8_LDB(B1, 0, 1); PG8_SCHED; PG8_LDA(At, 0, 0); PG8_STAGE(PG8_SA(1, 1), a1 + hstepA, voffA);
            PG8_WAIT_V(8); PG8_WAIT_L(0); PG8_BAR; PG8_MMA(0, 0, At, B0); PG8_MMA(0, 1, At, B1); PG8_BAR; PG8_SCHED;
            PG8_LDA(At, 0, 1); PG8_STAGE(PG8_SB(0, 0), b2, voffB); PG8_STAGE(PG8_SB(0, 1), b2 + hstep, voffB); PG8_STAGE(PG8_SA(0, 0), a2, voffA);
            PG8_WAIT_V(8); PG8_WAIT_L(0); PG8_BAR; PG8_MMA(1, 0, At, B0); PG8_MMA(1, 1, At, B1); PG8_BAR; PG8_SCHED;
            PG8_LDB(B0, 1, 0); PG8_LDB(B1, 1, 1); PG8_SCHED; PG8_LDA(At, 1, 0); PG8_STAGE(PG8_SA(0, 1), a2 + hstepA, voffA);
            PG8_WAIT_V(8); PG8_WAIT_L(0); PG8_BAR; PG8_MMA(0, 0, At, B0); PG8_MMA(0, 1, At, B1); PG8_BAR; PG8_SCHED;
            PG8_LDA(At, 1, 1); PG8_STAGE(PG8_SB(1, 0), b3, voffB); PG8_STAGE(PG8_SB(1, 1), b3 + hstep, voffB); PG8_STAGE(PG8_SA(1, 0), a3, voffA);
            PG8_WAIT_V(8); PG8_WAIT_L(0); PG8_BAR; PG8_MMA(1, 0, At, B0); PG8_MMA(1, 1, At, B1); PG8_BAR; PG8_SCHED;
        }
        if (wr == 0) PG8_BAR;
        E(acc, cur, wr, wc, fr, fq);
        if (!has_next) break;
#pragma unroll
        for (int a = 0; a < 2; ++a)
#pragma unroll
            for (int b = 0; b < 2; ++b)
#pragma unroll
                for (int m = 0; m < 4; ++m)
#pragma unroll
                    for (int n = 0; n < 2; ++n) acc[a][b][m][n] = (f32x4){0.f, 0.f, 0.f, 0.f};
        cur = nxt; cA = nA; cB = nB; ++ui;
        if (wr == 1) PG8_BAR;
    }
    PG8_WAIT_V(0);
    PG8_BAR;
#undef PG8_SA
#undef PG8_SB
#undef PG8_STAGE
#undef PG8_LDA
#undef PG8_LDB
#undef PG8_MMA
#undef PG8_WAIT_V
#undef PG8_WAIT_L
#undef PG8_BAR
#undef PG8_SCHED
}
}

struct Args { const float* in[33]; float* out; unsigned char* ws; int ph_lo, ph_hi; };
enum { I_XP = 0, I_XS, I_CK, I_CV, I_C, I_CCTX, I_WADA, I_BADA, I_NORMW, I_HWIN, I_HBIN, I_HWSH, I_HBSH, I_FW1, I_FB1, I_FFREQ, I_FW2, I_FB2, I_FW3, I_DBIAS, I_HWOUT, I_HBOUT,
       I_AWQKV, I_AWOUT, I_LQ1, I_LK1, I_LQ2, I_LK2, I_SUBLN, I_FUP, I_FDW, I_FBDW, I_FDOWN };

DI int up_row(int n) { return n < DFF ? (n >> 7) * 256 + (n & 127) : ((n - DFF) >> 7) * 256 + 128 + ((n - DFF) & 127); }
DI void p0_transpose_item(const float* W, int K, int N, bf16_t* WT, LAS float* scr, int item, int lane, bool perm_up = false) {
    const int nblk = N / 32, kb = item / nblk, nb = item % nblk, k0 = 64 * kb, n0 = 32 * nb;
    float wv[32];
#pragma unroll
    for (int i = 0; i < 32; ++i) { const int kk = 2 * i + (lane >> 5); wv[i] = __builtin_nontemporal_load(&W[(size_t)(k0 + kk) * N + n0 + (lane & 31)]); }
#pragma unroll
    for (int i = 0; i < 32; ++i) { const int kk = 2 * i + (lane >> 5); scr[kk * 33 + (lane & 31)] = wv[i]; }
    asm volatile("s_waitcnt lgkmcnt(0)" ::: "memory");
    const int c = lane & 7;
#pragma unroll
    for (int j = 0; j < 4; ++j) { const int n = (lane >> 3) + 8 * j; const LAS float* s = scr + (8 * c) * 33 + n;
        u32x4 o; o.x = cvtpk(s[0 * 33], s[1 * 33]); o.y = cvtpk(s[2 * 33], s[3 * 33]); o.z = cvtpk(s[4 * 33], s[5 * 33]); o.w = cvtpk(s[6 * 33], s[7 * 33]);
        *(u32x4*)(WT + (size_t)(perm_up ? up_row(n0) + n : n0 + n) * K + k0 + 8 * c) = o; }
    asm volatile("s_waitcnt lgkmcnt(0)" ::: "memory");
}

typedef const __attribute__((address_space(4))) Args* ArgsP;
constexpr int I_MIX = 16 * 96, I_OUT = 16 * 32, I_UP = 16 * 176, I_DOWN = 44 * 32, I_LAYER = I_MIX + I_OUT + I_UP + I_DOWN;
DI void convert_layer_weights(ArgsP ap, int i0, int gwl, int NGWL, LAS float* scr, int lane, int lo, int hi) {
    for (int itv = lo + gwl; itv < hi; itv += NGWL) {
        const int i = itv < I_LAYER ? i0 : i0 + 1, jj = i >> 1;
        unsigned char* wl = ap->ws + WS_W + (size_t)i * W_LAYER;
        int r = itv < I_LAYER ? itv : itv - I_LAYER;
        if (r < I_MIX) { const float* W = (i & 1) ? ap->in[I_AWQKV] + (size_t)jj * 1024 * 3072 : ap->in[I_HWIN] + (size_t)jj * 1024 * 3072; p0_transpose_item(W, 1024, 3072, (bf16_t*)(wl + W_MIX), scr, r, lane); continue; } r -= I_MIX;
        if (r < I_OUT) { const float* W = (i & 1) ? ap->in[I_AWOUT] + (size_t)jj * 1024 * 1024 : ap->in[I_HWOUT] + (size_t)jj * 1024 * 1024; p0_transpose_item(W, 1024, 1024, (bf16_t*)(wl + W_OUT), scr, r, lane); continue; } r -= I_OUT;
        if (r < I_UP) { p0_transpose_item(ap->in[I_FUP] + (size_t)i * 1024 * 5632, 1024, 5632, (bf16_t*)(wl + W_UP), scr, r, lane, true); continue; } r -= I_UP;
        p0_transpose_item(ap->in[I_FDOWN] + (size_t)i * 2816 * 1024, 2816, 1024, (bf16_t*)(wl + W_DOWN), scr, r, lane);
    }
}

DI void phase0(ArgsP ap, LAS unsigned char* lds, int tid, int lane, int wave, int G) {
    unsigned char* ws = ap->ws;
    LAS float* sl = (LAS float*)lds;
    LAS float* red = sl + 3072;
    for (int idx = tid; idx < 3072; idx += 512) { const int cnd = idx >> 10, k = idx & 1023; const float v = cnd == 0 ? ap->in[I_CCTX][k] : ap->in[I_C][(cnd - 1) * 1024 + k]; sl[idx] = v / (1.f + __expf(-v)); }
    __syncthreads();
    float* mod = (float*)(ws + WS_MOD);
    for (int rep = 0; rep < REP_P0A; ++rep)
    for (int item = blockIdx.x; item < 384; item += G) {
        const int i = item / 96, n0 = (item % 96) * 64;
        const float* W = ap->in[I_WADA] + (size_t)i * 1024 * 6144 + n0 + lane;
        float a0 = 0.f, a1 = 0.f, a2 = 0.f; const int k0 = wave * 128;
#pragma unroll 16
        for (int kk = 0; kk < 128; ++kk) { const float w = W[(size_t)(k0 + kk) * 6144]; a0 += sl[k0 + kk] * w; a1 += sl[1024 + k0 + kk] * w; a2 += sl[2048 + k0 + kk] * w; }
        red[(wave * 3 + 0) * 64 + lane] = a0; red[(wave * 3 + 1) * 64 + lane] = a1; red[(wave * 3 + 2) * 64 + lane] = a2;
        __syncthreads();
        if (tid < 192) { const int cnd = tid >> 6, l = tid & 63; float s = 0.f;
#pragma unroll
            for (int w = 0; w < 8; ++w) s += red[(w * 3 + cnd) * 64 + l];
            mod[(i * 3 + cnd) * 6144 + n0 + l] = s + ap->in[I_BADA][i * 6144 + n0 + l]; }
        __syncthreads();
    }
    __syncthreads();
    { float* rc = (float*)(ws + WS_ROPE); float* rs = rc + 2048 * 32;
      for (int idx = blockIdx.x * 512 + tid; idx < 2048 * 32; idx += G * 512) { const int t = idx >> 5, e = idx & 31, ax = e >> 4, f = e & 15;
          const float pos = (float)(ax == 0 ? (t >> 6) : (t & 63)); const float inv = __builtin_amdgcn_exp2f(-(float)f * (13.287712379549449f / 16.f)); const float ang = pos * inv;
          rc[idx] = __cosf(ang); rs[idx] = __sinf(ang); } }
    const int gw = blockIdx.x * NWAVES + wave, NGW = G * NWAVES;
    constexpr int FW_L = 33 * 64 + 64 * 64 + 192;
    LAS float* fw = (LAS float*)lds;
    for (int jj = 0; jj < 2; ++jj) {
        LAS float* f = fw + jj * FW_L;
        { float v[5];
#pragma unroll
          for (int k = 0; k < 5; ++k) { const int r = tid + 512 * k; v[k] = r < 2112 ? ap->in[I_FW1][jj * 2112 + r] : 0.f; }
#pragma unroll
          for (int k = 0; k < 5; ++k) { const int r = tid + 512 * k; if (r < 2112) f[r] = v[k]; } }
        { float v[8];
#pragma unroll
          for (int k = 0; k < 8; ++k) v[k] = ap->in[I_FW2][jj * 4096 + tid + 512 * k];
#pragma unroll
          for (int k = 0; k < 8; ++k) f[2112 + tid + 512 * k] = v[k]; }
        if (tid < 64) { f[6208 + tid] = ap->in[I_FB1][jj * 64 + tid]; f[6272 + tid] = ap->in[I_FB2][jj * 64 + tid]; f[6336 + tid] = ap->in[I_FFREQ][jj * 64 + tid]; }
    }
    __syncthreads();
    LAS float* hs = (LAS float*)(lds + 51200 + wave * 2048);
    LAS float* w3s = (LAS float*)(lds + 67584);
    const int fgrp = blockIdx.x & 15, fsub = blockIdx.x >> 4, fnb = (G + 15 - fgrp) >> 4;
    const int j = fgrp >> 3, half = (fgrp >> 2) & 1, ch4 = fgrp & 3;
    { const float* src = ap->in[I_FW3] + (size_t)j * 64 * 2048 + half * 1024 + ch4 * 256 + (tid >> 3) * 2048 + (tid & 7) * 32;
      f32x4 t[8];
#pragma unroll
      for (int k = 0; k < 8; ++k) t[k] = *(const f32x4*)(src + 4 * k);
#pragma unroll
      for (int k = 0; k < 8; ++k) *(LAS f32x4*)(w3s + (tid >> 3) * 256 + (tid & 7) * 32 + 4 * k) = t[k]; }
    __syncthreads();
    for (int rep = 0; rep < REP_P0C; ++rep)
    for (int pbx = fsub + fnb * wave; pbx < 288; pbx += fnb * NWAVES) {
        int L, pb;
        if (pbx < 256) { L = 2048; pb = pbx; } else { L = 256; pb = pbx - 256; }
        const LAS float* w1 = fw + j * FW_L; const LAS float* w2 = w1 + 2112; const LAS float* b1 = w1 + 6208; const LAS float* b2 = w1 + 6272; const LAS float* fq = w1 + 6336;
        const int t0 = pb * 8 + half;
        float zv[8], h1[8], h2[8];
        const float fr = fq[lane];
        for (int repc = 0; repc < REP_FC; ++repc) {
#pragma unroll
        for (int p = 0; p < 8; ++p) { int t = t0 + p; if (t > L - 1) t = L - 1;
            const float tn = (float)t / (float)(L - 1); const float w = 6.283185307179586f * (float)t / (float)L;
            float z = 0.f;
            if (lane == 0) z = tn;
            else if (lane <= 16) { const float band = 1e-4f + (float)(lane - 1) * ((15.f - 1e-4f) / 15.f); z = __cosf(band * w); }
            else if (lane <= 32) { const float band = 1e-4f + (float)(lane - 17) * ((15.f - 1e-4f) / 15.f); z = -__sinf(band * w); }
            zv[p] = z; h1[p] = b1[lane]; h2[p] = b2[lane]; }
#pragma unroll 3
        for (int e = 0; e < 33; ++e) { const float w = w1[e * 64 + lane];
#pragma unroll
            for (int p = 0; p < 8; ++p) h1[p] += __builtin_bit_cast(float, __builtin_amdgcn_readlane(__builtin_bit_cast(int, zv[p]), e)) * w; }
#pragma unroll
        for (int p = 0; p < 8; ++p) h1[p] = __sinf(fr * h1[p]);
#pragma unroll 4
        for (int i = 0; i < 64; ++i) { const float w = w2[i * 64 + lane];
#pragma unroll
            for (int p = 0; p < 8; ++p) h2[p] += __builtin_bit_cast(float, __builtin_amdgcn_readlane(__builtin_bit_cast(int, h1[p]), i)) * w; }
#pragma unroll
        for (int p = 0; p < 8; ++p) hs[lane * 8 + p] = __sinf(fr * h2[p]);
        }
        asm volatile("s_waitcnt lgkmcnt(0)" ::: "memory");
        float acc[4][8];
#pragma unroll
        for (int q = 0; q < 4; ++q)
#pragma unroll
            for (int p = 0; p < 8; ++p) acc[q][p] = 0.f;
#pragma unroll 4
        for (int i = 0; i < 64; ++i) {
            const f32x4 ha = *(const LAS f32x4*)(hs + i * 8), hb = *(const LAS f32x4*)(hs + i * 8 + 4);
#pragma unroll
            for (int q = 0; q < 4; ++q) { const float w = w3s[i * 256 + q * 64 + lane];
                acc[q][0] += ha[0] * w; acc[q][1] += ha[1] * w; acc[q][2] += ha[2] * w; acc[q][3] += ha[3] * w;
                acc[q][4] += hb[0] * w; acc[q][5] += hb[1] * w; acc[q][6] += hb[2] * w; acc[q][7] += hb[3] * w; }
        }
        asm volatile("s_waitcnt lgkmcnt(0)" ::: "memory");
        bf16_t* Fg = (bf16_t*)(ws + WS_FILT + (size_t)j * FILT_LAYER + (L == 2048 ? MiB : 0));
        const float mind = -3.0701134573253945f, maxd = -15.350567286626973f;
        for (int reps = 0; reps < REP_FS; ++reps)
#pragma unroll
        for (int q = 0; q < 4; ++q) { const int ch = ch4 * 256 + q * 64 + lane;
            const float ad = -(mind + (maxd - mind) * ((float)ch / 1023.f));
            float v[8];
#pragma unroll
            for (int p = 0; p < 8; ++p) { const int t = t0 + p; const float tn = (float)t / (float)(L - 1);
                float x = acc[q][p] * __expf(-tn * ad); if (t > L - 1) x = 0.f; if (half == 0 && t == 0) x += ap->in[I_DBIAS][j * 1024 + ch]; v[p] = x; }
            u32x4 o;
            if (half == 0) { o.x = cvtpk(v[7], v[6]); o.y = cvtpk(v[5], v[4]); o.z = cvtpk(v[3], v[2]); o.w = cvtpk(v[1], v[0]);
                *(u32x4*)(Fg + (size_t)ch * (2 * L) + (L - 8 - pb * 8)) = o; }
            else { o.x = cvtpk(v[0], v[1]); o.y = cvtpk(v[2], v[3]); o.z = cvtpk(v[4], v[5]); o.w = cvtpk(v[6], v[7]);
                *(u32x4*)(Fg + (size_t)ch * (2 * L) + (L + pb * 8)) = o; }
        }
    }
    __syncthreads();
    for (int rep = 0; rep < REP_P0D; ++rep) convert_layer_weights(ap, 0, gw, NGW, (LAS float*)(lds + wave * 16384), lane, 0, I_MIX);
    __syncthreads();
}

DI void row_phase(int gw, int NGW, int lane, const float* __restrict__ xP, const float* __restrict__ xS, float* __restrict__ xout, const bf16_t* __restrict__ Y, const float* __restrict__ ybias,
                  const float* __restrict__ modgate, const float* __restrict__ w_post, const float* __restrict__ w_pre, const float* __restrict__ modshift, const float* __restrict__ modscale, bf16_t* __restrict__ hout) {
    for (int m = gw; m < TT; m += NGW) {
        const int cnd = m < TP ? 0 : 1 + ((m - TP) >> 11);
        const float* xr = m < TP ? xP + (size_t)m * D : xS + (size_t)(m - TP) * D;
        f32x4 x[4], ya[4], bb[4], g[4], wp[4], wn[4], sh[4], sc[4]; u32x2 pa[4], pb[4];
#pragma unroll
        for (int j = 0; j < 4; ++j) x[j] = ((const f32x4*)xr)[lane + 64 * j];
        if (Y) {
#pragma unroll
            for (int j = 0; j < 4; ++j) { pa[j] = ((const u32x2*)(Y + (size_t)m * D))[lane + 64 * j]; pb[j] = ((const u32x2*)(Y + (size_t)TT * D + (size_t)m * D))[lane + 64 * j];
                bb[j] = ((const f32x4*)ybias)[lane + 64 * j]; g[j] = ((const f32x4*)(modgate + cnd * 6144))[lane + 64 * j]; wp[j] = ((const f32x4*)w_post)[lane + 64 * j]; }
        }
        if (hout) {
#pragma unroll
            for (int j = 0; j < 4; ++j) { wn[j] = ((const f32x4*)w_pre)[lane + 64 * j]; sh[j] = ((const f32x4*)(modshift + cnd * 6144))[lane + 64 * j]; sc[j] = ((const f32x4*)(modscale + cnd * 6144))[lane + 64 * j]; }
        }
        if (Y) {
            float ss = 0.f;
#pragma unroll
            for (int j = 0; j < 4; ++j) { ya[j] = (f32x4){bflo(pa[j].x) + bflo(pb[j].x), bfhi(pa[j].x) + bfhi(pb[j].x), bflo(pa[j].y) + bflo(pb[j].y), bfhi(pa[j].y) + bfhi(pb[j].y)} + bb[j]; ss += (ya[j].x * ya[j].x + ya[j].y * ya[j].y) + (ya[j].z * ya[j].z + ya[j].w * ya[j].w); }
            ss = wave_sum(ss); const float rstd = 1.f / sqrtf(ss * (1.f / D) + EPS);
#pragma unroll
            for (int j = 0; j < 4; ++j) x[j] += g[j] * (ya[j] * rstd * wp[j]);
        }
        u32x2 o[4];
        if (hout) {
            float ss = 0.f;
#pragma unroll
            for (int j = 0; j < 4; ++j) ss += (x[j].x * x[j].x + x[j].y * x[j].y) + (x[j].z * x[j].z + x[j].w * x[j].w);
            ss = wave_sum(ss); const float rstd = 1.f / sqrtf(ss * (1.f / D) + EPS);
#pragma unroll
            for (int j = 0; j < 4; ++j) { const f32x4 h = (x[j] * rstd * wn[j]) * (sc[j] + 1.f) + sh[j]; o[j].x = cvtpk(h.x, h.y); o[j].y = cvtpk(h.z, h.w); }
        }
#pragma unroll
        for (int j = 0; j < 4; ++j) ((f32x4*)(xout + (size_t)m * D))[lane + 64 * j] = x[j];
        if (hout) {
#pragma unroll
            for (int j = 0; j < 4; ++j) ((u32x2*)(hout + (size_t)m * D))[lane + 64 * j] = o[j];
        }
    }
}

DI void ffn_elem_phase(int gtid, int NT, const bf16_t* __restrict__ z, const float* __restrict__ wdw, const float* __restrict__ bdw, bf16_t* __restrict__ aout) {
    for (int item = gtid; item < 2048 * 352; item += NT) {
        const int r = item / 352, cc = item - r * 352, row0 = 4 * r;
        const int L = row0 < TP ? 256 : 2048, tl0 = row0 & (L - 1);
        float wg[3][8], wv[3][8], bg[8], bv[8];
#pragma unroll
        for (int k = 0; k < 3; ++k)
#pragma unroll
            for (int h = 0; h < 2; ++h) { const f32x4 t0 = *(const f32x4*)(wdw + k * NUP + 8 * cc + 4 * h), t1 = *(const f32x4*)(wdw + k * NUP + DFF + 8 * cc + 4 * h);
#pragma unroll
                for (int e = 0; e < 4; ++e) { wg[k][4 * h + e] = t0[e]; wv[k][4 * h + e] = t1[e]; } }
#pragma unroll
        for (int h = 0; h < 2; ++h) { const f32x4 t0 = *(const f32x4*)(bdw + 8 * cc + 4 * h), t1 = *(const f32x4*)(bdw + DFF + 8 * cc + 4 * h);
#pragma unroll
            for (int e = 0; e < 4; ++e) { bg[4 * h + e] = t0[e]; bv[4 * h + e] = t1[e]; } }
        const bf16_t* zb = z + (size_t)row0 * NUP + 8 * cc;
        const u32x4 zero4 = {0u, 0u, 0u, 0u};
        u32x4 rg[6], rv[6];
        rg[0] = tl0 > 0 ? *(const u32x4*)(zb - NUP) : zero4; rv[0] = tl0 > 0 ? *(const u32x4*)(zb - NUP + DFF) : zero4;
#pragma unroll
        for (int k = 0; k < 4; ++k) { rg[1 + k] = *(const u32x4*)(zb + (size_t)k * NUP); rv[1 + k] = *(const u32x4*)(zb + (size_t)k * NUP + DFF); }
        { const bool has_next = (tl0 + 4) < L; rg[5] = has_next ? *(const u32x4*)(zb + (size_t)4 * NUP) : zero4; rv[5] = has_next ? *(const u32x4*)(zb + (size_t)4 * NUP + DFF) : zero4; }
        u32x4 wout[4];
#pragma unroll
        for (int k = 0; k < 4; ++k) {
            float pg[8], pv[8], cg_[8], cv[8], ng[8], nv[8], o[8];
            unpack8(rg[k], pg); unpack8(rv[k], pv); unpack8(rg[k + 1], cg_); unpack8(rv[k + 1], cv); unpack8(rg[k + 2], ng); unpack8(rv[k + 2], nv);
#pragma unroll
            for (int e = 0; e < 8; ++e) { const float g = wg[0][e] * pg[e] + wg[1][e] * cg_[e] + wg[2][e] * ng[e] + bg[e]; const float v = wv[0][e] * pv[e] + wv[1][e] * cv[e] + wv[2][e] * nv[e] + bv[e];
                o[e] = (g / (1.f + __expf(-g))) * v; }
            wout[k].x = cvtpk(o[0], o[1]); wout[k].y = cvtpk(o[2], o[3]); wout[k].z = cvtpk(o[4], o[5]); wout[k].w = cvtpk(o[6], o[7]);
        }
#pragma unroll
        for (int k = 0; k < 4; ++k) *(u32x4*)(aout + (size_t)(row0 + k) * DFF + 8 * cc) = wout[k];
    }
}

DI void ffn_edge_fix(int tid, int pm, int ks, const float* __restrict__ side, const float* __restrict__ wdw, bf16_t* __restrict__ aout) {
    const bool sample = pm >= 16; const int st = (pm - 16) & 7;
    float pg[11], pv[11], og[11], ov[11], wg[11], wv[11];
#pragma unroll
    for (int k = 0; k < 11; ++k) {
        const int idx = tid + 512 * k, e = idx / 1408, n = ks * 1408 + (idx - e * 1408);
        const float* mine = side + (size_t)((pm * 4 + e) * 2) * NUP;
        int pt = -1, tap = 0;
        if (e == 1) { pt = pm * 4 + 2; tap = 2; } else if (e == 2) { pt = pm * 4 + 1; tap = 0; }
        else if (e == 0) { if (sample && st != 0) { pt = (pm - 1) * 4 + 3; tap = 0; } }
        else { if (sample && st != 7) { pt = (pm + 1) * 4 + 0; tap = 2; } }
        const float* o = side + (size_t)((pt < 0 ? pm * 4 + e : pt) * 2) * NUP;
        const float msk = pt < 0 ? 0.f : 1.f;
        pg[k] = mine[NUP + n]; pv[k] = mine[NUP + DFF + n];
        og[k] = o[n] * msk; ov[k] = o[DFF + n] * msk;
        wg[k] = wdw[tap * NUP + n]; wv[k] = wdw[tap * NUP + DFF + n];
    }
#pragma unroll
    for (int k = 0; k < 11; ++k) {
        const int idx = tid + 512 * k, e = idx / 1408, n = ks * 1408 + (idx - e * 1408);
        const float g = pg[k] + wg[k] * og[k], v = pv[k] + wv[k] * ov[k];
        const float r = g * __builtin_amdgcn_rcpf(1.f + __expf(-g)) * v;
        const int tok = pm * 256 + (e == 0 ? 0 : (e == 1 ? 127 : (e == 2 ? 128 : 255)));
        aout[(size_t)tok * DFF + n] = (bf16_t)(cvtpk(r, 0.f) & 0xffffu);
    }
    asm volatile("s_waitcnt vmcnt(0)" ::: "memory");
    __syncthreads();
}

constexpr int CV_G = 0, CV_GCH = 5120, CV_F = 40960, CV_FCH = 8192;
DI void conv_phase(LAS unsigned char* lds, int tid, int lane, int wave, int G, const bf16_t* __restrict__ z, const float* __restrict__ wsh, const float* __restrict__ bsh, const unsigned char* __restrict__ filt, bf16_t* __restrict__ yh) {
    for (int u = blockIdx.x; u < 512; u += G) {
        const int grp = u < 256 ? 2 + (u >> 7) : ((u - 256) >> 7), c0 = (u & 127) * 8;
        const int row0 = grp * 2048, L = grp < 2 ? 256 : 2048, nb = L >> 5;
        for (int rep1 = 0; rep1 < REP_CV1; ++rep1) {
            float w1[3][8], wv[3][8], b1[8], bv[8];
#pragma unroll
            for (int k = 0; k < 3; ++k)
#pragma unroll
                for (int h = 0; h < 2; ++h) { const f32x4 t0 = *(const f32x4*)(wsh + k * NMIX + 1024 + c0 + 4 * h), t1 = *(const f32x4*)(wsh + k * NMIX + 2048 + c0 + 4 * h);
#pragma unroll
                    for (int e = 0; e < 4; ++e) { w1[k][4 * h + e] = t0[e]; wv[k][4 * h + e] = t1[e]; } }
#pragma unroll
            for (int h = 0; h < 2; ++h) { const f32x4 t0 = *(const f32x4*)(bsh + 1024 + c0 + 4 * h), t1 = *(const f32x4*)(bsh + 2048 + c0 + 4 * h);
#pragma unroll
                for (int e = 0; e < 4; ++e) { b1[4 * h + e] = t0[e]; bv[4 * h + e] = t1[e]; } }
            const u32x4 zero4 = {0u, 0u, 0u, 0u};
            for (int idx = tid; idx < 2048; idx += 512) {
                const int tl = idx & (L - 1);
                const bf16_t* z1 = z + ((size_t)(128 + (c0 >> 3)) * TT + row0 + idx) * 8; const bf16_t* zv = z + ((size_t)(256 + (c0 >> 3)) * TT + row0 + idx) * 8;
                const u32x4 p1 = tl > 0 ? *(const u32x4*)(z1 - 8) : zero4, pv_ = tl > 0 ? *(const u32x4*)(zv - 8) : zero4;
                const u32x4 q1 = *(const u32x4*)z1, qv = *(const u32x4*)zv;
                const u32x4 n1 = tl < L - 1 ? *(const u32x4*)(z1 + 8) : zero4, nv = tl < L - 1 ? *(const u32x4*)(zv + 8) : zero4;
                float a[8], b[8], c[8], d[8], e_[8], f[8];
                unpack8(p1, a); unpack8(q1, b); unpack8(n1, c); unpack8(pv_, d); unpack8(qv, e_); unpack8(nv, f);
                LAS bf16_t* gp = (LAS bf16_t*)(lds + CV_G + (idx >> 5) * 80 + (idx & 31) * 2);
#pragma unroll
                for (int e = 0; e < 8; ++e) { const float x1 = w1[0][e] * a[e] + w1[1][e] * b[e] + w1[2][e] * c[e] + b1[e]; const float v = wv[0][e] * d[e] + wv[1][e] * e_[e] + wv[2][e] * f[e] + bv[e];
                    gp[e * (CV_GCH / 2)] = (bf16_t)(cvtpk(v * x1, 0.f) & 0xffffu); }
            }
            const u32x4* fsrc = (const u32x4*)(filt + (L == 2048 ? MiB : 0) + (size_t)(c0 + wave) * (size_t)(4 * L));
            LAS u32x4* fdst = (LAS u32x4*)(lds + CV_F + wave * CV_FCH);
            if (L == 2048) { u32x4 fv[8];
#pragma unroll
                for (int i = 0; i < 8; ++i) fv[i] = fsrc[lane + 64 * i];
#pragma unroll
                for (int i = 0; i < 8; ++i) fdst[lane + 64 * i] = fv[i]; }
            else fdst[lane] = fsrc[lane];
        }
        __syncthreads();
        f32x16 acc0, acc1;
        for (int rep2 = 0; rep2 < REP_CV2; ++rep2) {
#pragma unroll
        for (int i = 0; i < 16; ++i) { acc0[i] = 0.f; acc1[i] = 0.f; }
            const int p = lane & 31, kg = lane >> 5;
            const LAS unsigned char* Fw = lds + CV_F + wave * CV_FCH;
            const LAS unsigned char* Gw = lds + CV_G + wave * CV_GCH;
            const int bi0 = p & (nb - 1), bi1 = (32 + p) & (nb - 1);
            const u32x4 zero4 = {0u, 0u, 0u, 0u};
#define CONV_STEP(T0, T1) do { \
                const int s0 = L - 1 - 32 * d - p + 8 * kg; \
                const LAS unsigned* fp = (const LAS unsigned*)Fw + (s0 >> 1); \
                const unsigned sh = (s0 & 1) * 16; \
                unsigned w0[5], w1_[5]; \
                _Pragma("unroll") for (int i = 0; i < 5; ++i) { w0[i] = fp[i]; w1_[i] = fp[8 + i]; } \
                int blk0 = p - d; blk0 = blk0 < 0 ? 0 : (blk0 > 63 ? 63 : blk0); \
                int blk1 = 32 + p - d; blk1 = blk1 < 0 ? 0 : (blk1 > 63 ? 63 : blk1); \
                const LAS unsigned char* bp0 = Gw + blk0 * 80 + kg * 16; const LAS unsigned char* bp1 = Gw + blk1 * 80 + kg * 16; \
                u32x4 B00 = zero4, B01 = zero4, B10 = zero4, B11 = zero4; \
                if (T0) { B00 = *(const LAS u32x4*)bp0; B01 = *(const LAS u32x4*)(bp0 + 32); } \
                if (T1) { B10 = *(const LAS u32x4*)bp1; B11 = *(const LAS u32x4*)(bp1 + 32); } \
                const bool valid0 = (unsigned)(bi0 - d) < (unsigned)nb, valid1 = (unsigned)(bi1 - d) < (unsigned)nb; \
                u32x4 A0, A1; \
                A0.x = __builtin_amdgcn_alignbit(w0[1], w0[0], sh); A0.y = __builtin_amdgcn_alignbit(w0[2], w0[1], sh); A0.z = __builtin_amdgcn_alignbit(w0[3], w0[2], sh); A0.w = __builtin_amdgcn_alignbit(w0[4], w0[3], sh); \
                A1.x = __builtin_amdgcn_alignbit(w1_[1], w1_[0], sh); A1.y = __builtin_amdgcn_alignbit(w1_[2], w1_[1], sh); A1.z = __builtin_amdgcn_alignbit(w1_[3], w1_[2], sh); A1.w = __builtin_amdgcn_alignbit(w1_[4], w1_[3], sh); \
                const bf16x8 a0 = __builtin_bit_cast(bf16x8, A0), a1 = __builtin_bit_cast(bf16x8, A1); \
                if (!valid0) { B00 = zero4; B01 = zero4; } \
                if (!valid1) { B10 = zero4; B11 = zero4; } \
                if (T0) acc0 = __builtin_amdgcn_mfma_f32_32x32x16_bf16(a0, __builtin_bit_cast(bf16x8, B00), acc0, 0, 0, 0); \
                if (T1) acc1 = __builtin_amdgcn_mfma_f32_32x32x16_bf16(a0, __builtin_bit_cast(bf16x8, B10), acc1, 0, 0, 0); \
                if (T0) acc0 = __builtin_amdgcn_mfma_f32_32x32x16_bf16(a1, __builtin_bit_cast(bf16x8, B01), acc0, 0, 0, 0); \
                if (T1) acc1 = __builtin_amdgcn_mfma_f32_32x32x16_bf16(a1, __builtin_bit_cast(bf16x8, B11), acc1, 0, 0, 0); \
            } while (0)
            if (nb == 8) {
#pragma unroll 1
                for (int d = -7; d <= 7; ++d) CONV_STEP(true, true);
            } else {
#pragma unroll 1
                for (int d = -63; d <= -32; ++d) CONV_STEP(true, false);
#pragma unroll 1
                for (int d = -31; d <= 31; ++d) CONV_STEP(true, true);
#pragma unroll 1
                for (int d = 32; d <= 63; ++d) CONV_STEP(false, true);
            }
#undef CONV_STEP
        }
        __syncthreads();
        {
            LAS float* ys = (LAS float*)(lds + CV_F) + wave * 2112;
            const int n = lane & 31, hh = lane >> 5;
#pragma unroll
            for (int r = 0; r < 16; ++r) { const int p = (r & 3) + 8 * (r >> 2) + 4 * hh; ys[n * 33 + p] = acc0[r]; ys[(32 + n) * 33 + p] = acc1[r]; }
        }
        __syncthreads();
        for (int rep4 = 0; rep4 < REP_CV4; ++rep4) {
            float w0[3][8], b0[8];
#pragma unroll
            for (int k = 0; k < 3; ++k)
#pragma unroll
                for (int h = 0; h < 2; ++h) { const f32x4 t0 = *(const f32x4*)(wsh + k * NMIX + c0 + 4 * h);
#pragma unroll
                    for (int e = 0; e < 4; ++e) w0[k][4 * h + e] = t0[e]; }
#pragma unroll
            for (int h = 0; h < 2; ++h) { const f32x4 t0 = *(const f32x4*)(bsh + c0 + 4 * h);
#pragma unroll
                for (int e = 0; e < 4; ++e) b0[4 * h + e] = t0[e]; }
            const u32x4 zero4 = {0u, 0u, 0u, 0u};
            const LAS float* ysb = (const LAS float*)(lds + CV_F);
            u32x4 pz[4], cz[4], nz[4];
#pragma unroll
            for (int it = 0; it < 4; ++it) { const int t = tid + 512 * it, tl = t & (L - 1);
                const bf16_t* zb = z + ((size_t)(c0 >> 3) * TT + row0 + t) * 8;
                pz[it] = tl > 0 ? *(const u32x4*)(zb - 8) : zero4; cz[it] = *(const u32x4*)zb; nz[it] = tl < L - 1 ? *(const u32x4*)(zb + 8) : zero4; }
#pragma unroll
            for (int it = 0; it < 4; ++it) { const int t = tid + 512 * it;
                float a[8], b[8], c[8], o[8];
                unpack8(pz[it], a); unpack8(cz[it], b); unpack8(nz[it], c);
#pragma unroll
                for (int e = 0; e < 8; ++e) { const float x0 = w0[0][e] * a[e] + w0[1][e] * b[e] + w0[2][e] * c[e] + b0[e]; o[e] = x0 * ysb[e * 2112 + (t >> 5) * 33 + (t & 31)]; }
                u32x4 w; w.x = cvtpk(o[0], o[1]); w.y = cvtpk(o[2], o[3]); w.z = cvtpk(o[4], o[5]); w.w = cvtpk(o[6], o[7]);
                *(u32x4*)(yh + ((size_t)(c0 >> 3) * TT + row0 + t) * 8) = w;
            }
        }
        __syncthreads();
    }
}

constexpr int AT_K = 0, AT_KROW = 272, AT_V = 64 * 272, AT_VROW = 288, AT_BUF = 64 * 272 + 64 * 288;
DI void attn_phase(LAS unsigned char* lds, int tid, int lane, int wave, int G, const bf16_t* __restrict__ z, const float* __restrict__ cache_k, const float* __restrict__ cache_v, const float* __restrict__ subln, float lam, float lam_init, bf16_t* __restrict__ yh) {
    const float C2 = 0.125f * 1.4426950408889634f;
    const int q16 = lane & 15, kg = lane >> 4;
    for (int u = blockIdx.x; u < 512; u += G) {
        int b, h, qrow0, krow0, ntile; bool sample = u < 256;
        if (sample) { b = u >> 7; h = (u >> 4) & 7; const int qb = u & 15; krow0 = TP + b * 2048; qrow0 = krow0 + qb * 128; ntile = 36; }
        else { const int v = u - 256; b = v >> 4; h = (v >> 1) & 7; const int qb = v & 1; krow0 = b * 256; qrow0 = krow0 + qb * 128; ntile = 4; }
        const float* ck = cache_k + (size_t)(b * 16 + h) * 256 * 128;
        const float* cvp = cache_v + (size_t)(b * 16 + h) * 256 * 128;
        bf16x8 q1[2], q2[2];
        { const bf16_t* qp = z + (size_t)(qrow0 + wave * 16 + q16) * NMIX + h * 128 + 8 * kg;
          q1[0] = *(const bf16x8*)qp; q1[1] = *(const bf16x8*)(qp + 32); q2[0] = *(const bf16x8*)(qp + 64); q2[1] = *(const bf16x8*)(qp + 96); }
        f32x4 O1[8], O2[8];
#pragma unroll
        for (int i = 0; i < 8; ++i) { O1[i] = (f32x4){0.f, 0.f, 0.f, 0.f}; O2[i] = (f32x4){0.f, 0.f, 0.f, 0.f}; }
        float m1 = -1e30f, m2 = -1e30f, l1 = 0.f, l2 = 0.f;
        u32x4 kv[2], vv[2];
#define AT_LOAD(KT) do { _Pragma("unroll") for (int i = 0; i < 2; ++i) { const int id = tid + 512 * i, r = id & 63, c8 = id >> 6; \
            if (sample && (KT) < 4) { \
                const float* kp = ck + (size_t)((KT) * 64 + r) * 128 + c8 * 8; const float* vp = cvp + (size_t)((KT) * 64 + r) * 128 + c8 * 8; \
                const f32x4 k0 = *(const f32x4*)kp, k1 = *(const f32x4*)(kp + 4), v0 = *(const f32x4*)vp, v1 = *(const f32x4*)(vp + 4); \
                kv[i].x = cvtpk(k0[0], k0[1]); kv[i].y = cvtpk(k0[2], k0[3]); kv[i].z = cvtpk(k1[0], k1[1]); kv[i].w = cvtpk(k1[2], k1[3]); \
                vv[i].x = cvtpk(v0[0], v0[1]); vv[i].y = cvtpk(v0[2], v0[3]); vv[i].z = cvtpk(v1[0], v1[1]); vv[i].w = cvtpk(v1[2], v1[3]); \
            } else { \
                const int kr = krow0 + (sample ? (KT) - 4 : (KT)) * 64 + r; \
                const bf16_t* kp = z + (size_t)kr * NMIX + 1024 + h * 128 + c8 * 8; \
                kv[i] = *(const u32x4*)kp; vv[i] = *(const u32x4*)(kp + 1024); \
            } } } while (0)
#define AT_STORE(BUF) do { _Pragma("unroll") for (int i = 0; i < 2; ++i) { const int id = tid + 512 * i, r = id & 63, c8 = id >> 6; \
            *(LAS u32x4*)(lds + (BUF) * AT_BUF + AT_K + r * AT_KROW + c8 * 16) = kv[i]; \
            *(LAS u32x4*)(lds + (BUF) * AT_BUF + AT_V + r * AT_VROW + c8 * 16) = vv[i]; } } while (0)
        __syncthreads();
        AT_LOAD(0); AT_STORE(0);
        if (ntile > 1) AT_LOAD(1);
        __syncthreads();
        for (int kt = 0; kt < ntile; ++kt) {
            if (kt + 1 < ntile) AT_STORE((kt + 1) & 1);
            if (kt + 2 < ntile) AT_LOAD(kt + 2);
            const LAS unsigned char* kbase = lds + (kt & 1) * AT_BUF;
            f32x4 s1[4], s2[4];
#pragma unroll
            for (int hf = 0; hf < 2; ++hf) {
                bf16x8 kf[2][4];
#pragma unroll
                for (int k2 = 0; k2 < 2; ++k2) {
                    const LAS unsigned char* kp = kbase + AT_K + (32 * hf + 8 * (q16 >> 2) + 4 * k2 + (q16 & 3)) * AT_KROW + kg * 16;
                    kf[k2][0] = *(const LAS bf16x8*)kp; kf[k2][1] = *(const LAS bf16x8*)(kp + 64); kf[k2][2] = *(const LAS bf16x8*)(kp + 128); kf[k2][3] = *(const LAS bf16x8*)(kp + 192);
                }
#pragma unroll
                for (int k2 = 0; k2 < 2; ++k2) {
                    f32x4 t = {0.f, 0.f, 0.f, 0.f}, t2 = {0.f, 0.f, 0.f, 0.f};
                    t = __builtin_amdgcn_mfma_f32_16x16x32_bf16(kf[k2][0], q1[0], t, 0, 0, 0); t2 = __builtin_amdgcn_mfma_f32_16x16x32_bf16(kf[k2][2], q2[0], t2, 0, 0, 0);
                    t = __builtin_amdgcn_mfma_f32_16x16x32_bf16(kf[k2][1], q1[1], t, 0, 0, 0); t2 = __builtin_amdgcn_mfma_f32_16x16x32_bf16(kf[k2][3], q2[1], t2, 0, 0, 0);
                    s1[2 * hf + k2] = t; s2[2 * hf + k2] = t2;
                }
            }
            float mx1 = -1e30f, mx2 = -1e30f;
#pragma unroll
            for (int ks = 0; ks < 4; ++ks)
#pragma unroll
                for (int j = 0; j < 4; ++j) { mx1 = fmaxf(mx1, s1[ks][j]); mx2 = fmaxf(mx2, s2[ks][j]); }
            { const float a = __shfl_xor(mx1, 16), b = __shfl_xor(mx2, 16); mx1 = fmaxf(mx1, a); mx2 = fmaxf(mx2, b); }
            { const float a = __shfl_xor(mx1, 32), b = __shfl_xor(mx2, 32); mx1 = fmaxf(mx1, a); mx2 = fmaxf(mx2, b); }
            const float mn1 = fmaxf(m1, mx1 * C2), mn2 = fmaxf(m2, mx2 * C2);
            const float al1 = __builtin_amdgcn_exp2f(m1 - mn1), al2 = __builtin_amdgcn_exp2f(m2 - mn2);
            m1 = mn1; m2 = mn2;
            float ps1 = 0.f, ps2 = 0.f;
#pragma unroll
            for (int ks = 0; ks < 4; ++ks)
#pragma unroll
                for (int j = 0; j < 4; ++j) { const float p1 = __builtin_amdgcn_exp2f(s1[ks][j] * C2 - mn1), p2 = __builtin_amdgcn_exp2f(s2[ks][j] * C2 - mn2); s1[ks][j] = p1; s2[ks][j] = p2; ps1 += p1; ps2 += p2; }
            l1 = l1 * al1 + ps1; l2 = l2 * al2 + ps2;
#pragma unroll
            for (int i = 0; i < 8; ++i) { O1[i] *= al1; O2[i] *= al2; }
#pragma unroll
            for (int s = 0; s < 2; ++s) {
                u32x4 pa, pb;
                pa.x = cvtpk(s1[2 * s][0], s1[2 * s][1]); pa.y = cvtpk(s1[2 * s][2], s1[2 * s][3]); pa.z = cvtpk(s1[2 * s + 1][0], s1[2 * s + 1][1]); pa.w = cvtpk(s1[2 * s + 1][2], s1[2 * s + 1][3]);
                pb.x = cvtpk(s2[2 * s][0], s2[2 * s][1]); pb.y = cvtpk(s2[2 * s][2], s2[2 * s][3]); pb.z = cvtpk(s2[2 * s + 1][0], s2[2 * s + 1][1]); pb.w = cvtpk(s2[2 * s + 1][2], s2[2 * s + 1][3]);
                const bf16x8 P1 = __builtin_bit_cast(bf16x8, pa), P2 = __builtin_bit_cast(bf16x8, pb);
                bf16x8 vf[8];
#pragma unroll
                for (int dt = 0; dt < 8; ++dt) {
                    const LAS unsigned char* vp = kbase + AT_V + (32 * s + 8 * kg + (q16 >> 2)) * AT_VROW + 32 * dt + 8 * (q16 & 3);
                    const s16x4 va = __builtin_bit_cast(s16x4, __builtin_amdgcn_ds_read_tr16_b64_v4i16((LAS s16x4*)vp));
                    const s16x4 vb = __builtin_bit_cast(s16x4, __builtin_amdgcn_ds_read_tr16_b64_v4i16((LAS s16x4*)(vp + 4 * AT_VROW)));
                    const bf16x8 vq = {va[0], va[1], va[2], va[3], vb[0], vb[1], vb[2], vb[3]};
                    vf[dt] = vq;
                }
#pragma unroll
                for (int dt = 0; dt < 8; ++dt) {
                    O1[dt] = __builtin_amdgcn_mfma_f32_16x16x32_bf16(vf[dt], P1, O1[dt], 0, 0, 0);
                    O2[dt] = __builtin_amdgcn_mfma_f32_16x16x32_bf16(vf[dt], P2, O2[dt], 0, 0, 0);
                }
            }
            __syncthreads();
        }
        l1 += __shfl_xor(l1, 16); l1 += __shfl_xor(l1, 32); l2 += __shfl_xor(l2, 16); l2 += __shfl_xor(l2, 32);
        const float r1 = 1.f / l1, r2 = lam / l2;
        float ss = 0.f;
#pragma unroll
        for (int i = 0; i < 8; ++i) { O1[i] = O1[i] * r1 - O2[i] * r2; ss += (O1[i][0] * O1[i][0] + O1[i][1] * O1[i][1]) + (O1[i][2] * O1[i][2] + O1[i][3] * O1[i][3]); }
        ss += __shfl_xor(ss, 16); ss += __shfl_xor(ss, 32);
        const float rstd = (1.f - lam_init) / sqrtf(ss * (1.f / 128.f) + EPS);
        bf16_t* op = yh + (size_t)(qrow0 + wave * 16 + q16) * D + h * 128 + 4 * kg;
#pragma unroll
        for (int i = 0; i < 8; ++i) { const f32x4 w = *(const f32x4*)(subln + 16 * i + 4 * kg); const f32x4 o = O1[i] * rstd * w;
            u32x2 pk; pk.x = cvtpk(o[0], o[1]); pk.y = cvtpk(o[2], o[3]); *(u32x2*)(op + 16 * i) = pk; }
    }
    __syncthreads();
}


#define XB_TMO      128
#define XB_XCNT(j)  (256  + 64 * (j))
#define XB_XSUB(j)  (1280 + 64 * (j))
#define XB_XGEN(j)  (2304 + 64 * (j))
#define XB_TOP      3328
#define XB_TOPGEN   3392
#define XCD_BAR_WORDS 3456
#define XB_SPIN_CAP (1u << 22)
DI unsigned xb_ld(unsigned* p)              { return __hip_atomic_load(p, __ATOMIC_RELAXED, __HIP_MEMORY_SCOPE_AGENT); }
DI unsigned xb_add(unsigned* p, unsigned v) { return __hip_atomic_fetch_add(p, v, __ATOMIC_RELAXED, __HIP_MEMORY_SCOPE_AGENT); }
DI unsigned xb_xcc_id() { return (unsigned)__builtin_amdgcn_s_getreg((3 << 11) | 20) & 0xFu; }
#define XB_SPIN(cond, bar) do { unsigned _sp = 0; while (cond) { __builtin_amdgcn_s_sleep(1); \
    if ((++_sp & 255u) == 0u) { if (xb_ld(&(bar)[XB_TMO])) break; if (_sp > XB_SPIN_CAP) { atomicAdd(&(bar)[XB_TMO], 1u); break; } } } } while (0)
DI void xcd_barrier_complete(unsigned* bar, unsigned x, unsigned& nloc, unsigned& nx) {
    const unsigned G = gridDim.x * gridDim.y * gridDim.z;
    unsigned sum, cnt, mine, sp = 0u;
    for (;;) {
        sum = 0u; cnt = 0u; mine = 0u;
#pragma unroll
        for (unsigned j = 0; j < 16; ++j) { const unsigned c = xb_ld(&bar[XB_XCNT(j)]); sum += c; cnt += (c > 0u) ? 1u : 0u; mine = (j == x) ? c : mine; }
        if (sum == G) break;
        __builtin_amdgcn_s_sleep(1);
        if ((++sp & 255u) == 0u) { if (xb_ld(&bar[XB_TMO])) break; if (sp > XB_SPIN_CAP) { atomicAdd(&bar[XB_TMO], 1u); break; } }
    }
    nloc = mine > 0u ? mine : 1u; nx = cnt > 0u ? cnt : 1u;
}
DI void xcd_barrier(unsigned* bar, volatile LAS unsigned* st) {
    asm volatile("s_waitcnt vmcnt(0)" ::: "memory");
    __syncthreads();
    if (threadIdx.x == 0) {
        const unsigned x = xb_xcc_id();
        __builtin_amdgcn_s_waitcnt(0);
        unsigned nloc = st[0], nx = st[1];
        if (nloc == 0u) { xcd_barrier_complete(bar, x, nloc, nx); st[0] = nloc; st[1] = nx; }
        const unsigned old = xb_add(&bar[XB_XSUB(x)], 1u);
        const unsigned gen = old / nloc;
        if (old + 1u == (gen + 1u) * nloc) {
            __builtin_amdgcn_fence(__ATOMIC_RELEASE, "agent");
            asm volatile("s_waitcnt vmcnt(0)" ::: "memory");
            const unsigned og = xb_add(&bar[XB_TOP], 1u);
            const unsigned tg = og / nx;
            if (og + 1u == (tg + 1u) * nx) xb_add(&bar[XB_TOPGEN], 1u);
            else XB_SPIN(xb_ld(&bar[XB_TOPGEN]) == tg, bar);
            __builtin_amdgcn_fence(__ATOMIC_ACQUIRE, "agent");
            asm volatile("s_waitcnt vmcnt(0)" ::: "memory");
        } else {
            XB_SPIN(xb_ld(&bar[XB_TOPGEN]) == gen, bar);
            __builtin_amdgcn_fence(__ATOMIC_ACQUIRE, "agent");
            asm volatile("s_waitcnt vmcnt(0)" ::: "memory");
        }
    }
    __syncthreads();
}

constexpr int N_PHASES = 30;
__global__ void __launch_bounds__(NWAVES * 64, 2) fwd_megakernel(Args a_byval) {
    extern __shared__ __attribute__((aligned(16))) unsigned char lds_raw[];
    LAS unsigned char* lds = (LAS unsigned char*)lds_raw;
    const int ph_lo = a_byval.ph_lo, ph_hi = a_byval.ph_hi;
    if (threadIdx.x < 64) ((LAS unsigned*)(lds + LDS_MISC))[threadIdx.x] = 0u;
    __syncthreads();
    if (threadIdx.x == 0) (void)xb_add((unsigned*)(a_byval.ws + WS_CTL) + XB_XCNT(xb_xcc_id()), 1u);
    for (int ph = ph_lo; ph < ph_hi; ++ph) {
        ArgsP ap = (ArgsP)__builtin_amdgcn_kernarg_segment_ptr(); asm volatile("" : "+s"(ap));
        int tid = threadIdx.x; asm volatile("" : "+v"(tid));
        unsigned char* ws = ap->ws;
        float* xout = ap->out;
        const int lane = tid & 63, wave = __builtin_amdgcn_readfirstlane(tid >> 6), G = gridDim.x;
        const int gw = blockIdx.x * NWAVES + wave, NGW = G * NWAVES;
        float* newk = xout + (size_t)TT * D; float* newv = newk + (size_t)16 * 2 * 8 * 256 * 128;
        const float* mod = (const float*)(ws + WS_MOD);
        bf16_t* zb = (bf16_t*)(ws + WS_Z); bf16_t* Y = (bf16_t*)(ws + WS_Z + 48 * MiB); float* sideb = (float*)(ws + WS_Z + 80 * MiB);
        bf16_t* hb = (bf16_t*)(ws + WS_A); bf16_t* yhb = (bf16_t*)(ws + WS_A + 16 * MiB); bf16_t* ab = (bf16_t*)(ws + WS_Z);
        const float* normw = ap->in[I_NORMW];
        if (ph == 0) {
            for (int rep = 0; rep < REP_P0; ++rep) phase0(ap, lds, tid, lane, wave, G);
        } else if (ph == N_PHASES - 1) {
            if (KON(0)) row_phase(gw, NGW, lane, xout, xout + (size_t)TP * D, xout, Y, (const float*)(ws + WS_ZERO), mod + 3 * 3 * 6144 + 5 * 1024, normw + (3 * 4 + 3) * D, nullptr, nullptr, nullptr, nullptr);
        } else {
            const int i = (ph - 1) / 7, k7 = (ph - 1) - 7 * i, kind = k7 < 6 ? k7 : 7, j = i >> 1; const bool attn = (i & 1);
            const float* modl = mod + i * 3 * 6144;
            unsigned char* wl = ws + WS_W + (size_t)i * W_LAYER;
            if (kind & 1) {
                if (KON(1)) {
                pg8::Gemm g; pg8::Order S; pg8::EpiU E;
                E.z = pg8::EpiZ{zb, NMIX, nullptr, 0}; E.q = pg8::EpiQKV{zb, (const float*)(ws + WS_ROPE), (const float*)(ws + WS_ROPE) + 2048 * 32, newk + (size_t)j * 8 * 256 * 128, newv + (size_t)j * 8 * 256 * 128};
                E.f = pg8::EpiF32{Y, D, (size_t)TT * D}; E.n = pg8::EpiFFN{ab, ap->in[I_FDW] + (size_t)i * 3 * NUP, ap->in[I_FBDW] + (size_t)i * NUP, sideb};
                if (kind == 1) { g = pg8::Gemm{hb, (const bf16_t*)(wl + W_MIX), TT, NMIX, D, 1, 0}; E.mode = attn ? 1 : 0; E.z.bias = ap->in[I_HBIN] + j * NMIX; E.z.slab = 1; }
                else if (kind == 3) { g = pg8::Gemm{yhb, (const bf16_t*)(wl + W_OUT), TT, D, D, 2, attn ? 0 : 1}; E.mode = 2; }
                else if (kind == 5) { g = pg8::Gemm{hb, (const bf16_t*)(wl + W_UP), TT, NUP, D, 1, 2}; E.mode = 3; }
                else { g = pg8::Gemm{ab, (const bf16_t*)(wl + W_DOWN), TT, D, DFF, 2, 0}; E.mode = 2; }
                S.init(g.M, g.N, g.KS, G, (int)blockIdx.x);
                if (kind == 7) { pg8::Unit u0; for (int ui = 0; S.next(ui, u0); ++ui) ffn_edge_fix(tid, u0.pm, u0.ks, sideb, ap->in[I_FDW] + (size_t)i * 3 * NUP, ab); }
                for (int rep = 0; rep < REP_GEMM; ++rep) pg8::gemm_phase(lds, tid, g, S, E);
                if (kind == 1 && (int)blockIdx.x >= 128 && G == 256)
                    convert_layer_weights(ap, i, ((int)blockIdx.x - 128) * NWAVES + wave, 128 * NWAVES, (LAS float*)(lds + wave * 16384), lane, I_MIX, i < 3 ? I_LAYER + I_MIX : I_LAYER);
                else if (kind == 1 && G != 256) convert_layer_weights(ap, i, gw, NGW, (LAS float*)(lds + wave * 16384), lane, I_MIX, i < 3 ? I_LAYER + I_MIX : I_LAYER);
                }
            } else if (kind == 0 && KON(0)) {
                if (i == 0) row_phase(gw, NGW, lane, ap->in[I_XP], ap->in[I_XS], xout, nullptr, nullptr, nullptr, nullptr, normw + (i * 4 + 0) * D, modl, modl + 1024, hb);
                else row_phase(gw, NGW, lane, xout, xout + (size_t)TP * D, xout, Y, (const float*)(ws + WS_ZERO), modl - 3 * 6144 + 5 * 1024, normw + ((i - 1) * 4 + 3) * D, normw + (i * 4 + 0) * D, modl, modl + 1024, hb);
            } else if (kind == 2) {
                if (!attn) { for (int rep = 0; rep < REP_CONV; ++rep) conv_phase(lds, tid, lane, wave, G, zb, ap->in[I_HWSH] + j * 3 * NMIX, ap->in[I_HBSH] + j * NMIX, ws + WS_FILT + (size_t)j * FILT_LAYER, yhb); }
                else if (KON(9)) {
                    float d1 = 0.f, d2 = 0.f;
                    for (int e = 0; e < 64; ++e) { d1 += ap->in[I_LQ1][j * 64 + e] * ap->in[I_LK1][j * 64 + e]; d2 += ap->in[I_LQ2][j * 64 + e] * ap->in[I_LK2][j * 64 + e]; }
                    const float lam_init = 0.8f - 0.6f * __expf(-0.3f * (float)i);
                    const float lam = __expf(d1) - __expf(d2) + lam_init;
                    for (int rep = 0; rep < REP_ATTN; ++rep) attn_phase(lds, tid, lane, wave, G, zb, ap->in[I_CK] + (size_t)j * 8 * 256 * 128, ap->in[I_CV] + (size_t)j * 8 * 256 * 128, ap->in[I_SUBLN] + j * 128, lam, lam_init, yhb);
                }
            } else if (kind == 4 && KON(0)) {
                row_phase(gw, NGW, lane, xout, xout + (size_t)TP * D, xout, Y, attn ? (const float*)(ws + WS_ZERO) : ap->in[I_HBOUT] + j * D, modl + 2 * 1024, normw + (i * 4 + 1) * D, normw + (i * 4 + 2) * D, modl + 3 * 1024, modl + 4 * 1024, hb);
            } else if (kind == 6 && KON(6)) {
                for (int rep = 0; rep < REP_ELEM; ++rep) ffn_elem_phase(blockIdx.x * 512 + tid, G * 512, zb, ap->in[I_FDW] + (size_t)i * 3 * NUP, ap->in[I_FBDW] + (size_t)i * NUP, ab);
            }
        }
        if (ph + 1 < ph_hi) {
            if (ph_hi > 4096) cg::this_grid().sync();
            for (int rep = 0; rep < REP_SYNC; ++rep) xcd_barrier((unsigned*)(ws + WS_CTL), (volatile LAS unsigned*)(lds + LDS_MISC + 32));
        }
    }
}

extern "C" void kernel_launch(void* const* d_in, const int* in_sizes, int n_in, void* d_out, int out_size, void* d_ws, size_t ws_size, hipStream_t stream) {
    static int grid = 0;
    if (grid == 0) {
        if (n_in != 33 || ws_size < WS_END) { fprintf(stderr, "kernel_launch: unexpected inputs (n_in %d, ws %zu)\n", n_in, ws_size); grid = -1; return; }
        int dev = 0, cus = 0, per_cu = 0;
        hipGetDevice(&dev); hipDeviceGetAttribute(&cus, hipDeviceAttributeMultiprocessorCount, dev);
        if (hipFuncSetAttribute((const void*)fwd_megakernel, hipFuncAttributeMaxDynamicSharedMemorySize, LDS_BYTES) != hipSuccess) { fprintf(stderr, "kernel_launch: hipFuncSetAttribute failed\n"); grid = -1; return; }
        if (hipOccupancyMaxActiveBlocksPerMultiprocessor(&per_cu, (const void*)fwd_megakernel, NWAVES * 64, LDS_BYTES) != hipSuccess || per_cu < 1) { fprintf(stderr, "kernel_launch: occupancy query says %d\n", per_cu); per_cu = 1; }
        (void)hipGetLastError();
        grid = cus * 1;
    }
    if (grid < 0) return;
    if (hipMemsetAsync((char*)d_ws + WS_CTL, 0, CTL_BYTES, stream) != hipSuccess) { fprintf(stderr, "kernel_launch: memset failed\n"); return; }
    Args a{};
    for (int i = 0; i < 33; ++i) a.in[i] = (const float*)d_in[i];
    a.out = (float*)d_out; a.ws = (unsigned char*)d_ws;
#if MK_ONE_LAUNCH
    a.ph_lo = 0; a.ph_hi = N_PHASES;
    void* args[] = {&a};
    hipError_t e = hipLaunchCooperativeKernel((const void*)fwd_megakernel, dim3(grid), dim3(NWAVES * 64), args, LDS_BYTES, stream);
    if (e != hipSuccess) fprintf(stderr, "cooperative launch failed: %s (grid %d)\n", hipGetErrorString(e), grid);
#else
    for (int ph = 0; ph < N_PHASES; ++ph) {
        a.ph_lo = ph; a.ph_hi = ph + 1;
        void* args[] = {&a};
        hipError_t e = hipLaunchCooperativeKernel((const void*)fwd_megakernel, dim3(grid), dim3(NWAVES * 64), args, LDS_BYTES, stream);
        if (e != hipSuccess) { fprintf(stderr, "launch %d failed: %s (grid %d)\n", ph, hipGetErrorString(e), grid); break; }
    }
#endif
}
```

```cpp
#include <hip/hip_runtime.h>
#include <hip/hip_cooperative_groups.h>
#include <cstdio>
#include <cstdint>
namespace cg = cooperative_groups;

#ifndef KMASK
#define KMASK 0xFFFF
#endif
#define KON(n) ((KMASK >> (n)) & 1)
#ifndef REP_P0A
#define REP_P0A 1
#endif
#ifndef REP_P0C
#define REP_P0C 1
#endif
#ifndef REP_P0D
#define REP_P0D 1
#endif
#ifndef REP_CV1
#define REP_CV1 1
#endif
#ifndef REP_CV2
#define REP_CV2 1
#endif
#ifndef REP_CV4
#define REP_CV4 1
#endif
#ifndef REP_FC
#define REP_FC 1
#endif
#ifndef REP_FS
#define REP_FS 1
#endif
#ifndef REP_GEMM
#define REP_GEMM 1
#endif
#ifndef REP_CONV
#define REP_CONV 1
#endif
#ifndef REP_ATTN
#define REP_ATTN 1
#endif
#ifndef REP_ELEM
#define REP_ELEM 1
#endif
#ifndef REP_P0
#define REP_P0 1
#endif
#ifndef REP_SYNC
#define REP_SYNC 1
#endif
#ifndef MK_ONE_LAUNCH
#define MK_ONE_LAUNCH 1
#endif

#define LAS __attribute__((address_space(3)))
typedef unsigned short bf16_t;
typedef short bf16x8 __attribute__((ext_vector_type(8)));
typedef short s16x4 __attribute__((ext_vector_type(4)));
typedef float f32x4 __attribute__((ext_vector_type(4)));
typedef float f32x16 __attribute__((ext_vector_type(16)));
typedef unsigned u32x4 __attribute__((ext_vector_type(4)));
typedef unsigned u32x2 __attribute__((ext_vector_type(2)));
typedef float f32x2_t __attribute__((ext_vector_type(2)));
typedef __bf16 bf16x2_t __attribute__((ext_vector_type(2)));

#define DI __device__ __forceinline__
DI unsigned cvtpk(float lo, float hi) { f32x2_t v = {lo, hi}; bf16x2_t b = __builtin_convertvector(v, bf16x2_t); return __builtin_bit_cast(unsigned, b); }
DI float bflo(unsigned u) { return __builtin_bit_cast(float, u << 16); }
DI float bfhi(unsigned u) { return __builtin_bit_cast(float, u & 0xffff0000u); }
DI void unpack8(u32x4 v, float* f) { f[0] = bflo(v.x); f[1] = bfhi(v.x); f[2] = bflo(v.y); f[3] = bfhi(v.y); f[4] = bflo(v.z); f[5] = bfhi(v.z); f[6] = bflo(v.w); f[7] = bfhi(v.w); }
DI float wave_sum(float v) {
#pragma unroll
    for (int o = 1; o < 64; o <<= 1) v += __shfl_xor(v, o);
    return v;
}

constexpr int D = 1024, TT = 8192, TP = 4096, DFF = 2816, NUP = 5632, NMIX = 3072;
constexpr float EPS = 1e-6f;
constexpr int NWAVES = 8;
constexpr int LDS_BYTES = 139264, LDS_MISC = 135168;

constexpr size_t MiB = 1u << 20;
constexpr size_t WS_MOD = 0;
constexpr size_t WS_CTL = 512 * 1024, CTL_BYTES = 32768, WS_ZERO = WS_CTL + 16384;
constexpr size_t WS_ROPE = 1 * MiB;
constexpr size_t WS_W = 2 * MiB;
constexpr size_t W_MIX = 0, W_OUT = 6291456, W_UP = W_OUT + 2097152, W_DOWN = W_UP + 11534336, W_LAYER = W_DOWN + 5767168;
static_assert(W_LAYER == 25690112, "layer weight bytes");
constexpr size_t WS_FILT = 100 * MiB;
constexpr size_t FILT_LAYER = 9 * MiB;
constexpr size_t WS_Z = 118 * MiB;
constexpr size_t WS_A = 206 * MiB;
constexpr size_t WS_END = 254 * MiB;
static_assert(WS_W + 4 * W_LAYER <= WS_FILT, "ws map");

namespace pg8 {
constexpr int BM = 256, BK = 64, HALF = 128, HTB = HALF * BK * 2, STAGE_BYTES = 8 * HTB, NXCD = 8, WGM = 4;
DI int lds_byte(int r, int c) { const int st = (r >> 4) * 2 + (c >> 5), rr = r & 15, cc = c & 31, ob = rr * 64 + cc * 2; return st * 1024 + (ob ^ (((ob >> 9) & 1) << 5)); }
DI void stage_rc(int b, int& R, int& C) { const int st = b / 1024, sb = b % 1024, swz = sb ^ (((sb >> 9) & 1) << 5); R = (st >> 1) * 16 + swz / 64; C = (st & 1) * 32 + (swz % 64) / 2; }
DI int perm32(int rho) { const int n = rho >> 4, i = rho & 15; return 8 * (i >> 2) + 4 * n + (i & 3); }

struct Unit { int pm, pn, ks; };
struct Gemm { const bf16_t* A; const bf16_t* Bt; int M, N, K, KS, aslab; };

struct Order {
    int nM, nN, nwg, G, c, KS;
    DI void init(int M, int N, int KS_, int G_, int c_) { nM = M / BM; nN = N / BM; nwg = nM * nN; G = G_; c = c_; KS = KS_; }
    DI bool next(int i, Unit& u) const {
        const int L = i * G + c; if (L >= nwg * KS) return false;
        u.ks = L / nwg;
        int wgid = L % nwg; { const int q = nwg / NXCD, r = nwg % NXCD, xcd = wgid % NXCD, off = wgid / NXCD; wgid = (xcd < r ? xcd * (q + 1) : r * (q + 1) + (xcd - r) * q) + off; }
        const int nig = WGM * nN, gid = wgid / nig, fm = gid * WGM, gsz = (nM - fm) < WGM ? (nM - fm) : WGM;
        u.pm = fm + ((wgid % nig) % gsz); u.pn = (wgid % nig) / gsz; return true;
    }
};

struct EpiZ {
    bf16_t* O; int ldc; const float* bias; int slab;
    DI void operator()(const f32x4 (&acc)[2][2][4][2], const Unit& u, int wr, int wc, int fr, int fq) const {
        const int row0 = u.pm * BM + wr * 64 + fr, col0 = u.pn * BM + wc * 32 + 8 * fq;
        f32x4 bv[2][2];
#pragma unroll
        for (int bj = 0; bj < 2; ++bj)
#pragma unroll
            for (int n = 0; n < 2; ++n) bv[bj][n] = bias ? *(const f32x4*)(bias + col0 + bj * HALF + 4 * n) : (f32x4){0.f, 0.f, 0.f, 0.f};
#pragma unroll
        for (int ai = 0; ai < 2; ++ai)
#pragma unroll
            for (int m = 0; m < 4; ++m) { const int row = row0 + ai * HALF + m * 16;
                bf16_t* rowp = slab ? O + ((size_t)(col0 >> 3) * TT + row) * 8 : O + (size_t)row * ldc + col0;
                const size_t bjs = slab ? (size_t)16 * TT * 8 : (size_t)HALF;
#pragma unroll
                for (int bj = 0; bj < 2; ++bj) { const f32x4 v0 = acc[ai][bj][m][0] + bv[bj][0], v1 = acc[ai][bj][m][1] + bv[bj][1];
                    u32x4 w; w.x = cvtpk(v0[0], v0[1]); w.y = cvtpk(v0[2], v0[3]); w.z = cvtpk(v1[0], v1[1]); w.w = cvtpk(v1[2], v1[3]);
                    *(u32x4*)(rowp + bj * bjs) = w; } }
    }
};

struct EpiQKV {
    bf16_t* O; const float* ropec; const float* ropes; float* newk; float* newv;
    DI void operator()(const f32x4 (&acc)[2][2][4][2], const Unit& u, int wr, int wc, int fr, int fq) const {
        const int row0 = u.pm * BM + wr * 64 + fr, col0 = u.pn * BM + wc * 32 + 8 * fq;
        const bool sample = u.pm >= 16; const int sec = u.pn >> 2;
        const bool rope = sample && sec < 2;
        const float sgn = (fq & 2) ? 1.f : -1.f;
        const int axis = (col0 >> 5) & 1, f0 = col0 & 15;
#pragma unroll
        for (int ai = 0; ai < 2; ++ai) {
#pragma unroll
          for (int mh = 0; mh < 2; ++mh) {
            f32x4 c0[2], c1[2], s0[2], s1[2];
            if (rope) {
#pragma unroll
                for (int m2 = 0; m2 < 2; ++m2) { const int tpos = (row0 + ai * HALF + (2 * mh + m2) * 16 - TP) & 2047;
                    const float* cp = ropec + tpos * 32 + axis * 16 + f0; const float* sp = ropes + tpos * 32 + axis * 16 + f0;
                    c0[m2] = *(const f32x4*)cp; c1[m2] = *(const f32x4*)(cp + 4); s0[m2] = *(const f32x4*)sp; s1[m2] = *(const f32x4*)(sp + 4); }
            }
#pragma unroll
            for (int m2 = 0; m2 < 2; ++m2) { const int m = 2 * mh + m2; const int row = row0 + ai * HALF + m * 16;
#pragma unroll
                for (int bj = 0; bj < 2; ++bj) { const int col = col0 + bj * HALF;
                    f32x4 v0 = acc[ai][bj][m][0], v1 = acc[ai][bj][m][1];
                    if (rope) {
                        f32x4 p0, p1;
#pragma unroll
                        for (int e = 0; e < 4; ++e) { p0[e] = __shfl_xor(v0[e], 32); p1[e] = __shfl_xor(v1[e], 32); }
                        v0 = v0 * c0[m2] + (p0 * s0[m2]) * sgn; v1 = v1 * c1[m2] + (p1 * s1[m2]) * sgn;
                    }
                    u32x4 w; w.x = cvtpk(v0[0], v0[1]); w.y = cvtpk(v0[2], v0[3]); w.z = cvtpk(v1[0], v1[1]); w.w = cvtpk(v1[2], v1[3]);
                    *(u32x4*)(O + (size_t)row * NMIX + col) = w;
                    if (!sample && sec >= 1) {
                        const int cc = col - sec * 1024, h = cc >> 7, d = cc & 127, b = row >> 8, t = row & 255;
                        float* dst = (sec == 1 ? newk : newv) + ((size_t)((b * 2) * 8 + h) * 256 + t) * 128 + d;
                        *(f32x4*)dst = v0; *(f32x4*)(dst + 4) = v1;
                    }
                } }
          }
        }
    }
};

struct EpiF32 {
    bf16_t* Y; int ldc; size_t kstride;
    DI void operator()(const f32x4 (&acc)[2][2][4][2], const Unit& u, int wr, int wc, int fr, int fq) const {
        const int row0 = u.pm * BM + wr * 64 + fr, col0 = u.pn * BM + wc * 32 + 8 * fq;
        bf16_t* base = Y + (size_t)u.ks * kstride;
#pragma unroll
        for (int ai = 0; ai < 2; ++ai)
#pragma unroll
            for (int m = 0; m < 4; ++m) { bf16_t* rowp = base + (size_t)(row0 + ai * HALF + m * 16) * ldc + col0;
#pragma unroll
                for (int bj = 0; bj < 2; ++bj) { const f32x4 v0 = acc[ai][bj][m][0], v1 = acc[ai][bj][m][1];
                    u32x4 w; w.x = cvtpk(v0[0], v0[1]); w.y = cvtpk(v0[2], v0[3]); w.z = cvtpk(v1[0], v1[1]); w.w = cvtpk(v1[2], v1[3]);
                    *(u32x4*)(rowp + bj * HALF) = w; } }
    }
};

DI f32x4 bperm4(int addr, const f32x4 v) {
    const float v0 = v[0], v1 = v[1], v2 = v[2], v3 = v[3];
    const int a = __builtin_amdgcn_ds_bpermute(addr, __float_as_int(v0)), b = __builtin_amdgcn_ds_bpermute(addr, __float_as_int(v1));
    const int c = __builtin_amdgcn_ds_bpermute(addr, __float_as_int(v2)), d = __builtin_amdgcn_ds_bpermute(addr, __float_as_int(v3));
    return (f32x4){__int_as_float(a), __int_as_float(b), __int_as_float(c), __int_as_float(d)};
}
struct EpiFFN {
    bf16_t* Aout; const float* wdw; const float* bdw; float* side;
    DI void operator()(const f32x4 (&acc)[2][2][4][2], const Unit& u, int wr, int wc, int fr, int fq) const {
        const int colg = u.pn * 128 + wc * 32 + 8 * fq;
        const int tok0 = u.pm * BM + 8 * (16 * wr + fr);
        const bool efirst = (fr == 0), elast = (fr == 15);
        float* sb = side + (size_t)((u.pm * 4 + wr * 2 + (elast ? 1 : 0)) * 2) * NUP;
        bf16_t* ap_ = Aout + (size_t)tok0 * DFF + colg;
#pragma unroll
        for (int n = 0; n < 2; ++n) {
            const int cg = colg + 4 * n, cv = DFF + colg + 4 * n;
            const f32x4 wg0 = *(const f32x4*)(wdw + cg), wg1 = *(const f32x4*)(wdw + NUP + cg), wg2 = *(const f32x4*)(wdw + 2 * NUP + cg), bg = *(const f32x4*)(bdw + cg);
            const f32x4 wv0 = *(const f32x4*)(wdw + cv), wv1 = *(const f32x4*)(wdw + NUP + cv), wv2 = *(const f32x4*)(wdw + 2 * NUP + cv), bv = *(const f32x4*)(bdw + cv);
            const int lane_ = fq * 16 + fr, pl = ((lane_ - 1) & 63) * 4, nl = ((lane_ + 1) & 63) * 4;
            const float mf = efirst ? 0.f : 1.f, ml = elast ? 0.f : 1.f;
            const f32x4 pg = bperm4(pl, acc[1][0][3][n]) * mf, pv = bperm4(pl, acc[1][1][3][n]) * mf;
#pragma unroll
            for (int q = 0; q < 8; ++q) {
                const f32x4 zgp = q == 0 ? pg : acc[(q - 1) >> 2][0][(q - 1) & 3][n], zgc = acc[q >> 2][0][q & 3][n], zgn = q == 7 ? bperm4(nl, acc[0][0][0][n]) * ml : acc[((q + 1) & 7) >> 2][0][(q + 1) & 3][n];
                const f32x4 zvp = q == 0 ? pv : acc[(q - 1) >> 2][1][(q - 1) & 3][n], zvc = acc[q >> 2][1][q & 3][n], zvn = q == 7 ? bperm4(nl, acc[0][1][0][n]) * ml : acc[((q + 1) & 7) >> 2][1][(q + 1) & 3][n];
                const f32x4 g = wg0 * zgp + wg1 * zgc + wg2 * zgn + bg;
                const f32x4 v = wv0 * zvp + wv1 * zvc + wv2 * zvn + bv;
                const bool edge = (q == 0 && efirst) || (q == 7 && elast);
                if ((q == 0 || q == 7) && edge) {
                    *(f32x4*)(sb + cg) = zgc; *(f32x4*)(sb + cv) = zvc; *(f32x4*)(sb + NUP + cg) = g; *(f32x4*)(sb + NUP + cv) = v;
                } else {
                    float r[4];
#pragma unroll
                    for (int e = 0; e < 4; ++e) r[e] = g[e] * __builtin_amdgcn_rcpf(1.f + __expf(-g[e])) * v[e];
                    u32x2 w; w.x = cvtpk(r[0], r[1]); w.y = cvtpk(r[2], r[3]);
                    *(u32x2*)(ap_ + (size_t)q * DFF + 4 * n) = w;
                }
            }
        }
    }
};

struct EpiU {
    int mode; EpiZ z; EpiQKV q; EpiF32 f; EpiFFN n;
    DI void operator()(const f32x4 (&acc)[2][2][4][2], const Unit& u, int wr, int wc, int fr, int fq) const {
        if (mode == 0) z(acc, u, wr, wc, fr, fq); else if (mode == 1) q(acc, u, wr, wc, fr, fq); else if (mode == 2) f(acc, u, wr, wc, fr, fq); else n(acc, u, wr, wc, fr, fq);
    }
};

template <class Epi>
DI void gemm_phase(LAS unsigned char* lds, const int tid, const Gemm g, const Order& S, const Epi& E) {
    const int wid = __builtin_amdgcn_readfirstlane(tid >> 6), lane = tid & 63, wr = wid >> 2, wc = wid & 3, fr = lane & 15, fq = lane >> 4;
    const int K = g.K, Ksub = K / g.KS, nt = Ksub / BK;
    unsigned voffA[2], voffB[2];
#pragma unroll
    for (int i = 0; i < 2; ++i) { int R, C; stage_rc(tid * 16 + i * 8192, R, C); const int Rb = (R & ~31) + perm32(R & 31);
        const int tau = 8 * ((R >> 6) * 16 + (R & 15)) + ((R >> 4) & 3);
        voffA[i] = g.aslab == 1 ? (unsigned)((C >> 3) * g.M + R) * 16u : (g.aslab == 2 ? (unsigned)(tau * K + C) * 2u : (unsigned)(R * K + C) * 2u); voffB[i] = (unsigned)(Rb * K + C) * 2u; }
    const size_t kstep = (size_t)(BK * 2);
    const size_t hstep = (size_t)HALF * K * 2;
    const size_t tstep = 2 * hstep;
    const size_t ksb = (size_t)Ksub * 2;
    const size_t kstepA = g.aslab == 1 ? (size_t)8 * g.M * 16 : kstep, hstepA = g.aslab == 1 ? (size_t)HALF * 16 : (g.aslab == 2 ? (size_t)4 * K * 2 : hstep), tstepA = g.aslab == 1 ? (size_t)BM * 16 : tstep, ksbA = g.aslab == 1 ? (size_t)(Ksub / 8) * g.M * 16 : ksb;
    const unsigned ldsw = (unsigned)wid * 1024u;
    const int aoff = lds_byte(wr * 64 + fr, fq * 8), boff = lds_byte(wc * 32 + fr, fq * 8);
#define PG8_SA(b, h) (((b) * 2 + (h)) * HTB)
#define PG8_SB(b, h) ((4 + (b) * 2 + (h)) * HTB)
#define PG8_STAGE(bufoff, gbase, voff) do { _Pragma("unroll") for (int _i = 0; _i < 2; ++_i) \
        __builtin_amdgcn_global_load_lds((const unsigned*)((const char*)(gbase) + (voff)[_i]), (LAS unsigned*)(lds + (bufoff) + ldsw + _i * 8192), 16, 0, 0); } while (0)
#define PG8_LDA(dst, b, h) do { _Pragma("unroll") for (int m = 0; m < 4; ++m) _Pragma("unroll") for (int k = 0; k < 2; ++k) dst[m][k] = *(const LAS bf16x8*)(lds + PG8_SA(b, h) + aoff + m * 2048 + k * 1024); } while (0)
#define PG8_LDB(dst, b, h) do { _Pragma("unroll") for (int n = 0; n < 2; ++n) _Pragma("unroll") for (int k = 0; k < 2; ++k) dst[n][k] = *(const LAS bf16x8*)(lds + PG8_SB(b, h) + boff + n * 2048 + k * 1024); } while (0)
#define PG8_MMA(ai, bj, At, Bt) do { __builtin_amdgcn_s_setprio(1); _Pragma("unroll") for (int m = 0; m < 4; ++m) _Pragma("unroll") for (int n = 0; n < 2; ++n) _Pragma("unroll") for (int k = 0; k < 2; ++k) \
        acc[ai][bj][m][n] = __builtin_amdgcn_mfma_f32_16x16x32_bf16(Bt[n][k], At[m][k], acc[ai][bj][m][n], 0, 0, 0); __builtin_amdgcn_s_setprio(0); } while (0)
#define PG8_WAIT_V(n) asm volatile("s_waitcnt vmcnt(" #n ")" ::: "memory")
#define PG8_WAIT_L(n) asm volatile("s_waitcnt lgkmcnt(" #n ")" ::: "memory")
#define PG8_BAR __builtin_amdgcn_s_barrier()
#define PG8_SCHED __builtin_amdgcn_sched_barrier(0)
    Unit cur, nxt; int ui = 0;
    if (!S.next(0, cur)) return;
    f32x4 acc[2][2][4][2];
#pragma unroll
    for (int a = 0; a < 2; ++a)
#pragma unroll
        for (int b = 0; b < 2; ++b)
#pragma unroll
            for (int m = 0; m < 4; ++m)
#pragma unroll
                for (int n = 0; n < 2; ++n) acc[a][b][m][n] = (f32x4){0.f, 0.f, 0.f, 0.f};
    bf16x8 At[4][2], B0[2][2], B1[2][2];
    const char* cA = (const char*)g.A + (size_t)cur.pm * tstepA + (size_t)cur.ks * ksbA; const char* cB = (const char*)g.Bt + (size_t)cur.pn * tstep + (size_t)cur.ks * ksb;
    PG8_STAGE(PG8_SB(0, 0), cB, voffB); PG8_STAGE(PG8_SB(0, 1), cB + hstep, voffB); PG8_STAGE(PG8_SA(0, 0), cA, voffA); PG8_STAGE(PG8_SA(0, 1), cA + hstepA, voffA);
    if (wr == 1) PG8_BAR;
    PG8_WAIT_V(2); PG8_BAR;
    PG8_STAGE(PG8_SB(1, 0), cB + kstep, voffB); PG8_STAGE(PG8_SA(1, 0), cA + kstepA, voffA); PG8_STAGE(PG8_SB(1, 1), cB + hstep + kstep, voffB);
    PG8_WAIT_V(6); PG8_BAR;
    for (;;) {
        const bool has_next = S.next(ui + 1, nxt);
        const char* nA = has_next ? (const char*)g.A + (size_t)nxt.pm * tstepA + (size_t)nxt.ks * ksbA : cA; const char* nB = has_next ? (const char*)g.Bt + (size_t)nxt.pn * tstep + (size_t)nxt.ks * ksb : cB;
        for (int t = 0; t < nt; t += 2) {
            const bool last = (t == nt - 2);
            const char* a1 = cA + (size_t)(t + 1) * kstepA;
            const char* a2 = last ? nA : cA + (size_t)(t + 2) * kstepA; const char* b2 = last ? nB : cB + (size_t)(t + 2) * kstep;
            const char* a3 = a2 + kstepA; const char* b3 = b2 + kstep;
            PG8_LDB(B0, 0, 0); PG8_LDB(B1, 0, 1); PG8_SCHED; PG8_LDA(At, 0, 0); PG8_STAGE(PG8_SA(1, 1), a1 + hstepA, voffA);
            PG8_WAIT_V(8); PG8_WAIT_L(0); PG8_BAR; PG8_MMA(0, 0, At, B0); PG8_MMA(0, 1, At, B1); PG8_BAR; PG8_SCHED;
            PG8_LDA(At, 0, 1); PG8_STAGE(PG8_SB(0, 0), b2, voffB); PG8_STAGE(PG8_SB(0, 1), b2 + hstep, voffB); PG8_STAGE(PG8_SA(0, 0), a2, voffA);
            PG8_WAIT_V(8); PG8_WAIT_L(0); PG8_BAR; PG8_MMA(1, 0, At, B0); PG8_MMA(1, 1, At, B1); PG8_BAR; PG8_SCHED;
            PG8_LDB(B0, 1, 0); PG8_LDB(B1, 1, 1); PG8_SCHED; PG8_LDA(At, 1, 0); PG8_STAGE(PG8_SA(0, 1), a2 + hstepA, voffA);
            PG8_WAIT_V(8); PG8_WAIT_L(0); PG8_BAR; PG8_MMA(0, 0, At, B0); PG8_MMA(0, 1, At, B1); PG8_BAR; PG8_SCHED;
            PG8_LDA(At, 1, 1); PG8_STAGE(PG8_SB(1, 0), b3, voffB); PG8_STAGE(PG8_SB(1, 1), b3 + hstep, voffB); PG8_STAGE(PG8_SA(1, 0), a3, voffA);
            PG8_WAIT_V(8); PG8_WAIT_L(0); PG8_BAR; PG8_MMA(1, 0, At, B0); PG8_MMA(1, 1, At, B1); PG8_BAR; PG8_SCHED;
        }
        if (wr == 0) PG8_BAR;
        E(acc, cur, wr, wc, fr, fq);
        if (!has_next) break;
#pragma unroll
        for (int a = 0; a < 2; ++a)
#pragma unroll
            for (int b = 0; b < 2; ++b)
#pragma unroll
                for (int m = 0; m < 4; ++m)
#pragma unroll
                    for (int n = 0; n < 2; ++n) acc[a][b][m][n] = (f32x4){0.f, 0.f, 0.f, 0.f};
        cur = nxt; cA = nA; cB = nB; ++ui;
        if (wr == 1) PG8_BAR;
    }
    PG8_WAIT_V(0);
    PG8_BAR;
#undef PG8_SA
#undef PG8_SB
#undef PG8_STAGE
#undef PG8_LDA
#undef PG8_LDB
#undef PG8_MMA
#undef PG8_WAIT_V
#undef PG8_WAIT_L
#undef PG8_BAR
#undef PG8_SCHED
}
}

struct Args { const float* in[33]; float* out; unsigned char* ws; int ph_lo, ph_hi; };
enum { I_XP = 0, I_XS, I_CK, I_CV, I_C, I_CCTX, I_WADA, I_BADA, I_NORMW, I_HWIN, I_HBIN, I_HWSH, I_HBSH, I_FW1, I_FB1, I_FFREQ, I_FW2, I_FB2, I_FW3, I_DBIAS, I_HWOUT, I_HBOUT,
       I_AWQKV, I_AWOUT, I_LQ1, I_LK1, I_LQ2, I_LK2, I_SUBLN, I_FUP, I_FDW, I_FBDW, I_FDOWN };

DI int up_row(int n) { return n < DFF ? (n >> 7) * 256 + (n & 127) : ((n - DFF) >> 7) * 256 + 128 + ((n - DFF) & 127); }
DI void p0_transpose_item(const float* W, int K, int N, bf16_t* WT, LAS float* scr, int item, int lane, bool perm_up = false) {
    const int nblk = N / 32, kb = item / nblk, nb = item % nblk, k0 = 64 * kb, n0 = 32 * nb;
    float wv[32];
#pragma unroll
    for (int i = 0; i < 32; ++i) { const int kk = 2 * i + (lane >> 5); wv[i] = __builtin_nontemporal_load(&W[(size_t)(k0 + kk) * N + n0 + (lane & 31)]); }
#pragma unroll
    for (int i = 0; i < 32; ++i) { const int kk = 2 * i + (lane >> 5); scr[kk * 33 + (lane & 31)] = wv[i]; }
    asm volatile("s_waitcnt lgkmcnt(0)" ::: "memory");
    const int c = lane & 7;
#pragma unroll
    for (int j = 0; j < 4; ++j) { const int n = (lane >> 3) + 8 * j; const LAS float* s = scr + (8 * c) * 33 + n;
        u32x4 o; o.x = cvtpk(s[0 * 33], s[1 * 33]); o.y = cvtpk(s[2 * 33], s[3 * 33]); o.z = cvtpk(s[4 * 33], s[5 * 33]); o.w = cvtpk(s[6 * 33], s[7 * 33]);
        *(u32x4*)(WT + (size_t)(perm_up ? up_row(n0) + n : n0 + n) * K + k0 + 8 * c) = o; }
    asm volatile("s_waitcnt lgkmcnt(0)" ::: "memory");
}

typedef const __attribute__((address_space(4))) Args* ArgsP;
constexpr int I_MIX = 16 * 96, I_OUT = 16 * 32, I_UP = 16 * 176, I_DOWN = 44 * 32, I_LAYER = I_MIX + I_OUT + I_UP + I_DOWN;
DI void convert_layer_weights(ArgsP ap, int i0, int gwl, int NGWL, LAS float* scr, int lane, int lo, int hi) {
    for (int itv = lo + gwl; itv < hi; itv += NGWL) {
        const int i = itv < I_LAYER ? i0 : i0 + 1, jj = i >> 1;
        unsigned char* wl = ap->ws + WS_W + (size_t)i * W_LAYER;
        int r = itv < I_LAYER ? itv : itv - I_LAYER;
        if (r < I_MIX) { const float* W = (i & 1) ? ap->in[I_AWQKV] + (size_t)jj * 1024 * 3072 : ap->in[I_HWIN] + (size_t)jj * 1024 * 3072; p0_transpose_item(W, 1024, 3072, (bf16_t*)(wl + W_MIX), scr, r, lane); continue; } r -= I_MIX;
        if (r < I_OUT) { const float* W = (i & 1) ? ap->in[I_AWOUT] + (size_t)jj * 1024 * 1024 : ap->in[I_HWOUT] + (size_t)jj * 1024 * 1024; p0_transpose_item(W, 1024, 1024, (bf16_t*)(wl + W_OUT), scr, r, lane); continue; } r -= I_OUT;
        if (r < I_UP) { p0_transpose_item(ap->in[I_FUP] + (size_t)i * 1024 * 5632, 1024, 5632, (bf16_t*)(wl + W_UP), scr, r, lane, true); continue; } r -= I_UP;
        p0_transpose_item(ap->in[I_FDOWN] + (size_t)i * 2816 * 1024, 2816, 1024, (bf16_t*)(wl + W_DOWN), scr, r, lane);
    }
}

DI void phase0(ArgsP ap, LAS unsigned char* lds, int tid, int lane, int wave, int G) {
    unsigned char* ws = ap->ws;
    LAS float* sl = (LAS float*)lds;
    LAS float* red = sl + 3072;
    for (int idx = tid; idx < 3072; idx += 512) { const int cnd = idx >> 10, k = idx & 1023; const float v = cnd == 0 ? ap->in[I_CCTX][k] : ap->in[I_C][(cnd - 1) * 1024 + k]; sl[idx] = v / (1.f + __expf(-v)); }
    __syncthreads();
    float* mod = (float*)(ws + WS_MOD);
    for (int rep = 0; rep < REP_P0A; ++rep)
    for (int item = blockIdx.x; item < 384; item += G) {
        const int i = item / 96, n0 = (item % 96) * 64;
        const float* W = ap->in[I_WADA] + (size_t)i * 1024 * 6144 + n0 + lane;
        float a0 = 0.f, a1 = 0.f, a2 = 0.f; const int k0 = wave * 128;
#pragma unroll 16
        for (int kk = 0; kk < 128; ++kk) { const float w = W[(size_t)(k0 + kk) * 6144]; a0 += sl[k0 + kk] * w; a1 += sl[1024 + k0 + kk] * w; a2 += sl[2048 + k0 + kk] * w; }
        red[(wave * 3 + 0) * 64 + lane] = a0; red[(wave * 3 + 1) * 64 + lane] = a1; red[(wave * 3 + 2) * 64 + lane] = a2;
        __syncthreads();
        if (tid < 192) { const int cnd = tid >> 6, l = tid & 63; float s = 0.f;
#pragma unroll
            for (int w = 0; w < 8; ++w) s += red[(w * 3 + cnd) * 64 + l];
            mod[(i * 3 + cnd) * 6144 + n0 + l] = s + ap->in[I_BADA][i * 6144 + n0 + l]; }
        __syncthreads();
    }
    __syncthreads();
    { float* rc = (float*)(ws + WS_ROPE); float* rs = rc + 2048 * 32;
      for (int idx = blockIdx.x * 512 + tid; idx < 2048 * 32; idx += G * 512) { const int t = idx >> 5, e = idx & 31, ax = e >> 4, f = e & 15;
          const float pos = (float)(ax == 0 ? (t >> 6) : (t & 63)); const float inv = __builtin_amdgcn_exp2f(-(float)f * (13.287712379549449f / 16.f)); const float ang = pos * inv;
          rc[idx] = __cosf(ang); rs[idx] = __sinf(ang); } }
    const int gw = blockIdx.x * NWAVES + wave, NGW = G * NWAVES;
    constexpr int FW_L = 33 * 64 + 64 * 64 + 192;
    LAS float* fw = (LAS float*)lds;
    for (int jj = 0; jj < 2; ++jj) {
        LAS float* f = fw + jj * FW_L;
        { float v[5];
#pragma unroll
          for (int k = 0; k < 5; ++k) { const int r = tid + 512 * k; v[k] = r < 2112 ? ap->in[I_FW1][jj * 2112 + r] : 0.f; }
#pragma unroll
          for (int k = 0; k < 5; ++k) { const int r = tid + 512 * k; if (r < 2112) f[r] = v[k]; } }
        { float v[8];
#pragma unroll
          for (int k = 0; k < 8; ++k) v[k] = ap->in[I_FW2][jj * 4096 + tid + 512 * k];
#pragma unroll
          for (int k = 0; k < 8; ++k) f[2112 + tid + 512 * k] = v[k]; }
        if (tid < 64) { f[6208 + tid] = ap->in[I_FB1][jj * 64 + tid]; f[6272 + tid] = ap->in[I_FB2][jj * 64 + tid]; f[6336 + tid] = ap->in[I_FFREQ][jj * 64 + tid]; }
    }
    __syncthreads();
    LAS float* hs = (LAS float*)(lds + 51200 + wave * 2048);
    LAS float* w3s = (LAS float*)(lds + 67584);
    const int fgrp = blockIdx.x & 15, fsub = blockIdx.x >> 4, fnb = (G + 15 - fgrp) >> 4;
    const int j = fgrp >> 3, half = (fgrp >> 2) & 1, ch4 = fgrp & 3;
    { const float* src = ap->in[I_FW3] + (size_t)j * 64 * 2048 + half * 1024 + ch4 * 256 + (tid >> 3) * 2048 + (tid & 7) * 32;
      f32x4 t[8];
#pragma unroll
      for (int k = 0; k < 8; ++k) t[k] = *(const f32x4*)(src + 4 * k);
#pragma unroll
      for (int k = 0; k < 8; ++k) *(LAS f32x4*)(w3s + (tid >> 3) * 256 + (tid & 7) * 32 + 4 * k) = t[k]; }
    __syncthreads();
    for (int rep = 0; rep < REP_P0C; ++rep)
    for (int pbx = fsub + fnb * wave; pbx < 288; pbx += fnb * NWAVES) {
        int L, pb;
        if (pbx < 256) { L = 2048; pb = pbx; } else { L = 256; pb = pbx - 256; }
        const LAS float* w1 = fw + j * FW_L; const LAS float* w2 = w1 + 2112; const LAS float* b1 = w1 + 6208; const LAS float* b2 = w1 + 6272; const LAS float* fq = w1 + 6336;
        const int t0 = pb * 8 + half;
        float zv[8], h1[8], h2[8];
        const float fr = fq[lane];
        for (int repc = 0; repc < REP_FC; ++repc) {
#pragma unroll
        for (int p = 0; p < 8; ++p) { int t = t0 + p; if (t > L - 1) t = L - 1;
            const float tn = (float)t / (float)(L - 1); const float w = 6.283185307179586f * (float)t / (float)L;
            float z = 0.f;
            if (lane == 0) z = tn;
            else if (lane <= 16) { const float band = 1e-4f + (float)(lane - 1) * ((15.f - 1e-4f) / 15.f); z = __cosf(band * w); }
            else if (lane <= 32) { const float band = 1e-4f + (float)(lane - 17) * ((15.f - 1e-4f) / 15.f); z = -__sinf(band * w); }
            zv[p] = z; h1[p] = b1[lane]; h2[p] = b2[lane]; }
#pragma unroll 3
        for (int e = 0; e < 33; ++e) { const float w = w1[e * 64 + lane];
#pragma unroll
            for (int p = 0; p < 8; ++p) h1[p] += __builtin_bit_cast(float, __builtin_amdgcn_readlane(__builtin_bit_cast(int, zv[p]), e)) * w; }
#pragma unroll
        for (int p = 0; p < 8; ++p) h1[p] = __sinf(fr * h1[p]);
#pragma unroll 4
        for (int i = 0; i < 64; ++i) { const float w = w2[i * 64 + lane];
#pragma unroll
            for (int p = 0; p < 8; ++p) h2[p] += __builtin_bit_cast(float, __builtin_amdgcn_readlane(__builtin_bit_cast(int, h1[p]), i)) * w; }
#pragma unroll
        for (int p = 0; p < 8; ++p) hs[lane * 8 + p] = __sinf(fr * h2[p]);
        }
        asm volatile("s_waitcnt lgkmcnt(0)" ::: "memory");
        float acc[4][8];
#pragma unroll
        for (int q = 0; q < 4; ++q)
#pragma unroll
            for (int p = 0; p < 8; ++p) acc[q][p] = 0.f;
#pragma unroll 4
        for (int i = 0; i < 64; ++i) {
            const f32x4 ha = *(const LAS f32x4*)(hs + i * 8), hb = *(const LAS f32x4*)(hs + i * 8 + 4);
#pragma unroll
            for (int q = 0; q < 4; ++q) { const float w = w3s[i * 256 + q * 64 + lane];
                acc[q][0] += ha[0] * w; acc[q][1] += ha[1] * w; acc[q][2] += ha[2] * w; acc[q][3] += ha[3] * w;
                acc[q][4] += hb[0] * w; acc[q][5] += hb[1] * w; acc[q][6] += hb[2] * w; acc[q][7] += hb[3] * w; }
        }
        asm volatile("s_waitcnt lgkmcnt(0)" ::: "memory");
        bf16_t* Fg = (bf16_t*)(ws + WS_FILT + (size_t)j * FILT_LAYER + (L == 2048 ? MiB : 0));
        const float mind = -3.0701134573253945f, maxd = -15.350567286626973f;
        for (int reps = 0; reps < REP_FS; ++reps)
#pragma unroll
        for (int q = 0; q < 4; ++q) { const int ch = ch4 * 256 + q * 64 + lane;
            const float ad = -(mind + (maxd - mind) * ((float)ch / 1023.f));
            float v[8];
#pragma unroll
            for (int p = 0; p < 8; ++p) { const int t = t0 + p; const float tn = (float)t / (float)(L - 1);
                float x = acc[q][p] * __expf(-tn * ad); if (t > L - 1) x = 0.f; if (half == 0 && t == 0) x += ap->in[I_DBIAS][j * 1024 + ch]; v[p] = x; }
            u32x4 o;
            if (half == 0) { o.x = cvtpk(v[7], v[6]); o.y = cvtpk(v[5], v[4]); o.z = cvtpk(v[3], v[2]); o.w = cvtpk(v[1], v[0]);
                *(u32x4*)(Fg + (size_t)ch * (2 * L) + (L - 8 - pb * 8)) = o; }
            else { o.x = cvtpk(v[0], v[1]); o.y = cvtpk(v[2], v[3]); o.z = cvtpk(v[4], v[5]); o.w = cvtpk(v[6], v[7]);
                *(u32x4*)(Fg + (size_t)ch * (2 * L) + (L + pb * 8)) = o; }
        }
    }
    __syncthreads();
    for (int rep = 0; rep < REP_P0D; ++rep) convert_layer_weights(ap, 0, gw, NGW, (LAS float*)(lds + wave * 16384), lane, 0, I_MIX);
    __syncthreads();
}

DI void row_phase(int gw, int NGW, int lane, const float* __restrict__ xP, const float* __restrict__ xS, float* __restrict__ xout, const bf16_t* __restrict__ Y, const float* __restrict__ ybias,
                  const float* __restrict__ modgate, const float* __restrict__ w_post, const float* __restrict__ w_pre, const float* __restrict__ modshift, const float* __restrict__ modscale, bf16_t* __restrict__ hout) {
    for (int m = gw; m < TT; m += NGW) {
        const int cnd = m < TP ? 0 : 1 + ((m - TP) >> 11);
        const float* xr = m < TP ? xP + (size_t)m * D : xS + (size_t)(m - TP) * D;
        f32x4 x[4], ya[4], bb[4], g[4], wp[4], wn[4], sh[4], sc[4]; u32x2 pa[4], pb[4];
#pragma unroll
        for (int j = 0; j < 4; ++j) x[j] = ((const f32x4*)xr)[lane + 64 * j];
        if (Y) {
#pragma unroll
            for (int j = 0; j < 4; ++j) { pa[j] = ((const u32x2*)(Y + (size_t)m * D))[lane + 64 * j]; pb[j] = ((const u32x2*)(Y + (size_t)TT * D + (size_t)m * D))[lane + 64 * j];
                bb[j] = ((const f32x4*)ybias)[lane + 64 * j]; g[j] = ((const f32x4*)(modgate + cnd * 6144))[lane + 64 * j]; wp[j] = ((const f32x4*)w_post)[lane + 64 * j]; }
        }
        if (hout) {
#pragma unroll
            for (int j = 0; j < 4; ++j) { wn[j] = ((const f32x4*)w_pre)[lane + 64 * j]; sh[j] = ((const f32x4*)(modshift + cnd * 6144))[lane + 64 * j]; sc[j] = ((const f32x4*)(modscale + cnd * 6144))[lane + 64 * j]; }
        }
        if (Y) {
            float ss = 0.f;
#pragma unroll
            for (int j = 0; j < 4; ++j) { ya[j] = (f32x4){bflo(pa[j].x) + bflo(pb[j].x), bfhi(pa[j].x) + bfhi(pb[j].x), bflo(pa[j].y) + bflo(pb[j].y), bfhi(pa[j].y) + bfhi(pb[j].y)} + bb[j]; ss += (ya[j].x * ya[j].x + ya[j].y * ya[j].y) + (ya[j].z * ya[j].z + ya[j].w * ya[j].w); }
            ss = wave_sum(ss); const float rstd = 1.f / sqrtf(ss * (1.f / D) + EPS);
#pragma unroll
            for (int j = 0; j < 4; ++j) x[j] += g[j] * (ya[j] * rstd * wp[j]);
        }
        u32x2 o[4];
        if (hout) {
            float ss = 0.f;
#pragma unroll
            for (int j = 0; j < 4; ++j) ss += (x[j].x * x[j].x + x[j].y * x[j].y) + (x[j].z * x[j].z + x[j].w * x[j].w);
            ss = wave_sum(ss); const float rstd = 1.f / sqrtf(ss * (1.f / D) + EPS);
#pragma unroll
            for (int j = 0; j < 4; ++j) { const f32x4 h = (x[j] * rstd * wn[j]) * (sc[j] + 1.f) + sh[j]; o[j].x = cvtpk(h.x, h.y); o[j].y = cvtpk(h.z, h.w); }
        }
#pragma unroll
        for (int j = 0; j < 4; ++j) ((f32x4*)(xout + (size_t)m * D))[lane + 64 * j] = x[j];
        if (hout) {
#pragma unroll
            for (int j = 0; j < 4; ++j) ((u32x2*)(hout + (size_t)m * D))[lane + 64 * j] = o[j];
        }
    }
}

DI void ffn_elem_phase(int gtid, int NT, const bf16_t* __restrict__ z, const float* __restrict__ wdw, const float* __restrict__ bdw, bf16_t* __restrict__ aout) {
    for (int item = gtid; item < 2048 * 352; item += NT) {
        const int r = item / 352, cc = item - r * 352, row0 = 4 * r;
        const int L = row0 < TP ? 256 : 2048, tl0 = row0 & (L - 1);
        float wg[3][8], wv[3][8], bg[8], bv[8];
#pragma unroll
        for (int k = 0; k < 3; ++k)
#pragma unroll
            for (int h = 0; h < 2; ++h) { const f32x4 t0 = *(const f32x4*)(wdw + k * NUP + 8 * cc + 4 * h), t1 = *(const f32x4*)(wdw + k * NUP + DFF + 8 * cc + 4 * h);
#pragma unroll
                for (int e = 0; e < 4; ++e) { wg[k][4 * h + e] = t0[e]; wv[k][4 * h + e] = t1[e]; } }
#pragma unroll
        for (int h = 0; h < 2; ++h) { const f32x4 t0 = *(const f32x4*)(bdw + 8 * cc + 4 * h), t1 = *(const f32x4*)(bdw + DFF + 8 * cc + 4 * h);
#pragma unroll
            for (int e = 0; e < 4; ++e) { bg[4 * h + e] = t0[e]; bv[4 * h + e] = t1[e]; } }
        const bf16_t* zb = z + (size_t)row0 * NUP + 8 * cc;
        const u32x4 zero4 = {0u, 0u, 0u, 0u};
        u32x4 rg[6], rv[6];
        rg[0] = tl0 > 0 ? *(const u32x4*)(zb - NUP) : zero4; rv[0] = tl0 > 0 ? *(const u32x4*)(zb - NUP + DFF) : zero4;
#pragma unroll
        for (int k = 0; k < 4; ++k) { rg[1 + k] = *(const u32x4*)(zb + (size_t)k * NUP); rv[1 + k] = *(const u32x4*)(zb + (size_t)k * NUP + DFF); }
        { const bool has_next = (tl0 + 4) < L; rg[5] = has_next ? *(const u32x4*)(zb + (size_t)4 * NUP) : zero4; rv[5] = has_next ? *(const u32x4*)(zb + (size_t)4 * NUP + DFF) : zero4; }
        u32x4 wout[4];
#pragma unroll
        for (int k = 0; k < 4; ++k) {
            float pg[8], pv[8], cg_[8], cv[8], ng[8], nv[8], o[8];
            unpack8(rg[k], pg); unpack8(rv[k], pv); unpack8(rg[k + 1], cg_); unpack8(rv[k + 1], cv); unpack8(rg[k + 2], ng); unpack8(rv[k + 2], nv);
#pragma unroll
            for (int e = 0; e < 8; ++e) { const float g = wg[0][e] * pg[e] + wg[1][e] * cg_[e] + wg[2][e] * ng[e] + bg[e]; const float v = wv[0][e] * pv[e] + wv[1][e] * cv[e] + wv[2][e] * nv[e] + bv[e];
                o[e] = (g / (1.f + __expf(-g))) * v; }
            wout[k].x = cvtpk(o[0], o[1]); wout[k].y = cvtpk(o[2], o[3]); wout[k].z = cvtpk(o[4], o[5]); wout[k].w = cvtpk(o[6], o[7]);
        }
#pragma unroll
        for (int k = 0; k < 4; ++k) *(u32x4*)(aout + (size_t)(row0 + k) * DFF + 8 * cc) = wout[k];
    }
}

DI void ffn_edge_fix(int tid, int pm, int ks, const float* __restrict__ side, const float* __restrict__ wdw, bf16_t* __restrict__ aout) {
    const bool sample = pm >= 16; const int st = (pm - 16) & 7;
    float pg[11], pv[11], og[11], ov[11], wg[11], wv[11];
#pragma unroll
    for (int k = 0; k < 11; ++k) {
        const int idx = tid + 512 * k, e = idx / 1408, n = ks * 1408 + (idx - e * 1408);
        const float* mine = side + (size_t)((pm * 4 + e) * 2) * NUP;
        int pt = -1, tap = 0;
        if (e == 1) { pt = pm * 4 + 2; tap = 2; } else if (e == 2) { pt = pm * 4 + 1; tap = 0; }
        else if (e == 0) { if (sample && st != 0) { pt = (pm - 1) * 4 + 3; tap = 0; } }
        else { if (sample && st != 7) { pt = (pm + 1) * 4 + 0; tap = 2; } }
        const float* o = side + (size_t)((pt < 0 ? pm * 4 + e : pt) * 2) * NUP;
        const float msk = pt < 0 ? 0.f : 1.f;
        pg[k] = mine[NUP + n]; pv[k] = mine[NUP + DFF + n];
        og[k] = o[n] * msk; ov[k] = o[DFF + n] * msk;
        wg[k] = wdw[tap * NUP + n]; wv[k] = wdw[tap * NUP + DFF + n];
    }
#pragma unroll
    for (int k = 0; k < 11; ++k) {
        const int idx = tid + 512 * k, e = idx / 1408, n = ks * 1408 + (idx - e * 1408);
        const float g = pg[k] + wg[k] * og[k], v = pv[k] + wv[k] * ov[k];
        const float r = g * __builtin_amdgcn_rcpf(1.f + __expf(-g)) * v;
        const int tok = pm * 256 + (e == 0 ? 0 : (e == 1 ? 127 : (e == 2 ? 128 : 255)));
        aout[(size_t)tok * DFF + n] = (bf16_t)(cvtpk(r, 0.f) & 0xffffu);
    }
    asm volatile("s_waitcnt vmcnt(0)" ::: "memory");
    __syncthreads();
}

constexpr int CV_G = 0, CV_GCH = 5120, CV_F = 40960, CV_FCH = 8192;
DI void conv_phase(LAS unsigned char* lds, int tid, int lane, int wave, int G, const bf16_t* __restrict__ z, const float* __restrict__ wsh, const float* __restrict__ bsh, const unsigned char* __restrict__ filt, bf16_t* __restrict__ yh) {
    for (int u = blockIdx.x; u < 512; u += G) {
        const int grp = u < 256 ? 2 + (u >> 7) : ((u - 256) >> 7), c0 = (u & 127) * 8;
        const int row0 = grp * 2048, L = grp < 2 ? 256 : 2048, nb = L >> 5;
        for (int rep1 = 0; rep1 < REP_CV1; ++rep1) {
            float w1[3][8], wv[3][8], b1[8], bv[8];
#pragma unroll
            for (int k = 0; k < 3; ++k)
#pragma unroll
                for (int h = 0; h < 2; ++h) { const f32x4 t0 = *(const f32x4*)(wsh + k * NMIX + 1024 + c0 + 4 * h), t1 = *(const f32x4*)(wsh + k * NMIX + 2048 + c0 + 4 * h);
#pragma unroll
                    for (int e = 0; e < 4; ++e) { w1[k][4 * h + e] = t0[e]; wv[k][4 * h + e] = t1[e]; } }
#pragma unroll
            for (int h = 0; h < 2; ++h) { const f32x4 t0 = *(const f32x4*)(bsh + 1024 + c0 + 4 * h), t1 = *(const f32x4*)(bsh + 2048 + c0 + 4 * h);
#pragma unroll
                for (int e = 0; e < 4; ++e) { b1[4 * h + e] = t0[e]; bv[4 * h + e] = t1[e]; } }
            const u32x4 zero4 = {0u, 0u, 0u, 0u};
            for (int idx = tid; idx < 2048; idx += 512) {
                const int tl = idx & (L - 1);
                const bf16_t* z1 = z + ((size_t)(128 + (c0 >> 3)) * TT + row0 + idx) * 8; const bf16_t* zv = z + ((size_t)(256 + (c0 >> 3)) * TT + row0 + idx) * 8;
                const u32x4 p1 = tl > 0 ? *(const u32x4*)(z1 - 8) : zero4, pv_ = tl > 0 ? *(const u32x4*)(zv - 8) : zero4;
                const u32x4 q1 = *(const u32x4*)z1, qv = *(const u32x4*)zv;
                const u32x4 n1 = tl < L - 1 ? *(const u32x4*)(z1 + 8) : zero4, nv = tl < L - 1 ? *(const u32x4*)(zv + 8) : zero4;
                float a[8], b[8], c[8], d[8], e_[8], f[8];
                unpack8(p1, a); unpack8(q1, b); unpack8(n1, c); unpack8(pv_, d); unpack8(qv, e_); unpack8(nv, f);
                LAS bf16_t* gp = (LAS bf16_t*)(lds + CV_G + (idx >> 5) * 80 + (idx & 31) * 2);
#pragma unroll
                for (int e = 0; e < 8; ++e) { const float x1 = w1[0][e] * a[e] + w1[1][e] * b[e] + w1[2][e] * c[e] + b1[e]; const float v = wv[0][e] * d[e] + wv[1][e] * e_[e] + wv[2][e] * f[e] + bv[e];
                    gp[e * (CV_GCH / 2)] = (bf16_t)(cvtpk(v * x1, 0.f) & 0xffffu); }
            }
            const u32x4* fsrc = (const u32x4*)(filt + (L == 2048 ? MiB : 0) + (size_t)(c0 + wave) * (size_t)(4 * L));
            LAS u32x4* fdst = (LAS u32x4*)(lds + CV_F + wave * CV_FCH);
            if (L == 2048) { u32x4 fv[8];
#pragma unroll
                for (int i = 0; i < 8; ++i) fv[i] = fsrc[lane + 64 * i];
#pragma unroll
                for (int i = 0; i < 8; ++i) fdst[lane + 64 * i] = fv[i]; }
            else fdst[lane] = fsrc[lane];
        }
        __syncthreads();
        f32x16 acc0, acc1;
        for (int rep2 = 0; rep2 < REP_CV2; ++rep2) {
#pragma unroll
        for (int i = 0; i < 16; ++i) { acc0[i] = 0.f; acc1[i] = 0.f; }
            const int p = lane & 31, kg = lane >> 5;
            const LAS unsigned char* Fw = lds + CV_F + wave * CV_FCH;
            const LAS unsigned char* Gw = lds + CV_G + wave * CV_GCH;
            const int bi0 = p & (nb - 1), bi1 = (32 + p) & (nb - 1);
            const u32x4 zero4 = {0u, 0u, 0u, 0u};
#define CONV_STEP(T0, T1) do { \
                const int s0 = L - 1 - 32 * d - p + 8 * kg; \
                const LAS unsigned* fp = (const LAS unsigned*)Fw + (s0 >> 1); \
                const unsigned sh = (s0 & 1) * 16; \
                unsigned w0[5], w1_[5]; \
                _Pragma("unroll") for (int i = 0; i < 5; ++i) { w0[i] = fp[i]; w1_[i] = fp[8 + i]; } \
                int blk0 = p - d; blk0 = blk0 < 0 ? 0 : (blk0 > 63 ? 63 : blk0); \
                int blk1 = 32 + p - d; blk1 = blk1 < 0 ? 0 : (blk1 > 63 ? 63 : blk1); \
                const LAS unsigned char* bp0 = Gw + blk0 * 80 + kg * 16; const LAS unsigned char* bp1 = Gw + blk1 * 80 + kg * 16; \
                u32x4 B00 = zero4, B01 = zero4, B10 = zero4, B11 = zero4; \
                if (T0) { B00 = *(const LAS u32x4*)bp0; B01 = *(const LAS u32x4*)(bp0 + 32); } \
                if (T1) { B10 = *(const LAS u32x4*)bp1; B11 = *(const LAS u32x4*)(bp1 + 32); } \
                const bool valid0 = (unsigned)(bi0 - d) < (unsigned)nb, valid1 = (unsigned)(bi1 - d) < (unsigned)nb; \
                u32x4 A0, A1; \
                A0.x = __builtin_amdgcn_alignbit(w0[1], w0[0], sh); A0.y = __builtin_amdgcn_alignbit(w0[2], w0[1], sh); A0.z = __builtin_amdgcn_alignbit(w0[3], w0[2], sh); A0.w = __builtin_amdgcn_alignbit(w0[4], w0[3], sh); \
                A1.x = __builtin_amdgcn_alignbit(w1_[1], w1_[0], sh); A1.y = __builtin_amdgcn_alignbit(w1_[2], w1_[1], sh); A1.z = __builtin_amdgcn_alignbit(w1_[3], w1_[2], sh); A1.w = __builtin_amdgcn_alignbit(w1_[4], w1_[3], sh); \
                const bf16x8 a0 = __builtin_bit_cast(bf16x8, A0), a1 = __builtin_bit_cast(bf16x8, A1); \
                if (!valid0) { B00 = zero4; B01 = zero4; } \
                if (!valid1) { B10 = zero4; B11 = zero4; } \
                if (T0) acc0 = __builtin_amdgcn_mfma_f32_32x32x16_bf16(a0, __builtin_bit_cast(bf16x8, B00), acc0, 0, 0, 0); \
                if (T1) acc1 = __builtin_amdgcn_mfma_f32_32x32x16_bf16(a0, __builtin_bit_cast(bf16x8, B10), acc1, 0, 0, 0); \
                if (T0) acc0 = __builtin_amdgcn_mfma_f32_32x32x16_bf16(a1, __builtin_bit_cast(bf16x8, B01), acc0, 0, 0, 0); \
                if (T1) acc1 = __builtin_amdgcn_mfma_f32_32x32x16_bf16(a1, __builtin_bit_cast(bf16x8, B11), acc1, 0, 0, 0); \
            } while (0)
            if (nb == 8) {
#pragma unroll 1
                for (int d = -7; d <= 7; ++d) CONV_STEP(true, true);
            } else {
#pragma unroll 1
                for (int d = -63; d <= -32; ++d) CONV_STEP(true, false);
#pragma unroll 1
                for (int d = -31; d <= 31; ++d) CONV_STEP(true, true);
#pragma unroll 1
                for (int d = 32; d <= 63; ++d) CONV_STEP(false, true);
            }
#undef CONV_STEP
        }
        __syncthreads();
        {
            LAS float* ys = (LAS float*)(lds + CV_F) + wave * 2112;
            const int n = lane & 31, hh = lane >> 5;
#pragma unroll
            for (int r = 0; r < 16; ++r) { const int p = (r & 3) + 8 * (r >> 2) + 4 * hh; ys[n * 33 + p] = acc0[r]; ys[(32 + n) * 33 + p] = acc1[r]; }
        }
        __syncthreads();
        for (int rep4 = 0; rep4 < REP_CV4; ++rep4) {
            float w0[3][8], b0[8];
#pragma unroll
            for (int k = 0; k < 3; ++k)
#pragma unroll
                for (int h = 0; h < 2; ++h) { const f32x4 t0 = *(const f32x4*)(wsh + k * NMIX + c0 + 4 * h);
#pragma unroll
                    for (int e = 0; e < 4; ++e) w0[k][4 * h + e] = t0[e]; }
#pragma unroll
            for (int h = 0; h < 2; ++h) { const f32x4 t0 = *(const f32x4*)(bsh + c0 + 4 * h);
#pragma unroll
                for (int e = 0; e < 4; ++e) b0[4 * h + e] = t0[e]; }
            const u32x4 zero4 = {0u, 0u, 0u, 0u};
            const LAS float* ysb = (const LAS float*)(lds + CV_F);
            u32x4 pz[4], cz[4], nz[4];
#pragma unroll
            for (int it = 0; it < 4; ++it) { const int t = tid + 512 * it, tl = t & (L - 1);
                const bf16_t* zb = z + ((size_t)(c0 >> 3) * TT + row0 + t) * 8;
                pz[it] = tl > 0 ? *(const u32x4*)(zb - 8) : zero4; cz[it] = *(const u32x4*)zb; nz[it] = tl < L - 1 ? *(const u32x4*)(zb + 8) : zero4; }
#pragma unroll
            for (int it = 0; it < 4; ++it) { const int t = tid + 512 * it;
                float a[8], b[8], c[8], o[8];
                unpack8(pz[it], a); unpack8(cz[it], b); unpack8(nz[it], c);
#pragma unroll
                for (int e = 0; e < 8; ++e) { const float x0 = w0[0][e] * a[e] + w0[1][e] * b[e] + w0[2][e] * c[e] + b0[e]; o[e] = x0 * ysb[e * 2112 + (t >> 5) * 33 + (t & 31)]; }
                u32x4 w; w.x = cvtpk(o[0], o[1]); w.y = cvtpk(o[2], o[3]); w.z = cvtpk(o[4], o[5]); w.w = cvtpk(o[6], o[7]);
                *(u32x4*)(yh + ((size_t)(c0 >> 3) * TT + row0 + t) * 8) = w;
            }
        }
        __syncthreads();
    }
}

constexpr int AT_K = 0, AT_KROW = 272, AT_V = 64 * 272, AT_VROW = 288, AT_BUF = 64 * 272 + 64 * 288;
DI void attn_phase(LAS unsigned char* lds, int tid, int lane, int wave, int G, const bf16_t* __restrict__ z, const float* __restrict__ cache_k, const float* __restrict__ cache_v, const float* __restrict__ subln, float lam, float lam_init, bf16_t* __restrict__ yh) {
    const float C2 = 0.125f * 1.4426950408889634f;
    const int q16 = lane & 15, kg = lane >> 4;
    for (int u0 = blockIdx.x; u0 < 512; u0 += G) {
        int u = u0;
        if (G == 256) { const int c = u0 & 255; u = (u0 & 256) + (c & 7) * 32 + (c >> 3); }
        int b, h, qrow0, krow0, ntile; bool sample = u < 256;
        if (sample) { b = u >> 7; h = (u >> 4) & 7; const int qb = u & 15; krow0 = TP + b * 2048; qrow0 = krow0 + qb * 128; ntile = 36; }
        else { const int v = u - 256; b = v >> 4; h = (v >> 1) & 7; const int qb = v & 1; krow0 = b * 256; qrow0 = krow0 + qb * 128; ntile = 4; }
        const float* ck = cache_k + (size_t)(b * 16 + h) * 256 * 128;
        const float* cvp = cache_v + (size_t)(b * 16 + h) * 256 * 128;
        bf16x8 q1[2], q2[2];
        { const bf16_t* qp = z + (size_t)(qrow0 + wave * 16 + q16) * NMIX + h * 128 + 8 * kg;
          q1[0] = *(const bf16x8*)qp; q1[1] = *(const bf16x8*)(qp + 32); q2[0] = *(const bf16x8*)(qp + 64); q2[1] = *(const bf16x8*)(qp + 96); }
        f32x4 O1[8], O2[8];
#pragma unroll
        for (int i = 0; i < 8; ++i) { O1[i] = (f32x4){0.f, 0.f, 0.f, 0.f}; O2[i] = (f32x4){0.f, 0.f, 0.f, 0.f}; }
        float m1 = -1e30f, m2 = -1e30f, l1 = 0.f, l2 = 0.f;
        u32x4 kv[2], vv[2];
#define AT_LOAD(KT) do { _Pragma("unroll") for (int i = 0; i < 2; ++i) { const int id = tid + 512 * i, r = id & 63, c8 = id >> 6; \
            if (sample && (KT) < 4) { \
                const float* kp = ck + (size_t)((KT) * 64 + r) * 128 + c8 * 8; const float* vp = cvp + (size_t)((KT) * 64 + r) * 128 + c8 * 8; \
                const f32x4 k0 = *(const f32x4*)kp, k1 = *(const f32x4*)(kp + 4), v0 = *(const f32x4*)vp, v1 = *(const f32x4*)(vp + 4); \
                kv[i].x = cvtpk(k0[0], k0[1]); kv[i].y = cvtpk(k0[2], k0[3]); kv[i].z = cvtpk(k1[0], k1[1]); kv[i].w = cvtpk(k1[2], k1[3]); \
                vv[i].x = cvtpk(v0[0], v0[1]); vv[i].y = cvtpk(v0[2], v0[3]); vv[i].z = cvtpk(v1[0], v1[1]); vv[i].w = cvtpk(v1[2], v1[3]); \
            } else { \
                const int kr = krow0 + (sample ? (KT) - 4 : (KT)) * 64 + r; \
                const bf16_t* kp = z + (size_t)kr * NMIX + 1024 + h * 128 + c8 * 8; \
                kv[i] = *(const u32x4*)kp; vv[i] = *(const u32x4*)(kp + 1024); \
            } } } while (0)
#define AT_STORE(BUF) do { _Pragma("unroll") for (int i = 0; i < 2; ++i) { const int id = tid + 512 * i, r = id & 63, c8 = id >> 6; \
            *(LAS u32x4*)(lds + (BUF) * AT_BUF + AT_K + r * AT_KROW + c8 * 16) = kv[i]; \
            *(LAS u32x4*)(lds + (BUF) * AT_BUF + AT_V + r * AT_VROW + c8 * 16) = vv[i]; } } while (0)
        __syncthreads();
        AT_LOAD(0); AT_STORE(0);
        if (ntile > 1) AT_LOAD(1);
        __syncthreads();
        for (int kt = 0; kt < ntile; ++kt) {
            if (kt + 1 < ntile) AT_STORE((kt + 1) & 1);
            if (kt + 2 < ntile) AT_LOAD(kt + 2);
            const LAS unsigned char* kbase = lds + (kt & 1) * AT_BUF;
            f32x4 s1[4], s2[4];
#pragma unroll
            for (int hf = 0; hf < 2; ++hf) {
                bf16x8 kf[2][4];
#pragma unroll
                for (int k2 = 0; k2 < 2; ++k2) {
                    const LAS unsigned char* kp = kbase + AT_K + (32 * hf + 8 * (q16 >> 2) + 4 * k2 + (q16 & 3)) * AT_KROW + kg * 16;
                    kf[k2][0] = *(const LAS bf16x8*)kp; kf[k2][1] = *(const LAS bf16x8*)(kp + 64); kf[k2][2] = *(const LAS bf16x8*)(kp + 128); kf[k2][3] = *(const LAS bf16x8*)(kp + 192);
                }
#pragma unroll
                for (int k2 = 0; k2 < 2; ++k2) {
                    f32x4 t = {0.f, 0.f, 0.f, 0.f}, t2 = {0.f, 0.f, 0.f, 0.f};
                    t = __builtin_amdgcn_mfma_f32_16x16x32_bf16(kf[k2][0], q1[0], t, 0, 0, 0); t2 = __builtin_amdgcn_mfma_f32_16x16x32_bf16(kf[k2][2], q2[0], t2, 0, 0, 0);
                    t = __builtin_amdgcn_mfma_f32_16x16x32_bf16(kf[k2][1], q1[1], t, 0, 0, 0); t2 = __builtin_amdgcn_mfma_f32_16x16x32_bf16(kf[k2][3], q2[1], t2, 0, 0, 0);
                    s1[2 * hf + k2] = t; s2[2 * hf + k2] = t2;
                }
            }
            float mx1 = -1e30f, mx2 = -1e30f;
#pragma unroll
            for (int ks = 0; ks < 4; ++ks)
#pragma unroll
                for (int j = 0; j < 4; ++j) { mx1 = fmaxf(mx1, s1[ks][j]); mx2 = fmaxf(mx2, s2[ks][j]); }
            { const float a = __shfl_xor(mx1, 16), b = __shfl_xor(mx2, 16); mx1 = fmaxf(mx1, a); mx2 = fmaxf(mx2, b); }
            { const float a = __shfl_xor(mx1, 32), b = __shfl_xor(mx2, 32); mx1 = fmaxf(mx1, a); mx2 = fmaxf(mx2, b); }
            const float mn1 = fmaxf(m1, mx1 * C2), mn2 = fmaxf(m2, mx2 * C2);
            const float al1 = __builtin_amdgcn_exp2f(m1 - mn1), al2 = __builtin_amdgcn_exp2f(m2 - mn2);
            m1 = mn1; m2 = mn2;
            float ps1 = 0.f, ps2 = 0.f;
#pragma unroll
            for (int ks = 0; ks < 4; ++ks)
#pragma unroll
                for (int j = 0; j < 4; ++j) { const float p1 = __builtin_amdgcn_exp2f(s1[ks][j] * C2 - mn1), p2 = __builtin_amdgcn_exp2f(s2[ks][j] * C2 - mn2); s1[ks][j] = p1; s2[ks][j] = p2; ps1 += p1; ps2 += p2; }
            l1 = l1 * al1 + ps1; l2 = l2 * al2 + ps2;
#pragma unroll
            for (int i = 0; i < 8; ++i) { O1[i] *= al1; O2[i] *= al2; }
#pragma unroll
            for (int s = 0; s < 2; ++s) {
                u32x4 pa, pb;
                pa.x = cvtpk(s1[2 * s][0], s1[2 * s][1]); pa.y = cvtpk(s1[2 * s][2], s1[2 * s][3]); pa.z = cvtpk(s1[2 * s + 1][0], s1[2 * s + 1][1]); pa.w = cvtpk(s1[2 * s + 1][2], s1[2 * s + 1][3]);
                pb.x = cvtpk(s2[2 * s][0], s2[2 * s][1]); pb.y = cvtpk(s2[2 * s][2], s2[2 * s][3]); pb.z = cvtpk(s2[2 * s + 1][0], s2[2 * s + 1][1]); pb.w = cvtpk(s2[2 * s + 1][2], s2[2 * s + 1][3]);
                const bf16x8 P1 = __builtin_bit_cast(bf16x8, pa), P2 = __builtin_bit_cast(bf16x8, pb);
                bf16x8 vf[8];
#pragma unroll
                for (int dt = 0; dt < 8; ++dt) {
                    const LAS unsigned char* vp = kbase + AT_V + (32 * s + 8 * kg + (q16 >> 2)) * AT_VROW + 32 * dt + 8 * (q16 & 3);
                    const s16x4 va = __builtin_bit_cast(s16x4, __builtin_amdgcn_ds_read_tr16_b64_v4i16((LAS s16x4*)vp));
                    const s16x4 vb = __builtin_bit_cast(s16x4, __builtin_amdgcn_ds_read_tr16_b64_v4i16((LAS s16x4*)(vp + 4 * AT_VROW)));
                    const bf16x8 vq = {va[0], va[1], va[2], va[3], vb[0], vb[1], vb[2], vb[3]};
                    vf[dt] = vq;
                }
#pragma unroll
                for (int dt = 0; dt < 8; ++dt) {
                    O1[dt] = __builtin_amdgcn_mfma_f32_16x16x32_bf16(vf[dt], P1, O1[dt], 0, 0, 0);
                    O2[dt] = __builtin_amdgcn_mfma_f32_16x16x32_bf16(vf[dt], P2, O2[dt], 0, 0, 0);
                }
            }
            __syncthreads();
        }
        l1 += __shfl_xor(l1, 16); l1 += __shfl_xor(l1, 32); l2 += __shfl_xor(l2, 16); l2 += __shfl_xor(l2, 32);
        const float r1 = 1.f / l1, r2 = lam / l2;
        float ss = 0.f;
#pragma unroll
        for (int i = 0; i < 8; ++i) { O1[i] = O1[i] * r1 - O2[i] * r2; ss += (O1[i][0] * O1[i][0] + O1[i][1] * O1[i][1]) + (O1[i][2] * O1[i][2] + O1[i][3] * O1[i][3]); }
        ss += __shfl_xor(ss, 16); ss += __shfl_xor(ss, 32);
        const float rstd = (1.f - lam_init) / sqrtf(ss * (1.f / 128.f) + EPS);
        bf16_t* op = yh + (size_t)(qrow0 + wave * 16 + q16) * D + h * 128 + 4 * kg;
#pragma unroll
        for (int i = 0; i < 8; ++i) { const f32x4 w = *(const f32x4*)(subln + 16 * i + 4 * kg); const f32x4 o = O1[i] * rstd * w;
            u32x2 pk; pk.x = cvtpk(o[0], o[1]); pk.y = cvtpk(o[2], o[3]); *(u32x2*)(op + 16 * i) = pk; }
    }
    __syncthreads();
}


#define XB_TMO      128
#define XB_XCNT(j)  (256  + 64 * (j))
#define XB_XSUB(j)  (1280 + 64 * (j))
#define XB_XGEN(j)  (2304 + 64 * (j))
#define XB_TOP      3328
#define XB_TOPGEN   3392
#define XCD_BAR_WORDS 3456
#define XB_SPIN_CAP (1u << 22)
DI unsigned xb_ld(unsigned* p)              { return __hip_atomic_load(p, __ATOMIC_RELAXED, __HIP_MEMORY_SCOPE_AGENT); }
DI unsigned xb_add(unsigned* p, unsigned v) { return __hip_atomic_fetch_add(p, v, __ATOMIC_RELAXED, __HIP_MEMORY_SCOPE_AGENT); }
DI unsigned xb_xcc_id() { return (unsigned)__builtin_amdgcn_s_getreg((3 << 11) | 20) & 0xFu; }
#define XB_SPIN(cond, bar) do { unsigned _sp = 0; while (cond) { __builtin_amdgcn_s_sleep(1); \
    if ((++_sp & 255u) == 0u) { if (xb_ld(&(bar)[XB_TMO])) break; if (_sp > XB_SPIN_CAP) { atomicAdd(&(bar)[XB_TMO], 1u); break; } } } } while (0)
DI void xcd_barrier_complete(unsigned* bar, unsigned x, unsigned& nloc, unsigned& nx) {
    const unsigned G = gridDim.x * gridDim.y * gridDim.z;
    unsigned sum, cnt, mine, sp = 0u;
    for (;;) {
        sum = 0u; cnt = 0u; mine = 0u;
#pragma unroll
        for (unsigned j = 0; j < 16; ++j) { const unsigned c = xb_ld(&bar[XB_XCNT(j)]); sum += c; cnt += (c > 0u) ? 1u : 0u; mine = (j == x) ? c : mine; }
        if (sum == G) break;
        __builtin_amdgcn_s_sleep(1);
        if ((++sp & 255u) == 0u) { if (xb_ld(&bar[XB_TMO])) break; if (sp > XB_SPIN_CAP) { atomicAdd(&bar[XB_TMO], 1u); break; } }
    }
    nloc = mine > 0u ? mine : 1u; nx = cnt > 0u ? cnt : 1u;
}
DI void xcd_barrier(unsigned* bar, volatile LAS unsigned* st) {
    asm volatile("s_waitcnt vmcnt(0)" ::: "memory");
    __syncthreads();
    if (threadIdx.x == 0) {
        const unsigned x = xb_xcc_id();
        __builtin_amdgcn_s_waitcnt(0);
        unsigned nloc = st[0], nx = st[1];
        if (nloc == 0u) { xcd_barrier_complete(bar, x, nloc, nx); st[0] = nloc; st[1] = nx; }
        const unsigned old = xb_add(&bar[XB_XSUB(x)], 1u);
        const unsigned gen = old / nloc;
        if (old + 1u == (gen + 1u) * nloc) {
            __builtin_amdgcn_fence(__ATOMIC_RELEASE, "agent");
            asm volatile("s_waitcnt vmcnt(0)" ::: "memory");
            const unsigned og = xb_add(&bar[XB_TOP], 1u);
            const unsigned tg = og / nx;
            if (og + 1u == (tg + 1u) * nx) xb_add(&bar[XB_TOPGEN], 1u);
            else XB_SPIN(xb_ld(&bar[XB_TOPGEN]) == tg, bar);
            __builtin_amdgcn_fence(__ATOMIC_ACQUIRE, "agent");
            asm volatile("s_waitcnt vmcnt(0)" ::: "memory");
        } else {
            XB_SPIN(xb_ld(&bar[XB_TOPGEN]) == gen, bar);
            __builtin_amdgcn_fence(__ATOMIC_ACQUIRE, "agent");
            asm volatile("s_waitcnt vmcnt(0)" ::: "memory");
        }
    }
    __syncthreads();
}

constexpr int N_PHASES = 30;
__global__ void __launch_bounds__(NWAVES * 64, 2) fwd_megakernel(Args a_byval) {
    extern __shared__ __attribute__((aligned(16))) unsigned char lds_raw[];
    LAS unsigned char* lds = (LAS unsigned char*)lds_raw;
    const int ph_lo = a_byval.ph_lo, ph_hi = a_byval.ph_hi;
    if (threadIdx.x < 64) ((LAS unsigned*)(lds + LDS_MISC))[threadIdx.x] = 0u;
    __syncthreads();
    if (threadIdx.x == 0) (void)xb_add((unsigned*)(a_byval.ws + WS_CTL) + XB_XCNT(xb_xcc_id()), 1u);
    for (int ph = ph_lo; ph < ph_hi; ++ph) {
        ArgsP ap = (ArgsP)__builtin_amdgcn_kernarg_segment_ptr(); asm volatile("" : "+s"(ap));
        int tid = threadIdx.x; asm volatile("" : "+v"(tid));
        unsigned char* ws = ap->ws;
        float* xout = ap->out;
        const int lane = tid & 63, wave = __builtin_amdgcn_readfirstlane(tid >> 6), G = gridDim.x;
        const int gw = blockIdx.x * NWAVES + wave, NGW = G * NWAVES;
        float* newk = xout + (size_t)TT * D; float* newv = newk + (size_t)16 * 2 * 8 * 256 * 128;
        const float* mod = (const float*)(ws + WS_MOD);
        bf16_t* zb = (bf16_t*)(ws + WS_Z); bf16_t* Y = (bf16_t*)(ws + WS_Z + 48 * MiB); float* sideb = (float*)(ws + WS_Z + 80 * MiB);
        bf16_t* hb = (bf16_t*)(ws + WS_A); bf16_t* yhb = (bf16_t*)(ws + WS_A + 16 * MiB); bf16_t* ab = (bf16_t*)(ws + WS_Z);
        const float* normw = ap->in[I_NORMW];
        if (ph == 0) {
            for (int rep = 0; rep < REP_P0; ++rep) phase0(ap, lds, tid, lane, wave, G);
        } else if (ph == N_PHASES - 1) {
            if (KON(0)) row_phase(gw, NGW, lane, xout, xout + (size_t)TP * D, xout, Y, (const float*)(ws + WS_ZERO), mod + 3 * 3 * 6144 + 5 * 1024, normw + (3 * 4 + 3) * D, nullptr, nullptr, nullptr, nullptr);
        } else {
            const int i = (ph - 1) / 7, k7 = (ph - 1) - 7 * i, kind = k7 < 6 ? k7 : 7, j = i >> 1; const bool attn = (i & 1);
            const float* modl = mod + i * 3 * 6144;
            unsigned char* wl = ws + WS_W + (size_t)i * W_LAYER;
            if (kind & 1) {
                if (KON(1)) {
                pg8::Gemm g; pg8::Order S; pg8::EpiU E;
                E.z = pg8::EpiZ{zb, NMIX, nullptr, 0}; E.q = pg8::EpiQKV{zb, (const float*)(ws + WS_ROPE), (const float*)(ws + WS_ROPE) + 2048 * 32, newk + (size_t)j * 8 * 256 * 128, newv + (size_t)j * 8 * 256 * 128};
                E.f = pg8::EpiF32{Y, D, (size_t)TT * D}; E.n = pg8::EpiFFN{ab, ap->in[I_FDW] + (size_t)i * 3 * NUP, ap->in[I_FBDW] + (size_t)i * NUP, sideb};
                if (kind == 1) { g = pg8::Gemm{hb, (const bf16_t*)(wl + W_MIX), TT, NMIX, D, 1, 0}; E.mode = attn ? 1 : 0; E.z.bias = ap->in[I_HBIN] + j * NMIX; E.z.slab = 1; }
                else if (kind == 3) { g = pg8::Gemm{yhb, (const bf16_t*)(wl + W_OUT), TT, D, D, 2, attn ? 0 : 1}; E.mode = 2; }
                else if (kind == 5) { g = pg8::Gemm{hb, (const bf16_t*)(wl + W_UP), TT, NUP, D, 1, 2}; E.mode = 3; }
                else { g = pg8::Gemm{ab, (const bf16_t*)(wl + W_DOWN), TT, D, DFF, 2, 0}; E.mode = 2; }
                S.init(g.M, g.N, g.KS, G, (int)blockIdx.x);
                if (kind == 7) { pg8::Unit u0; for (int ui = 0; S.next(ui, u0); ++ui) ffn_edge_fix(tid, u0.pm, u0.ks, sideb, ap->in[I_FDW] + (size_t)i * 3 * NUP, ab); }
                for (int rep = 0; rep < REP_GEMM; ++rep) pg8::gemm_phase(lds, tid, g, S, E);
                if (kind == 1 && (int)blockIdx.x >= 128 && G == 256)
                    convert_layer_weights(ap, i, ((int)blockIdx.x - 128) * NWAVES + wave, 128 * NWAVES, (LAS float*)(lds + wave * 16384), lane, I_MIX, i < 3 ? I_LAYER + I_MIX : I_LAYER);
                else if (kind == 1 && G != 256) convert_layer_weights(ap, i, gw, NGW, (LAS float*)(lds + wave * 16384), lane, I_MIX, i < 3 ? I_LAYER + I_MIX : I_LAYER);
                }
            } else if (kind == 0 && KON(0)) {
                if (i == 0) row_phase(gw, NGW, lane, ap->in[I_XP], ap->in[I_XS], xout, nullptr, nullptr, nullptr, nullptr, normw + (i * 4 + 0) * D, modl, modl + 1024, hb);
                else row_phase(gw, NGW, lane, xout, xout + (size_t)TP * D, xout, Y, (const float*)(ws + WS_ZERO), modl - 3 * 6144 + 5 * 1024, normw + ((i - 1) * 4 + 3) * D, normw + (i * 4 + 0) * D, modl, modl + 1024, hb);
            } else if (kind == 2) {
                if (!attn) { for (int rep = 0; rep < REP_CONV; ++rep) conv_phase(lds, tid, lane, wave, G, zb, ap->in[I_HWSH] + j * 3 * NMIX, ap->in[I_HBSH] + j * NMIX, ws + WS_FILT + (size_t)j * FILT_LAYER, yhb); }
                else if (KON(9)) {
                    float d1 = 0.f, d2 = 0.f;
                    for (int e = 0; e < 64; ++e) { d1 += ap->in[I_LQ1][j * 64 + e] * ap->in[I_LK1][j * 64 + e]; d2 += ap->in[I_LQ2][j * 64 + e] * ap->in[I_LK2][j * 64 + e]; }
                    const float lam_init = 0.8f - 0.6f * __expf(-0.3f * (float)i);
                    const float lam = __expf(d1) - __expf(d2) + lam_init;
                    for (int rep = 0; rep < REP_ATTN; ++rep) attn_phase(lds, tid, lane, wave, G, zb, ap->in[I_CK] + (size_t)j * 8 * 256 * 128, ap->in[I_CV] + (size_t)j * 8 * 256 * 128, ap->in[I_SUBLN] + j * 128, lam, lam_init, yhb);
                }
            } else if (kind == 4 && KON(0)) {
                row_phase(gw, NGW, lane, xout, xout + (size_t)TP * D, xout, Y, attn ? (const float*)(ws + WS_ZERO) : ap->in[I_HBOUT] + j * D, modl + 2 * 1024, normw + (i * 4 + 1) * D, normw + (i * 4 + 2) * D, modl + 3 * 1024, modl + 4 * 1024, hb);
            } else if (kind == 6 && KON(6)) {
                for (int rep = 0; rep < REP_ELEM; ++rep) ffn_elem_phase(blockIdx.x * 512 + tid, G * 512, zb, ap->in[I_FDW] + (size_t)i * 3 * NUP, ap->in[I_FBDW] + (size_t)i * NUP, ab);
            }
        }
        if (ph + 1 < ph_hi) {
            if (ph_hi > 4096) cg::this_grid().sync();
            for (int rep = 0; rep < REP_SYNC; ++rep) xcd_barrier((unsigned*)(ws + WS_CTL), (volatile LAS unsigned*)(lds + LDS_MISC + 32));
        }
    }
}

extern "C" void kernel_launch(void* const* d_in, const int* in_sizes, int n_in, void* d_out, int out_size, void* d_ws, size_t ws_size, hipStream_t stream) {
    static int grid = 0;
    if (grid == 0) {
        if (n_in != 33 || ws_size < WS_END) { fprintf(stderr, "kernel_launch: unexpected inputs (n_in %d, ws %zu)\n", n_in, ws_size); grid = -1; return; }
        int dev = 0, cus = 0, per_cu = 0;
        hipGetDevice(&dev); hipDeviceGetAttribute(&cus, hipDeviceAttributeMultiprocessorCount, dev);
        if (hipFuncSetAttribute((const void*)fwd_megakernel, hipFuncAttributeMaxDynamicSharedMemorySize, LDS_BYTES) != hipSuccess) { fprintf(stderr, "kernel_launch: hipFuncSetAttribute failed\n"); grid = -1; return; }
        if (hipOccupancyMaxActiveBlocksPerMultiprocessor(&per_cu, (const void*)fwd_megakernel, NWAVES * 64, LDS_BYTES) != hipSuccess || per_cu < 1) { fprintf(stderr, "kernel_launch: occupancy query says %d\n", per_cu); per_cu = 1; }
        (void)hipGetLastError();
        grid = cus * 1;
    }
    if (grid < 0) return;
    if (hipMemsetAsync((char*)d_ws + WS_CTL, 0, CTL_BYTES, stream) != hipSuccess) { fprintf(stderr, "kernel_launch: memset failed\n"); return; }
    Args a{};
    for (int i = 0; i < 33; ++i) a.in[i] = (const float*)d_in[i];
    a.out = (float*)d_out; a.ws = (unsigned char*)d_ws;
#if MK_ONE_LAUNCH
    a.ph_lo = 0; a.ph_hi = N_PHASES;
    void* args[] = {&a};
    hipError_t e = hipLaunchCooperativeKernel((const void*)fwd_megakernel, dim3(grid), dim3(NWAVES * 64), args, LDS_BYTES, stream);
    if (e != hipSuccess) fprintf(stderr, "cooperative launch failed: %s (grid %d)\n", hipGetErrorString(e), grid);
#else
    for (int ph = 0; ph < N_PHASES; ++ph) {
        a.ph_lo = ph; a.ph_hi = ph + 1;
        void* args[] = {&a};
        hipError_t e = hipLaunchCooperativeKernel((const void*)fwd_megakernel, dim3(grid), dim3(NWAVES * 64), args, LDS_BYTES, stream);
        if (e != hipSuccess) { fprintf(stderr, "launch %d failed: %s (grid %d)\n", ph, hipGetErrorString(e), grid); break; }
    }
#endif
}
```
